# Optimizing an MI355X kernel written in HIP

```python
import math
import jax, jax.numpy as jnp
from jax import lax
import numpy as np

D_MODEL = 1024
BATCH = 8
SEQ = 4096
DEPTH = 2

N_A_LAYERS = DEPTH // 2
N_B_LAYERS = DEPTH - N_A_LAYERS
A_HEADS = 8
A_HEAD_DIM = 128
A_WIDTH = A_HEADS * A_HEAD_DIM
A_CONV = 4
A_CHUNK = 64
B_HEADS = 16
B_GROUPS = 2
B_HPG = B_HEADS // B_GROUPS
B_HEAD_DIM = 64
B_WIDTH = B_HEADS * B_HEAD_DIM
N_BRANCH = 3
L_CMP = 32
CMP_STRIDE = 16
CMP_HIDDEN = 256
L_SLC = 64
N_SEL = 16
WINDOW = 512
Q_BLOCK = 64
NUM_BUCKETS = 32
MAX_DISTANCE = 128

EPS = 1e-6
NEG_INF = -1e30
SEL_BOOST = 1e9

kernel_name = "yoco_deltanet_nsa_hybrid"


def rmsnorm(x, g):
    xf = x.astype(jnp.float32)
    y = xf * lax.rsqrt(jnp.mean(xf * xf, axis=-1, keepdims=True) + EPS)
    return (y * g.astype(jnp.float32)).astype(x.dtype)


def l2norm(x):
    xf = x.astype(jnp.float32)
    return xf * lax.rsqrt(jnp.sum(xf * xf, axis=-1, keepdims=True) + EPS)


def masked_softmax(logits, mask):
    logits = jnp.where(mask, logits.astype(jnp.float32), NEG_INF)
    m = jnp.max(logits, axis=-1, keepdims=True)
    e = jnp.exp(logits - m) * mask
    return e / jnp.maximum(jnp.sum(e, axis=-1, keepdims=True), 1e-30)


def ada_modulation(c, w, b):
    mod = jax.nn.silu(c) @ w + b
    shift, scale, gate = jnp.split(mod, 3, axis=-1)
    return shift[:, None], scale[:, None], gate[:, None]


def t5_bucket(dist):
    n = jnp.maximum(dist, 0)
    max_exact = NUM_BUCKETS // 2
    nf = jnp.maximum(n, 1).astype(jnp.float32)
    large = max_exact + (jnp.log(nf / max_exact) / math.log(MAX_DISTANCE / max_exact)
                         * (NUM_BUCKETS - max_exact)).astype(jnp.int32)
    large = jnp.minimum(large, NUM_BUCKETS - 1)
    return jnp.where(n < max_exact, n, large)


def causal_depthwise_conv(x, w):
    K = w.shape[0]
    T = x.shape[1]
    xp = jnp.pad(x, ((0, 0), (K - 1, 0), (0, 0)))
    y = xp[:, 0:T] * w[0]
    for k in range(1, K):
        y = y + xp[:, k:k + T] * w[k]
    return y


def chunk_gated_delta_rule(q, k, v, g, beta):
    Bn, T, H, dk = q.shape
    dv = v.shape[-1]
    C = A_CHUNK
    N = T // C

    def chunks(t):
        return t.reshape(Bn, N, C, H, -1).transpose(0, 3, 1, 2, 4)

    q, k, v = chunks(q), chunks(k), chunks(v)
    g = g.reshape(Bn, N, C, H).transpose(0, 3, 1, 2)
    beta = beta.reshape(Bn, N, C, H).transpose(0, 3, 1, 2)
    gc = jnp.cumsum(g, axis=-1)
    incl = np.tril(np.ones((C, C), dtype=bool))
    strict = np.tril(np.ones((C, C), dtype=bool), -1)
    diff = gc[..., :, None] - gc[..., None, :]
    decay = jnp.where(incl, jnp.exp(jnp.where(incl, diff, 0.0)), 0.0)
    kb = k * beta[..., None]
    m = jnp.where(strict, jnp.einsum('bhnid,bhnjd->bhnij', kb, k) * decay, 0.0)
    a_mat = m + jnp.eye(C, dtype=m.dtype)
    rhs = jnp.concatenate([v * beta[..., None], kb * jnp.exp(gc)[..., None]], axis=-1)
    uw = lax.linalg.triangular_solve(a_mat, rhs, left_side=True, lower=True, unit_diagonal=True)
    u, w = uw[..., :dv], uw[..., dv:]
    attn = jnp.einsum('bhnid,bhnjd->bhnij', q, k) * decay
    q_dec = q * jnp.exp(gc)[..., None]
    k_dec = k * jnp.exp(gc[..., -1:] - gc)[..., None]
    g_last = jnp.exp(gc[..., -1])

    def step(S, xs):
        q_n, u_n, w_n, a_n, kd_n, gl_n = xs
        v_new = u_n - jnp.einsum('bhck,bhkv->bhcv', w_n, S)
        o_n = jnp.einsum('bhck,bhkv->bhcv', q_n, S) + jnp.einsum('bhij,bhjv->bhiv', a_n, v_new)
        S = S * gl_n[..., None, None] + jnp.einsum('bhck,bhcv->bhkv', kd_n, v_new)
        return S, o_n

    xs = tuple(jnp.moveaxis(t, 2, 0) for t in (q_dec, u, w, attn, k_dec, g_last))
    S0 = jnp.zeros((Bn, H, dk, dv), jnp.float32)
    _, o = lax.scan(step, S0, xs)
    return o.transpose(1, 0, 3, 2, 4).reshape(Bn, T, H, dv)


def gated_deltanet_layer(h, in_w, conv_w, A_log, dt_bias, onorm_g, out_w):
    Bn, T, _ = h.shape
    proj = h @ in_w
    qkv = jax.nn.silu(causal_depthwise_conv(proj[..., :3 * A_WIDTH], conv_w))
    z = proj[..., 3 * A_WIDTH:4 * A_WIDTH].reshape(Bn, T, A_HEADS, A_HEAD_DIM)
    b = proj[..., 4 * A_WIDTH:4 * A_WIDTH + A_HEADS]
    a = proj[..., 4 * A_WIDTH + A_HEADS:]
    q, k, v = [t.reshape(Bn, T, A_HEADS, A_HEAD_DIM) for t in jnp.split(qkv, 3, axis=-1)]
    q = l2norm(q) * (A_HEAD_DIM ** -0.5)
    k = l2norm(k)
    beta = jax.nn.sigmoid(b.astype(jnp.float32))
    g = -jnp.exp(A_log.astype(jnp.float32)) * jax.nn.softplus(a.astype(jnp.float32) + dt_bias.astype(jnp.float32))
    o = chunk_gated_delta_rule(q, k, v.astype(jnp.float32), g, beta)
    o = rmsnorm(o, onorm_g) * jax.nn.silu(z.astype(jnp.float32))
    return o.astype(h.dtype).reshape(Bn, T, A_WIDTH) @ out_w


def nsa_shared_kv(stream, kv_norm_g, kv_w, cmp_pos_k, cmp_pos_v, cmp_k_w1, cmp_k_w2, cmp_v_w1, cmp_v_w2):
    Bn, T, _ = stream.shape
    s = rmsnorm(stream, kv_norm_g)
    kv = (s @ kv_w).reshape(Bn, T, 6, B_GROUPS, B_HEAD_DIM).transpose(2, 0, 3, 1, 4)
    n_cmp = (T - L_CMP) // CMP_STRIDE + 1
    idx = np.arange(n_cmp)[:, None] * CMP_STRIDE + np.arange(L_CMP)[None, :]

    def compress(tok, pos, w1, w2):
        blk = tok[:, :, idx] + pos
        return jax.nn.silu(blk.reshape(Bn, B_GROUPS, n_cmp, L_CMP * B_HEAD_DIM) @ w1) @ w2

    k_cmp = compress(kv[0], cmp_pos_k, cmp_k_w1, cmp_k_w2)
    v_cmp = compress(kv[1], cmp_pos_v, cmp_v_w1, cmp_v_w2)
    n_slc = T // L_SLC
    k_slc = kv[2].reshape(Bn, B_GROUPS, n_slc, L_SLC, B_HEAD_DIM)
    v_slc = kv[3].reshape(Bn, B_GROUPS, n_slc, L_SLC, B_HEAD_DIM)
    return k_cmp, v_cmp, k_slc, v_slc, kv[4], kv[5]


def nsa_layer(h, shared, rel_bias, in_w, out_w):
    k_cmp, v_cmp, k_slc, v_slc, k_win, v_win = shared
    Bn, T, _ = h.shape
    proj = h @ in_w
    z = proj[..., B_WIDTH:4 * B_WIDTH].reshape(Bn, T, N_BRANCH, B_HEADS, B_HEAD_DIM)
    gates = jax.nn.sigmoid(proj[..., 4 * B_WIDTH:].astype(jnp.float32)).reshape(Bn, T, N_BRANCH, B_HEADS)
    n_q = T // Q_BLOCK
    q = (proj[..., :B_WIDTH] * (B_HEAD_DIM ** -0.5)).reshape(
        Bn, n_q, Q_BLOCK, B_GROUPS, B_HPG, B_HEAD_DIM).transpose(1, 0, 3, 4, 2, 5)
    n_cmp = k_cmp.shape[2]
    n_slc = k_slc.shape[2]
    n_sel = min(N_SEL, n_slc)
    cmp_end = jnp.arange(n_cmp) * CMP_STRIDE + (L_CMP - 1)
    cells = np.arange(n_cmp)[:, None] + np.arange(L_CMP // CMP_STRIDE)[None, :]
    overlap = jnp.asarray((cells[:, None, :] // (L_SLC // CMP_STRIDE) == np.arange(n_slc)[None, :, None])
                          .sum(-1).astype(np.float32))
    rb_group = rel_bias.reshape(NUM_BUCKETS, B_GROUPS, B_HPG)
    k_win_p = jnp.pad(k_win, ((0, 0), (0, 0), (WINDOW, 0), (0, 0)))
    v_win_p = jnp.pad(v_win, ((0, 0), (0, 0), (WINDOW, 0), (0, 0)))
    b_idx = jnp.arange(Bn)[:, None, None, None]
    g_idx = jnp.arange(B_GROUPS)[None, :, None, None]
    blk_ids = jnp.arange(n_slc)

    def dense_bias(dist):
        return rel_bias[t5_bucket(dist)].transpose(2, 0, 1).reshape(B_GROUPS, B_HPG, *dist.shape)

    def attend_block(args):
        qb, qi = args
        t = qi * Q_BLOCK + jnp.arange(Q_BLOCK)
        d_c = t[:, None] - cmp_end[None, :]
        s_c = jnp.einsum('bghqd,bgcd->bghqc', qb, k_cmp).astype(jnp.float32) + dense_bias(d_c)
        p_c = masked_softmax(s_c, d_c >= 0)
        o_c = jnp.einsum('bghqc,bgcd->bghqd', p_c.astype(v_cmp.dtype), v_cmp)
        imp = jnp.einsum('bghqc,cs->bgqs', p_c, overlap)
        cur = (t // L_SLC)[:, None]
        forced = (blk_ids == 0) | (blk_ids == cur) | (blk_ids == cur - 1)
        imp = jnp.where(forced, SEL_BOOST, jnp.where(blk_ids > cur, -SEL_BOOST, imp))
        _, sel = lax.top_k(imp, n_sel)
        k_sel = k_slc[b_idx, g_idx, sel]
        v_sel = v_slc[b_idx, g_idx, sel]
        d_s = t[:, None, None] - (sel[..., None] * L_SLC + jnp.arange(L_SLC))
        bias_s = jnp.moveaxis(rb_group[t5_bucket(d_s), g_idx[..., None]], -1, 2)
        s_s = jnp.einsum('bghqd,bgqnld->bghqnl', qb, k_sel).astype(jnp.float32) + bias_s
        p_s = masked_softmax(s_s.reshape(Bn, B_GROUPS, B_HPG, Q_BLOCK, n_sel * L_SLC),
                             (d_s >= 0).reshape(Bn, B_GROUPS, 1, Q_BLOCK, n_sel * L_SLC))
        o_s = jnp.einsum('bghqk,bgqkd->bghqd', p_s.astype(v_sel.dtype),
                         v_sel.reshape(Bn, B_GROUPS, Q_BLOCK, n_sel * L_SLC, B_HEAD_DIM))
        q0 = qi * Q_BLOCK
        k_w = lax.dynamic_slice_in_dim(k_win_p, q0, WINDOW + Q_BLOCK, axis=2)
        v_w = lax.dynamic_slice_in_dim(v_win_p, q0, WINDOW + Q_BLOCK, axis=2)
        kpos = q0 - WINDOW + jnp.arange(WINDOW + Q_BLOCK)
        d_w = t[:, None] - kpos[None, :]
        mask_w = (d_w >= 0) & (d_w < WINDOW) & (kpos[None, :] >= 0)
        s_w = jnp.einsum('bghqd,bgkd->bghqk', qb, k_w).astype(jnp.float32) + dense_bias(d_w)
        p_w = masked_softmax(s_w, mask_w)
        o_w = jnp.einsum('bghqk,bgkd->bghqd', p_w.astype(v_w.dtype), v_w)
        return jnp.stack([o_c, o_s, o_w], axis=0)

    o = lax.map(attend_block, (q, jnp.arange(n_q)))
    o = o.transpose(2, 0, 5, 1, 3, 4, 6).reshape(Bn, T, N_BRANCH, B_HEADS, B_HEAD_DIM)
    y = jnp.sum(gates[..., None].astype(o.dtype) * o * jax.nn.silu(z), axis=2)
    return y.reshape(Bn, T, B_WIDTH) @ out_w


def setup_inputs(seed: int = 0) -> dict:
    key = jax.random.key(seed)
    ks = jax.random.split(key, 24)
    f32 = jnp.float32

    def nrm(k, shape, scale):
        return jax.random.normal(k, shape, f32) * scale

    a_cols = 4 * A_WIDTH + 2 * A_HEADS
    b_cols = 4 * B_WIDTH + N_BRANCH * B_HEADS
    dt = jnp.exp(jax.random.uniform(ks[9], (N_A_LAYERS, A_HEADS), f32, math.log(1e-3), math.log(1e-1)))
    return {
        "x": nrm(ks[0], (BATCH, SEQ, D_MODEL), 1.0),
        "c": nrm(ks[1], (BATCH, D_MODEL), 1.0),
        "rel_bias": nrm(ks[2], (NUM_BUCKETS, B_HEADS), 0.3),
        "ada_w": nrm(ks[3], (DEPTH, D_MODEL, 3 * D_MODEL), 0.5 * D_MODEL ** -0.5),
        "ada_b": nrm(ks[4], (DEPTH, 3 * D_MODEL), 0.02),
        "norm_g": 1.0 + nrm(ks[5], (DEPTH, D_MODEL), 0.02),
        "a_in_w": nrm(ks[6], (N_A_LAYERS, D_MODEL, a_cols), D_MODEL ** -0.5),
        "a_conv_w": nrm(ks[7], (N_A_LAYERS, A_CONV, 3 * A_WIDTH), A_CONV ** -0.5),
        "a_A_log": jnp.log(jax.random.uniform(ks[8], (N_A_LAYERS, A_HEADS), f32, 1.0, 16.0)),
        "a_dt_bias": dt + jnp.log(-jnp.expm1(-dt)),
        "a_onorm_g": 1.0 + nrm(ks[10], (N_A_LAYERS, A_HEAD_DIM), 0.02),
        "a_out_w": nrm(ks[11], (N_A_LAYERS, A_WIDTH, D_MODEL), A_WIDTH ** -0.5),
        "kv_norm_g": 1.0 + nrm(ks[12], (D_MODEL,), 0.02),
        "kv_w": nrm(ks[13], (D_MODEL, 6 * B_GROUPS * B_HEAD_DIM), D_MODEL ** -0.5),
        "cmp_pos_k": nrm(ks[14], (L_CMP, B_HEAD_DIM), 0.1),
        "cmp_pos_v": nrm(ks[15], (L_CMP, B_HEAD_DIM), 0.1),
        "cmp_k_w1": nrm(ks[16], (L_CMP * B_HEAD_DIM, CMP_HIDDEN), (L_CMP * B_HEAD_DIM) ** -0.5),
        "cmp_k_w2": nrm(ks[17], (CMP_HIDDEN, B_HEAD_DIM), CMP_HIDDEN ** -0.5),
        "cmp_v_w1": nrm(ks[18], (L_CMP * B_HEAD_DIM, CMP_HIDDEN), (L_CMP * B_HEAD_DIM) ** -0.5),
        "cmp_v_w2": nrm(ks[19], (CMP_HIDDEN, B_HEAD_DIM), CMP_HIDDEN ** -0.5),
        "b_in_w": nrm(ks[20], (N_B_LAYERS, D_MODEL, b_cols), D_MODEL ** -0.5),
        "b_out_w": nrm(ks[21], (N_B_LAYERS, B_WIDTH, D_MODEL), B_WIDTH ** -0.5),
        "final_g": 1.0 + nrm(ks[22], (D_MODEL,), 0.02),
    }


def reference(x, c, rel_bias, ada_w, ada_b, norm_g, a_in_w, a_conv_w, a_A_log, a_dt_bias, a_onorm_g, a_out_w,
              kv_norm_g, kv_w, cmp_pos_k, cmp_pos_v, cmp_k_w1, cmp_k_w2, cmp_v_w1, cmp_v_w2,
              b_in_w, b_out_w, final_g):
    shared = None
    for l in range(DEPTH):
        shift, scale, gate = ada_modulation(c, ada_w[l], ada_b[l])
        h = rmsnorm(x, norm_g[l]) * (1.0 + scale) + shift
        if l < N_A_LAYERS:
            out = gated_deltanet_layer(h, a_in_w[l], a_conv_w[l], a_A_log[l], a_dt_bias[l], a_onorm_g[l], a_out_w[l])
        else:
            j = l - N_A_LAYERS
            out = nsa_layer(h, shared, rel_bias, b_in_w[j], b_out_w[j])
        x = x + gate * out
        if l == N_A_LAYERS - 1:
            shared = nsa_shared_kv(x, kv_norm_g, kv_w, cmp_pos_k, cmp_pos_v, cmp_k_w1, cmp_k_w2, cmp_v_w1, cmp_v_w2)
    return rmsnorm(x, final_g)
```

```cpp
#include <hip/hip_runtime.h>
#include <cstdio>
#include <cstdint>
#include <type_traits>

#define DI __device__ __forceinline__
#define LAS __attribute__((address_space(3)))
typedef unsigned short bf16_t;
typedef short bf16x8 __attribute__((ext_vector_type(8)));
typedef short s16x4 __attribute__((ext_vector_type(4)));
typedef float f32x4 __attribute__((ext_vector_type(4)));
typedef float f32x2 __attribute__((ext_vector_type(2)));
typedef float f32x16 __attribute__((ext_vector_type(16)));
typedef unsigned u32x4 __attribute__((ext_vector_type(4)));
typedef unsigned u32x2 __attribute__((ext_vector_type(2)));
typedef __bf16 bf16x2_t __attribute__((ext_vector_type(2)));

#ifndef MK_ONE_LAUNCH
#define MK_ONE_LAUNCH 1
#endif

constexpr int NB = 8, T = 4096, D = 1024, M = NB * T;
constexpr int A_LD = 4112, B_LD = 4144;
constexpr float EPS = 1e-6f;
constexpr int NPH = 14;

constexpr size_t MiB = 1u << 20;
constexpr size_t WS_CTL = 0;
constexpr size_t WS_MODP = 1 * MiB;
constexpr size_t WS_WA = 4 * MiB;
constexpr size_t WS_WAO = 12 * MiB;
constexpr size_t WS_WCAT = 14 * MiB;
constexpr size_t WS_WBO = 24 * MiB;
constexpr size_t WS_W1T = 26 * MiB;
constexpr size_t WS_W2T = 28 * MiB;
constexpr size_t WS_C1P = 28 * MiB + 65536;
constexpr size_t WS_MOD = 28 * MiB + 131072;
constexpr size_t WS_SSQ = 28 * MiB + 524288;
constexpr size_t WS_BG = 31 * MiB;
constexpr size_t WS_GL = 33 * MiB;
constexpr size_t WS_RA = 34 * MiB;
constexpr size_t WS_RP = 130 * MiB;
constexpr size_t WS_PW = WS_RP;
constexpr size_t WS_PQD = WS_RP + 64 * MiB;
constexpr size_t WS_PKDT = WS_RP + 128 * MiB;
constexpr size_t WS_PU = WS_RP + 192 * MiB;
constexpr size_t WS_PAT = WS_RP + 256 * MiB;
constexpr size_t WS_PROJB = WS_RP;
constexpr size_t WS_S = WS_RP + 256 * MiB;
constexpr size_t WS_KV = WS_RP + 320 * MiB;
constexpr size_t WS_GATES = WS_RP + 368 * MiB;
constexpr size_t WS_CMP = WS_RP + 374 * MiB;
constexpr size_t WS_END = WS_RP + 375 * MiB;

constexpr int LDS_BYTES = 155648;

DI unsigned cvtpk(float lo, float hi) { f32x2 v = {lo, hi}; bf16x2_t b = __builtin_convertvector(v, bf16x2_t); return __builtin_bit_cast(unsigned, b); }
DI bf16_t f2bf(float f) { return (bf16_t)(cvtpk(f, 0.f) & 0xffffu); }
DI float bf2f(bf16_t v) { return __uint_as_float((unsigned)v << 16); }
DI float bflo(unsigned u) { return __uint_as_float(u << 16); }
DI float bfhi(unsigned u) { return __uint_as_float(u & 0xffff0000u); }
DI float siluf(float x) { return x / (1.f + __expf(-x)); }
DI float sigm(float x) { return 1.f / (1.f + __expf(-x)); }
DI float wave_sum(float v) {
#pragma unroll
    for (int o = 1; o < 64; o <<= 1) v += __shfl_xor(v, o);
    return v;
}
DI int crow(int reg, int h) { return (reg & 3) + 8 * (reg >> 2) + 4 * h; }
#define MFMA32(a, b, c) __builtin_amdgcn_mfma_f32_32x32x16_bf16((a), (b), (c), 0, 0, 0)
DI bf16x8 pack8(const f32x16& x, const int s) {
    u32x4 p;
    p[0] = cvtpk(x[8 * s + 0], x[8 * s + 1]); p[1] = cvtpk(x[8 * s + 2], x[8 * s + 3]);
    p[2] = cvtpk(x[8 * s + 4], x[8 * s + 5]); p[3] = cvtpk(x[8 * s + 6], x[8 * s + 7]);
    return __builtin_bit_cast(bf16x8, p);
}
DI bf16x8 lds128(const LAS unsigned char* p) { return *(const LAS bf16x8*)p; }
DI bf16x8 lds2x64(const LAS unsigned char* lo, const LAS unsigned char* hi) {
    const s16x4 a = *(const LAS s16x4*)lo, b = *(const LAS s16x4*)hi;
    return __builtin_shufflevector(a, b, 0, 1, 2, 3, 4, 5, 6, 7);
}
DI int otid() { int t = threadIdx.x; asm volatile("" : "+v"(t)); return t; }
DI f32x16 zero16() { f32x16 z; for (int i = 0; i < 16; ++i) z[i] = 0.f; return z; }

struct Params { const float* in[23]; float* out; unsigned char* ws; int ph_lo, ph_hi, pad0, pad1; };

#define XB_TMO      128
#define XB_XCNT(j)  (256  + 64 * (j))
#define XB_XSUB(j)  (1280 + 64 * (j))
#define XB_XGEN(j)  (2304 + 64 * (j))
#define XB_TOP      3328
#define XB_TOPGEN   3392
#define XCD_BAR_WORDS 3456
#define XB_SPIN_CAP (1u << 22)
DI unsigned xb_ld(unsigned* p)              { return __hip_atomic_load(p, __ATOMIC_RELAXED, __HIP_MEMORY_SCOPE_AGENT); }
DI unsigned xb_add(unsigned* p, unsigned v) { return __hip_atomic_fetch_add(p, v, __ATOMIC_RELAXED, __HIP_MEMORY_SCOPE_AGENT); }
DI unsigned xb_xcc_id() { return (unsigned)__builtin_amdgcn_s_getreg((3 << 11) | 20) & 0xFu; }
#define XB_SPIN(cond, bar) do { unsigned _sp = 0; while (cond) { __builtin_amdgcn_s_sleep(1); \
    if ((++_sp & 255u) == 0u) { if (xb_ld(&(bar)[XB_TMO])) break; if (_sp > XB_SPIN_CAP) { atomicAdd(&(bar)[XB_TMO], 1u); break; } } } } while (0)
struct XcdBarrier { unsigned* bar; unsigned x; volatile LAS unsigned* st; };
DI XcdBarrier xcd_barrier_post(unsigned* bar, volatile LAS unsigned* st) {
    XcdBarrier b; b.bar = bar; b.x = xb_xcc_id(); b.st = st;
    if (threadIdx.x == 0) (void)xb_add(&bar[XB_XCNT(b.x)], 1u);
    return b;
}
DI void xcd_barrier_complete(unsigned* bar, unsigned x, unsigned& nloc, unsigned& nx) {
    const unsigned G = gridDim.x * gridDim.y * gridDim.z;
    unsigned sum, cnt, mine, sp = 0u;
    for (;;) {
        sum = 0u; cnt = 0u; mine = 0u;
#pragma unroll
        for (unsigned j = 0; j < 16; ++j) { const unsigned c = xb_ld(&bar[XB_XCNT(j)]); sum += c; cnt += (c > 0u) ? 1u : 0u; mine = (j == x) ? c : mine; }
        if (sum == G) break;
        __builtin_amdgcn_s_sleep(1);
        if ((++sp & 255u) == 0u) { if (xb_ld(&bar[XB_TMO])) break; if (sp > XB_SPIN_CAP) { atomicAdd(&bar[XB_TMO], 1u); break; } }
    }
    nloc = mine > 0u ? mine : 1u; nx = cnt > 0u ? cnt : 1u;
}
DI void xcd_barrier(const XcdBarrier& b) {
    asm volatile("s_waitcnt vmcnt(0)" ::: "memory");
    __syncthreads();
    if (threadIdx.x == 0) {
        unsigned* bar = b.bar;
        __builtin_amdgcn_s_waitcnt(0);
        unsigned nloc = b.st[0], nx = b.st[1];
        if (nloc == 0u) { xcd_barrier_complete(bar, b.x, nloc, nx); b.st[0] = nloc; b.st[1] = nx; }
        const unsigned old = xb_add(&bar[XB_XSUB(b.x)], 1u);
        const unsigned gen = old / nloc;
        if (old + 1u == (gen + 1u) * nloc) {
            __builtin_amdgcn_fence(__ATOMIC_RELEASE, "agent");
            asm volatile("s_waitcnt vmcnt(0)" ::: "memory");
            const unsigned og = xb_add(&bar[XB_TOP], 1u);
            const unsigned tg = og / nx;
            if (og + 1u == (tg + 1u) * nx) xb_add(&bar[XB_TOPGEN], 1u);
            else XB_SPIN(xb_ld(&bar[XB_TOPGEN]) == tg, bar);
            __builtin_amdgcn_fence(__ATOMIC_ACQUIRE, "agent");
            xb_add(&bar[XB_XGEN(b.x)], 1u);
            asm volatile("s_waitcnt vmcnt(0)" ::: "memory");
        } else {
            XB_SPIN(xb_ld(&bar[XB_XGEN(b.x)]) == gen, bar);
            __builtin_amdgcn_fence(__ATOMIC_ACQUIRE, "agent");
            asm volatile("s_waitcnt vmcnt(0)" ::: "memory");
        }
    }
    __syncthreads();
}

namespace pg8 {
constexpr int BM = 256, BK = 64, HALF = 128, HTB = HALF * BK * 2, STAGE_BYTES = 8 * HTB, NXCD = 8, WGM = 8;
DI int lds_byte(int r, int c) { const int st = (r >> 4) * 2 + (c >> 5), rr = r & 15, cc = c & 31, ob = rr * 64 + cc * 2; return st * 1024 + (ob ^ (((ob >> 9) & 1) << 5)); }
DI void stage_rc(int b, int& R, int& C) { const int st = b / 1024, sb = b % 1024, swz = sb ^ (((sb >> 9) & 1) << 5); R = (st >> 1) * 16 + swz / 64; C = (st & 1) * 32 + (swz % 64) / 2; }
DI int perm32(int rho) { const int n = rho >> 4, i = rho & 15; return 8 * (i >> 2) + 4 * n + (i & 3); }
struct Unit { int pm, pn; };
struct Gemm { const bf16_t* A0; const bf16_t* A1; int split; const bf16_t* Bt; int M, N, K; };
struct StaticOrder {
    int nM, nN, nwg, G, c;
    DI void init(int M_, int N_, int G_, int c_) { nM = M_ / BM; nN = N_ / BM; nwg = nM * nN; G = G_; c = c_; }
    DI bool next(int i, Unit& u) const {
        const long L = (long)i * G + c; if (L >= nwg) return false;
        int wgid = (int)L; { const int q = nwg / NXCD, r = nwg % NXCD, xcd = wgid % NXCD, off = wgid / NXCD; wgid = (xcd < r ? xcd * (q + 1) : r * (q + 1) + (xcd - r) * q) + off; }
        const int nig = WGM * nN, gid = wgid / nig, fm = gid * WGM, gsz = (nM - fm) < WGM ? (nM - fm) : WGM;
        u.pm = fm + ((wgid % nig) % gsz); u.pn = (wgid % nig) / gsz; return true;
    }
};
template <class Epi, bool ALIGN_EPI>
DI void gemm_phase(LAS unsigned char* lds, const Gemm g, const StaticOrder& S, const Epi& E) {
    const int tid = otid(), wid = __builtin_amdgcn_readfirstlane(tid >> 6), lane = tid & 63, wr = wid >> 2, wc = wid & 3, fr = lane & 15, fq = lane >> 4;
    const int K = g.K, nt = K / BK;
    unsigned voffA[2], voffB[2];
#pragma unroll
    for (int i = 0; i < 2; ++i) { int R, C; stage_rc(tid * 16 + i * 8192, R, C); const int Rb = Epi::PERM ? ((R & ~31) + perm32(R & 31)) : R;
        voffA[i] = (unsigned)(R * K + C) * 2u; voffB[i] = (unsigned)(Rb * K + C) * 2u; }
    const size_t kstep = (size_t)(BK * 2);
    const size_t hstep = (size_t)HALF * K * 2;
    const size_t tstep = 2 * hstep;
    const unsigned ldsw = (unsigned)wid * 1024u;
    const int aoff = lds_byte(wr * 64 + fr, fq * 8), boff = lds_byte(wc * 32 + fr, fq * 8);
#define PG8_SA(b, h) (((b) * 2 + (h)) * HTB)
#define PG8_SB(b, h) ((4 + (b) * 2 + (h)) * HTB)
#define PG8_STAGE(bufoff, gbase, voff) do { _Pragma("unroll") for (int _i = 0; _i < 2; ++_i) \
        __builtin_amdgcn_global_load_lds((const unsigned*)((const char*)(gbase) + (voff)[_i]), (LAS unsigned*)(lds + (bufoff) + ldsw + _i * 8192), 16, 0, 0); } while (0)
#define PG8_LDA(dst, b, h) do { _Pragma("unroll") for (int m = 0; m < 4; ++m) _Pragma("unroll") for (int k = 0; k < 2; ++k) dst[m][k] = *(const LAS bf16x8*)(lds + PG8_SA(b, h) + aoff + m * 2048 + k * 1024); } while (0)
#define PG8_LDB(dst, b, h) do { _Pragma("unroll") for (int n = 0; n < 2; ++n) _Pragma("unroll") for (int k = 0; k < 2; ++k) dst[n][k] = *(const LAS bf16x8*)(lds + PG8_SB(b, h) + boff + n * 2048 + k * 1024); } while (0)
#define PG8_MMA(ai, bj, At, Bt) do { __builtin_amdgcn_s_setprio(1); _Pragma("unroll") for (int m = 0; m < 4; ++m) _Pragma("unroll") for (int n = 0; n < 2; ++n) _Pragma("unroll") for (int k = 0; k < 2; ++k) \
        acc[ai][bj][m][n] = __builtin_amdgcn_mfma_f32_16x16x32_bf16(Bt[n][k], At[m][k], acc[ai][bj][m][n], 0, 0, 0); __builtin_amdgcn_s_setprio(0); } while (0)
#define PG8_WAIT_V(n) asm volatile("s_waitcnt vmcnt(" #n ")" ::: "memory")
#define PG8_WAIT_L(n) asm volatile("s_waitcnt lgkmcnt(" #n ")" ::: "memory")
#define PG8_BAR __builtin_amdgcn_s_barrier()
#define PG8_SCHED __builtin_amdgcn_sched_barrier(0)
    Unit cur, nxt; int ui = 0;
    if (!S.next(0, cur)) return;
    f32x4 acc[2][2][4][2];
#pragma unroll
    for (int a = 0; a < 2; ++a)
#pragma unroll
        for (int b = 0; b < 2; ++b)
#pragma unroll
            for (int m = 0; m < 4; ++m)
#pragma unroll
                for (int n = 0; n < 2; ++n) acc[a][b][m][n] = (f32x4){0.f, 0.f, 0.f, 0.f};
    bf16x8 At[4][2], B0[2][2], B1[2][2];
    const char* cA = (const char*)(cur.pn < g.split ? g.A0 : g.A1) + (size_t)cur.pm * tstep; const char* cB = (const char*)g.Bt + (size_t)cur.pn * tstep;
    PG8_STAGE(PG8_SB(0, 0), cB, voffB); PG8_STAGE(PG8_SB(0, 1), cB + hstep, voffB); PG8_STAGE(PG8_SA(0, 0), cA, voffA); PG8_STAGE(PG8_SA(0, 1), cA + hstep, voffA);
    if (wr == 1) PG8_BAR;
    PG8_WAIT_V(2); PG8_BAR;
    PG8_STAGE(PG8_SB(1, 0), cB + kstep, voffB); PG8_STAGE(PG8_SA(1, 0), cA + kstep, voffA); PG8_STAGE(PG8_SB(1, 1), cB + hstep + kstep, voffB);
    PG8_WAIT_V(6); PG8_BAR;
    for (;;) {
        const bool has_next = S.next(ui + 1, nxt);
        const char* nA = has_next ? (const char*)(nxt.pn < g.split ? g.A0 : g.A1) + (size_t)nxt.pm * tstep : cA; const char* nB = has_next ? (const char*)g.Bt + (size_t)nxt.pn * tstep : cB;
        for (int t = 0; t < nt; t += 2) {
            const bool last = (t == nt - 2);
            const char* a1 = cA + (size_t)(t + 1) * kstep;
            const char* a2 = last ? nA : cA + (size_t)(t + 2) * kstep; const char* b2 = last ? nB : cB + (size_t)(t + 2) * kstep;
            const char* a3 = a2 + kstep; const char* b3 = b2 + kstep;
            PG8_LDB(B0, 0, 0); PG8_LDB(B1, 0, 1); PG8_SCHED; PG8_LDA(At, 0, 0); PG8_STAGE(PG8_SA(1, 1), a1 + hstep, voffA);
            PG8_WAIT_V(8); PG8_WAIT_L(0); PG8_BAR; PG8_MMA(0, 0, At, B0); PG8_MMA(0, 1, At, B1); PG8_BAR; PG8_SCHED;
            PG8_LDA(At, 0, 1); PG8_STAGE(PG8_SB(0, 0), b2, voffB); PG8_STAGE(PG8_SB(0, 1), b2 + hstep, voffB); PG8_STAGE(PG8_SA(0, 0), a2, voffA);
            PG8_WAIT_V(8); PG8_WAIT_L(0); PG8_BAR; PG8_MMA(1, 0, At, B0); PG8_MMA(1, 1, At, B1); PG8_BAR; PG8_SCHED;
            PG8_LDB(B0, 1, 0); PG8_LDB(B1, 1, 1); PG8_SCHED; PG8_LDA(At, 1, 0); PG8_STAGE(PG8_SA(0, 1), a2 + hstep, voffA);
            PG8_WAIT_V(8); PG8_WAIT_L(0); PG8_BAR; PG8_MMA(0, 0, At, B0); PG8_MMA(0, 1, At, B1); PG8_BAR; PG8_SCHED;
            PG8_LDA(At, 1, 1); PG8_STAGE(PG8_SB(1, 0), b3, voffB); PG8_STAGE(PG8_SB(1, 1), b3 + hstep, voffB); PG8_STAGE(PG8_SA(1, 0), a3, voffA);
            PG8_WAIT_V(8); PG8_WAIT_L(0); PG8_BAR; PG8_MMA(1, 0, At, B0); PG8_MMA(1, 1, At, B1); PG8_BAR; PG8_SCHED;
        }
        if constexpr (ALIGN_EPI) { if (wr == 0) PG8_BAR; }
        E(acc, cur, wr, wc, fr, fq);
        if (!has_next) break;
#pragma unroll
        for (int a = 0; a < 2; ++a)
#pragma unroll
            for (int b = 0; b < 2; ++b)
#pragma unroll
                for (int m = 0; m < 4; ++m)
#pragma unroll
                    for (int n = 0; n < 2; ++n) acc[a][b][m][n] = (f32x4){0.f, 0.f, 0.f, 0.f};
        cur = nxt; cA = nA; cB = nB; ++ui;
        if constexpr (ALIGN_EPI) { if (wr == 1) PG8_BAR; }
    }
    PG8_WAIT_V(0);
    if constexpr (!ALIGN_EPI) { if (wr == 0) PG8_BAR; }
    PG8_BAR;
#undef PG8_SA
#undef PG8_SB
#undef PG8_STAGE
#undef PG8_LDA
#undef PG8_LDB
#undef PG8_MMA
#undef PG8_WAIT_V
#undef PG8_WAIT_L
#undef PG8_BAR
#undef PG8_SCHED
}
}

struct EpiA {
    static constexpr bool PERM = true;
    bf16_t* qkv; bf16_t* z; int row_off;
    DI void operator()(const f32x4 (&acc)[2][2][4][2], const pg8::Unit& u, int wr, int wc, int fr, int fq) const {
        const int row0 = u.pm * 256 + wr * 64 + fr; const int ct = u.pn * 256 + wc * 32 + 8 * fq;
        bf16_t* base; int ldc, col0;
        if (u.pn < 12) { base = qkv + (size_t)row0 * 3072; ldc = 3072; col0 = ct; } else { base = z + (size_t)(row_off + row0) * 1024; ldc = 1024; col0 = ct - 3072; }
#pragma unroll
        for (int ai = 0; ai < 2; ++ai)
#pragma unroll
            for (int m = 0; m < 4; ++m) { bf16_t* rowp = base + (size_t)(ai * 128 + m * 16) * ldc + col0;
#pragma unroll
                for (int bj = 0; bj < 2; ++bj) { const f32x4 v0 = acc[ai][bj][m][0], v1 = acc[ai][bj][m][1];
                    u32x4 w; w.x = cvtpk(v0[0], v0[1]); w.y = cvtpk(v0[2], v0[3]); w.z = cvtpk(v1[0], v1[1]); w.w = cvtpk(v1[2], v1[3]);
                    *(u32x4*)(rowp + bj * 128) = w; } }
    }
};
template <bool SSQ> struct EpiRes {
    static constexpr bool PERM = false;
    const float* base; float* out; const float* gate  ; float* ssq;
    DI void operator()(const f32x4 (&acc)[2][2][4][2], const pg8::Unit& u, int wr, int wc, int fr, int fq) const {
        const int col0 = u.pn * 256 + wc * 32 + 4 * fq; const int b = (u.pm * 256) >> 12;
        f32x4 gv[2][2];
#pragma unroll
        for (int bj = 0; bj < 2; ++bj)
#pragma unroll
            for (int n = 0; n < 2; ++n) gv[bj][n] = *(const f32x4*)(gate + (size_t)b * 3072 + 2048 + col0 + bj * 128 + n * 16);
#pragma unroll
        for (int ai = 0; ai < 2; ++ai)
#pragma unroll
            for (int m = 0; m < 4; ++m) { const int r = u.pm * 256 + ai * 128 + wr * 64 + m * 16 + fr; const size_t off = (size_t)r * 1024 + col0; float ss = 0.f;
#pragma unroll
                for (int bj = 0; bj < 2; ++bj)
#pragma unroll
                    for (int n = 0; n < 2; ++n) { const f32x4 bs = *(const f32x4*)(base + off + bj * 128 + n * 16); const f32x4 o = bs + gv[bj][n] * acc[ai][bj][m][n];
                        *(f32x4*)(out + off + bj * 128 + n * 16) = o; if (SSQ) ss += (o[0] * o[0] + o[1] * o[1]) + (o[2] * o[2] + o[3] * o[3]); }
                if (SSQ) { ss += __shfl_xor(ss, 16); ss += __shfl_xor(ss, 32); if (fq == 0) ssq[(size_t)(u.pn * 4 + wc) * M + r] = ss; } }
    }
};
struct EpiB {
    static constexpr bool PERM = true;
    bf16_t* kv; bf16_t* projb; float* gates;
    DI void operator()(const f32x4 (&acc)[2][2][4][2], const pg8::Unit& u, int wr, int wc, int fr, int fq) const {
        const int row0 = u.pm * 256 + wr * 64 + fr; const int cw = wc * 32 + 8 * fq;
        if (u.pn == 19) {
#pragma unroll
            for (int ai = 0; ai < 2; ++ai)
#pragma unroll
                for (int m = 0; m < 4; ++m) { float* rowp = gates + (size_t)(row0 + ai * 128 + m * 16) * 48;
                    if (cw < 48) {
#pragma unroll
                        for (int n = 0; n < 2; ++n) { const f32x4 v = acc[ai][0][m][n]; f32x4 o; o[0] = sigm(v[0]); o[1] = sigm(v[1]); o[2] = sigm(v[2]); o[3] = sigm(v[3]); *(f32x4*)(rowp + cw + 4 * n) = o; } } }
            return;
        }
        bf16_t* base; int ldc, col0; float sc = 1.f;
        if (u.pn < 3) { base = kv + (size_t)row0 * 768; ldc = 768; col0 = u.pn * 256 + cw; } else { base = projb + (size_t)row0 * 4096; ldc = 4096; col0 = (u.pn - 3) * 256 + cw; if (u.pn < 7) sc = 0.125f; }
#pragma unroll
        for (int ai = 0; ai < 2; ++ai)
#pragma unroll
            for (int m = 0; m < 4; ++m) { bf16_t* rowp = base + (size_t)(ai * 128 + m * 16) * ldc + col0;
#pragma unroll
                for (int bj = 0; bj < 2; ++bj) { const f32x4 v0 = acc[ai][bj][m][0] * sc, v1 = acc[ai][bj][m][1] * sc;
                    u32x4 w; w.x = cvtpk(v0[0], v0[1]); w.y = cvtpk(v0[2], v0[3]); w.z = cvtpk(v1[0], v1[1]); w.w = cvtpk(v1[2], v1[3]);
                    *(u32x4*)(rowp + bj * 128) = w; } }
    }
};

DI void p0_transpose_item(const float* W, int ld, int col0, int nvalid, int K, bf16_t* WT, int row_off, LAS float* scr, int item, int nblk, int lane) {
    const int kb = item / nblk, nb = item % nblk, k0 = 64 * kb, n0 = 32 * nb;
    const int nn = n0 + (lane & 31);
#pragma unroll 8
    for (int i = 0; i < 32; ++i) { const int kk = 2 * i + (lane >> 5); scr[kk * 33 + (lane & 31)] = (nn < nvalid) ? W[(size_t)(k0 + kk) * ld + col0 + nn] : 0.f; }
    asm volatile("s_waitcnt lgkmcnt(0)" ::: "memory");
    const int c = lane & 7;
#pragma unroll
    for (int j = 0; j < 4; ++j) { const int n = (lane >> 3) + 8 * j; const LAS float* s = scr + (8 * c) * 33 + n;
        u32x4 o; o.x = cvtpk(s[0 * 33], s[1 * 33]); o.y = cvtpk(s[2 * 33], s[3 * 33]); o.z = cvtpk(s[4 * 33], s[5 * 33]); o.w = cvtpk(s[6 * 33], s[7 * 33]);
        *(u32x4*)(WT + (size_t)(row_off + n0 + n) * K + k0 + 8 * c) = o; }
    asm volatile("s_waitcnt lgkmcnt(0)" ::: "memory");
}
DI void p0_prologue(const Params& p, LAS unsigned char* lds) {
    const int tid = otid(), lane = tid & 63, wave = __builtin_amdgcn_readfirstlane(tid >> 6);
    LAS float* scr = (LAS float*)(lds + wave * 8704);
    const int gw = blockIdx.x * 8 + wave, NGW = gridDim.x * 8;
    unsigned char* ws = p.ws;
    constexpr int I_ADA = 1536, I_WA = 16 * 128, I_WAO = 16 * 32, I_KV = 16 * 24, I_WB = 16 * 128, I_WG = 16 * 8, I_WBO = 16 * 32, I_W1 = 32 * 8, I_W2 = 4 * 2, I_C1 = 128;
    constexpr int NITEMS = I_ADA + I_WA + I_WAO + I_KV + I_WB + I_WG + I_WBO + 2 * I_W1 + 2 * I_W2 + I_C1;
    for (int it0 = gw; it0 < NITEMS; it0 += NGW) {
        int r = __builtin_amdgcn_readfirstlane(it0);
        if (r < I_ADA) {
            const int l = r / 768, rem = r % 768, jc = rem / 16, kc = rem % 16;
            const float* c = p.in[1]; const float* w = p.in[3] + (size_t)l * 1024 * 3072;
            float a[8]; for (int b = 0; b < 8; ++b) a[b] = 0.f;
            const int j = jc * 64 + lane;
            for (int kk = 0; kk < 64; ++kk) { const int k = kc * 64 + kk; const float wv = w[(size_t)k * 3072 + j];
#pragma unroll
                for (int b = 0; b < 8; ++b) { const float cv = c[b * 1024 + k]; a[b] += siluf(cv) * wv; } }
            float* modp = (float*)(ws + WS_MODP);
#pragma unroll
            for (int b = 0; b < 8; ++b) modp[(size_t)((kc * 2 + l) * 8 + b) * 3072 + j] = a[b];
            continue;
        }
        r -= I_ADA;
        if (r < I_WA) { p0_transpose_item(p.in[6], A_LD, 0, 4096, 1024, (bf16_t*)(ws + WS_WA), 0, scr, r, 128, lane); continue; } r -= I_WA;
        if (r < I_WAO) { p0_transpose_item(p.in[11], 1024, 0, 1024, 1024, (bf16_t*)(ws + WS_WAO), 0, scr, r, 32, lane); continue; } r -= I_WAO;
        if (r < I_KV) { p0_transpose_item(p.in[13], 768, 0, 768, 1024, (bf16_t*)(ws + WS_WCAT), 0, scr, r, 24, lane); continue; } r -= I_KV;
        if (r < I_WB) { p0_transpose_item(p.in[20], B_LD, 0, 4096, 1024, (bf16_t*)(ws + WS_WCAT), 768, scr, r, 128, lane); continue; } r -= I_WB;
        if (r < I_WG) { p0_transpose_item(p.in[20], B_LD, 4096, 48, 1024, (bf16_t*)(ws + WS_WCAT), 4864, scr, r, 8, lane); continue; } r -= I_WG;
        if (r < I_WBO) { p0_transpose_item(p.in[21], 1024, 0, 1024, 1024, (bf16_t*)(ws + WS_WBO), 0, scr, r, 32, lane); continue; } r -= I_WBO;
        if (r < I_W1) { p0_transpose_item(p.in[16], 256, 0, 256, 2048, (bf16_t*)(ws + WS_W1T), 0, scr, r, 8, lane); continue; } r -= I_W1;
        if (r < I_W1) { p0_transpose_item(p.in[18], 256, 0, 256, 2048, (bf16_t*)(ws + WS_W1T), 256, scr, r, 8, lane); continue; } r -= I_W1;
        if (r < I_W2) { p0_transpose_item(p.in[17], 64, 0, 64, 256, (bf16_t*)(ws + WS_W2T), 0, scr, r, 2, lane); continue; } r -= I_W2;
        if (r < I_W2) { p0_transpose_item(p.in[19], 64, 0, 64, 256, (bf16_t*)(ws + WS_W2T), 64, scr, r, 2, lane); continue; } r -= I_W2;
        {
            const int which = r / 64, rem = r % 64, jc = rem / 16, kc = rem % 16;
            const float* pos = p.in[14 + which]; const float* w1 = p.in[16 + 2 * which];
            const int j = jc * 64 + lane; float a = 0.f;
            for (int kk = 0; kk < 128; ++kk) { const int k = kc * 128 + kk; a += pos[k] * w1[(size_t)k * 256 + j]; }
            ((float*)(ws + WS_C1P))[(kc * 2 + which) * 256 + j] = a;
        }
    }
}

template <int LAYER> DI void norm_rows(const Params& p, LAS unsigned char* lds) {
    const int tid = otid(), lane = tid & 63, wave = __builtin_amdgcn_readfirstlane(tid >> 6);
    unsigned char* ws = p.ws;
    LAS float* gs = (LAS float*)lds;
    LAS float* sh = gs + 1024;
    LAS float* g2 = sh + 1024;
    LAS float* wba = g2 + 1024;
    const float* xin = LAYER == 0 ? p.in[0] : p.out;
    bf16_t* hout = LAYER == 0 ? (bf16_t*)((unsigned char*)p.out + 64 * MiB) : (bf16_t*)(ws + WS_RA);
    bf16_t* sout = (bf16_t*)(ws + WS_S);
    const float* modp = (const float*)(ws + WS_MODP);
    float* mod = (float*)(ws + WS_MOD);
    for (int rb = blockIdx.x; rb < 256; rb += gridDim.x) {
        const int b = rb >> 5;
        __syncthreads();
        for (int k = tid; k < 1024; k += 512) {
            float v[3];
#pragma unroll
            for (int part = 0; part < 3; ++part) { float a = p.in[4][LAYER * 3072 + part * 1024 + k];
                for (int kc = 0; kc < 16; ++kc) a += modp[(size_t)((kc * 2 + LAYER) * 8 + b) * 3072 + part * 1024 + k];
                v[part] = a; if ((rb & 31) == 0) mod[(size_t)(LAYER * 8 + b) * 3072 + part * 1024 + k] = a; }
            gs[k] = p.in[5][LAYER * 1024 + k] * (1.f + v[1]); sh[k] = v[0];
            if (LAYER == 1) g2[k] = p.in[12][k];
        }
        if (LAYER == 0) for (int i = tid; i < 16 * 1024; i += 512) { const int c = i & 15, k = i >> 4; wba[c * 1024 + k] = p.in[6][(size_t)k * A_LD + 4096 + c]; }
        __syncthreads();
        for (int rr = 0; rr < 16; ++rr) {
            const int m = rb * 128 + wave * 16 + rr;
            const f32x4* xr = (const f32x4*)(xin + (size_t)m * 1024) + lane;
            f32x4 v[4]; float s = 0.f;
#pragma unroll
            for (int j = 0; j < 4; ++j) { v[j] = xr[64 * j]; s += (v[j][0] * v[j][0] + v[j][1] * v[j][1]) + (v[j][2] * v[j][2] + v[j][3] * v[j][3]); }
            const float rstd = rsqrtf(wave_sum(s) * (1.f / 1024.f) + EPS);
            f32x4 hv[4];
#pragma unroll
            for (int j = 0; j < 4; ++j) { const f32x4 g4 = *(const LAS f32x4*)(gs + 4 * lane + 256 * j), s4 = *(const LAS f32x4*)(sh + 4 * lane + 256 * j);
                const f32x4 xn = v[j] * rstd; hv[j] = xn * g4 + s4;
                u32x2 o; o.x = cvtpk(hv[j][0], hv[j][1]); o.y = cvtpk(hv[j][2], hv[j][3]);
                *((u32x2*)(hout + (size_t)m * 1024) + lane + 64 * j) = o;
                if (LAYER == 1) { const f32x4 k4 = *(const LAS f32x4*)(g2 + 4 * lane + 256 * j); const f32x4 sv = xn * k4; u32x2 o2; o2.x = cvtpk(sv[0], sv[1]); o2.y = cvtpk(sv[2], sv[3]);
                    *((u32x2*)(sout + (size_t)m * 1024) + lane + 64 * j) = o2; } }
            if (LAYER == 0) {
                float mine = 0.f;
#pragma unroll 2
                for (int c = 0; c < 16; ++c) { float a = 0.f;
#pragma unroll
                    for (int j = 0; j < 4; ++j) { const f32x4 w4 = *(const LAS f32x4*)(wba + c * 1024 + 4 * lane + 256 * j); a += (hv[j][0] * w4[0] + hv[j][1] * w4[1]) + (hv[j][2] * w4[2] + hv[j][3] * w4[3]); }
                    a = wave_sum(a); if (lane == c) mine = a; }
                if (lane < 16) { float o;
                    if (lane < 8) o = sigm(mine);
                    else { const float xx = mine + p.in[9][lane - 8]; const float sp = xx > 20.f ? xx : log1pf(__expf(xx)); o = -__expf(p.in[8][lane - 8]) * sp; }
                    ((float*)(ws + WS_BG))[(size_t)m * 16 + lane] = o; }
            }
        }
    }
}

DI void mm16_acc(float (&acc)[4], const LAS float* X, int px, const LAS float* Y, int py, int c, int q) {
#pragma unroll
    for (int k4 = 0; k4 < 4; ++k4) {
        float y[4];
#pragma unroll
        for (int kk = 0; kk < 4; ++kk) y[kk] = Y[(4 * k4 + kk) * py + c];
#pragma unroll
        for (int rr = 0; rr < 4; ++rr) { const f32x4 xv = *(const LAS f32x4*)(X + (4 * q + rr) * px + 4 * k4);
            acc[rr] += (xv[0] * y[0] + xv[1] * y[1]) + (xv[2] * y[2] + xv[3] * y[3]); }
    }
}
DI void p3_prep(const Params& p, LAS unsigned char* lds, const int half) {
    const int tid = otid(), lane_k = tid & 63, wave = __builtin_amdgcn_readfirstlane(tid >> 6);
    unsigned char* ws = p.ws;
    constexpr int L_CW = 0, L_QS = 6144, L_KS = L_QS + 17408, L_VBT = L_KS + 17408, L_KBGT = L_VBT + 18432, L_KDT = L_KBGT + 18432,
                  L_LM = L_KDT + 18432, L_TM = L_LM + 17408, L_TB = L_TM + 17408, L_PM = L_TB + 9216, L_GC = L_PM + 1280, L_BETA = L_GC + 256, L_SS = L_BETA + 256;
    static_assert(L_SS + 4096 <= LDS_BYTES, "p3 lds");
    LAS float* cw = (LAS float*)(lds + L_CW);
    LAS float* Lm = (LAS float*)(lds + L_LM);
    LAS float* Tm = (LAS float*)(lds + L_TM);
    LAS float* Pm = (LAS float*)(lds + L_PM);
    LAS float* gcs = (LAS float*)(lds + L_GC);
    LAS float* betas = (LAS float*)(lds + L_BETA);
    LAS float* ssp = (LAS float*)(lds + L_SS);
    const bf16_t* qkv = (const bf16_t*)(ws + WS_RA);
    const float* bg = (const float*)(ws + WS_BG);
    for (int g8 = blockIdx.x; g8 < 256; g8 += gridDim.x) {
        const int bl = g8 >> 6, h = (g8 >> 3) & 7, nbase = (g8 & 7) * 8;
        __syncthreads();
        for (int i = tid; i < 3 * 4 * 128; i += 512) { const int X = i / 512, k = (i >> 7) & 3, c = i & 127; cw[i] = p.in[7][(size_t)k * 3072 + X * 1024 + h * 128 + c]; }
        for (int nn = 0; nn < 8; ++nn) {
            int lane = lane_k, r32, hh; asm volatile("" : "+v"(lane));
            r32 = lane & 31; hh = lane >> 5;
            const int tid = wave * 64 + lane;
            const int n = nbase + nn;
            const int bglob = half * 4 + bl;
            const int ug = (bglob * 8 + h) * 64 + n;
            if (wave == 0) {
                const size_t row = (size_t)bglob * 4096 + n * 64 + lane;
                float gv = bg[row * 16 + 8 + h];
#pragma unroll
                for (int o = 1; o < 64; o <<= 1) { const float t = __shfl_up(gv, o); if (lane >= o) gv += t; }
                gcs[lane] = gv; betas[lane] = bg[row * 16 + h];
            }
            __syncthreads();
            const int i = lane, t = n * 64 + i, c0 = 16 * wave;
            float yq[16], yk[16];
            const float beta_i = betas[i], gc_i = gcs[i], gc_last = gcs[63];
#pragma unroll
            for (int X = 0; X < 3; ++X) {
                float a[16];
#pragma unroll
                for (int c = 0; c < 16; ++c) a[c] = 0.f;
#pragma unroll
                for (int k = 0; k < 4; ++k) {
                    const int tt = t - 3 + k;
                    if (tt >= 0) {
                        const bf16_t* src = qkv + ((size_t)bl * 4096 + tt) * 3072 + X * 1024 + h * 128 + c0;
                        const u32x4 lo = *(const u32x4*)src, hi = *(const u32x4*)(src + 8);
                        const LAS float* wk = cw + (X * 4 + k) * 128 + c0;
#pragma unroll
                        for (int e = 0; e < 4; ++e) { a[2 * e] += bflo(lo[e]) * wk[2 * e]; a[2 * e + 1] += bfhi(lo[e]) * wk[2 * e + 1];
                                                      a[8 + 2 * e] += bflo(hi[e]) * wk[8 + 2 * e]; a[8 + 2 * e + 1] += bfhi(hi[e]) * wk[8 + 2 * e + 1]; }
                    }
                }
                float ss = 0.f;
#pragma unroll
                for (int c = 0; c < 16; ++c) { a[c] = siluf(a[c]); ss += a[c] * a[c]; }
                if (X == 0) { for (int c = 0; c < 16; ++c) yq[c] = a[c]; ssp[(0 * 8 + wave) * 64 + i] = ss; }
                else if (X == 1) { for (int c = 0; c < 16; ++c) yk[c] = a[c]; ssp[(1 * 8 + wave) * 64 + i] = ss; }
                else {
                    LAS bf16_t* vbt = (LAS bf16_t*)(lds + L_VBT);
#pragma unroll
                    for (int c = 0; c < 16; ++c) vbt[(c0 + c) * 72 + i] = f2bf(a[c] * beta_i);
                }
            }
            __syncthreads();
            {
                float sq = 0.f, sk = 0.f;
#pragma unroll
                for (int w = 0; w < 8; ++w) { sq += ssp[(0 * 8 + w) * 64 + i]; sk += ssp[(1 * 8 + w) * 64 + i]; }
                const float rq = rsqrtf(sq + EPS) * 0.08838834764831845f, rk = rsqrtf(sk + EPS);
                const float eg = __expf(gc_i), ed = __expf(gc_last - gc_i);
                u32x4 q0, q1, k0, k1, d0, d1;
#pragma unroll
                for (int e = 0; e < 4; ++e) {
                    q0[e] = cvtpk(yq[2 * e] * rq, yq[2 * e + 1] * rq); q1[e] = cvtpk(yq[8 + 2 * e] * rq, yq[8 + 2 * e + 1] * rq);
                    k0[e] = cvtpk(yk[2 * e] * rk, yk[2 * e + 1] * rk); k1[e] = cvtpk(yk[8 + 2 * e] * rk, yk[8 + 2 * e + 1] * rk);
                    d0[e] = cvtpk(yq[2 * e] * rq * eg, yq[2 * e + 1] * rq * eg); d1[e] = cvtpk(yq[8 + 2 * e] * rq * eg, yq[8 + 2 * e + 1] * rq * eg);
                }
                *(LAS u32x4*)(lds + L_QS + i * 272 + c0 * 2) = q0; *(LAS u32x4*)(lds + L_QS + i * 272 + c0 * 2 + 16) = q1;
                *(LAS u32x4*)(lds + L_KS + i * 272 + c0 * 2) = k0; *(LAS u32x4*)(lds + L_KS + i * 272 + c0 * 2 + 16) = k1;
                bf16_t* qd = (bf16_t*)(ws + WS_PQD) + ((size_t)ug * 64 + i) * 128 + c0;
                *(u32x4*)qd = d0; *(u32x4*)(qd + 8) = d1;
                LAS bf16_t* kbgt = (LAS bf16_t*)(lds + L_KBGT); LAS bf16_t* kdt = (LAS bf16_t*)(lds + L_KDT);
                const float fb = rk * beta_i * eg, fd = rk * ed;
#pragma unroll
                for (int c = 0; c < 16; ++c) { kbgt[(c0 + c) * 72 + i] = f2bf(yk[c] * fb); kdt[(c0 + c) * 72 + i] = f2bf(yk[c] * fd); }
            }
            __syncthreads();
            {
                const int which = wave >> 2, mi = (wave >> 1) & 1, ni = wave & 1;
                f32x16 acc = zero16();
                if (!(mi == 0 && ni == 1)) {
                    const LAS unsigned char* ab = lds + (which ? L_QS : L_KS) + (32 * mi + r32) * 272 + hh * 16;
                    const LAS unsigned char* bb = lds + L_KS + (32 * ni + r32) * 272 + hh * 16;
#pragma unroll
                    for (int ks = 0; ks < 8; ++ks) acc = MFMA32(lds128(ab + ks * 32), lds128(bb + ks * 32), acc);
                }
                const int j = 32 * ni + r32; const float gcj = gcs[j];
                bf16_t* at = (bf16_t*)(ws + WS_PAT) + (size_t)ug * 4096;
#pragma unroll
                for (int reg = 0; reg < 16; ++reg) {
                    const int ii = 32 * mi + crow(reg, hh);
                    const float dec = (ii >= j) ? __expf(gcs[ii] - gcj) : 0.f;
                    if (which == 0) Lm[ii * 68 + j] = (ii > j) ? betas[ii] * acc[reg] * dec : 0.f;
                    else at[ii * 64 + j] = f2bf(acc[reg] * dec);
                }
            }
            __syncthreads();
            if (wave == 0) {
                const int a = lane >> 4, c = lane & 15;
                {
                    float tt[16];
#pragma unroll
                    for (int ii = 0; ii < 16; ++ii) {
                        float s = 0.f;
#pragma unroll
                        for (int k = 0; k < ii; ++k) s += Lm[(16 * a + ii) * 68 + 16 * a + k] * tt[k];
                        tt[ii] = (ii == c ? 1.f : 0.f) - s;
                    }
#pragma unroll
                    for (int ii = 0; ii < 16; ++ii) Tm[(16 * a + ii) * 68 + 16 * a + c] = tt[ii];
                }
                const int q = lane >> 4;
#pragma unroll
                for (int d = 1; d < 4; ++d)
#pragma unroll
                    for (int aa = d; aa < 4; ++aa) {
                        const int bb = aa - d;
                        float acc[4] = {0.f, 0.f, 0.f, 0.f};
                        for (int cc = bb; cc < aa; ++cc) mm16_acc(acc, Lm + (16 * aa) * 68 + 16 * cc, 68, Tm + (16 * cc) * 68 + 16 * bb, 68, c, q);
#pragma unroll
                        for (int rr = 0; rr < 4; ++rr) Pm[(4 * q + rr) * 20 + c] = acc[rr];
                        float acc2[4] = {0.f, 0.f, 0.f, 0.f};
                        mm16_acc(acc2, Tm + (16 * aa) * 68 + 16 * aa, 68, Pm, 20, c, q);
#pragma unroll
                        for (int rr = 0; rr < 4; ++rr) Tm[(16 * aa + 4 * q + rr) * 68 + 16 * bb + c] = -acc2[rr];
                    }
            } else {
                bf16_t* dst = (bf16_t*)(ws + WS_PKDT) + (size_t)ug * 8192;
                for (int ci = tid - 64; ci < 1024; ci += 448) { const int row = ci >> 3, ch = ci & 7;
                    *(u32x4*)(dst + row * 64 + ch * 8) = *(const LAS u32x4*)(lds + L_KDT + row * 144 + ch * 16); }
                if (tid == 64) ((float*)(ws + WS_GL))[ug] = __expf(gcs[63]);
            }
            __syncthreads();
            for (int e = tid; e < 4096; e += 512) { const int ii = e >> 6, j = e & 63;
                *(LAS bf16_t*)(lds + L_TB + ii * 144 + j * 2) = ((j >> 4) > (ii >> 4)) ? (bf16_t)0 : f2bf(Tm[ii * 68 + j]); }
            __syncthreads();
            {
                const int mat = wave >> 2, nb = wave & 3;
                const LAS unsigned char* bb = lds + (mat ? L_KBGT : L_VBT) + (32 * nb + r32) * 144 + hh * 16;
#pragma unroll
                for (int mi = 0; mi < 2; ++mi) {
                    f32x16 acc = zero16();
                    const LAS unsigned char* ab = lds + L_TB + (32 * mi + r32) * 144 + hh * 16;
#pragma unroll
                    for (int ks = 0; ks < 4; ++ks) if (mi == 1 || ks < 2) acc = MFMA32(lds128(ab + ks * 32), lds128(bb + ks * 32), acc);
                    if (mat == 0) {
                        bf16_t* up = (bf16_t*)(ws + WS_PU) + ((((size_t)ug * 4 + nb) * 2 + mi) * 64 + lane) * 16;
                        u32x4 o0, o1;
#pragma unroll
                        for (int e = 0; e < 4; ++e) { o0[e] = cvtpk(acc[2 * e], acc[2 * e + 1]); o1[e] = cvtpk(acc[8 + 2 * e], acc[8 + 2 * e + 1]); }
                        *(u32x4*)up = o0; *(u32x4*)(up + 8) = o1;
                    } else {
                        bf16_t* wp = (bf16_t*)(ws + WS_PW) + (size_t)ug * 8192;
#pragma unroll
                        for (int reg = 0; reg < 16; ++reg) wp[(32 * mi + crow(reg, hh)) * 128 + 32 * nb + r32] = f2bf(acc[reg]);
                    }
                }
            }
            __syncthreads();
        }
    }
}

DI void p4_scan(const Params& p, LAS unsigned char* lds) {
    const int tid = otid(), lane = tid & 63, wave = __builtin_amdgcn_readfirstlane(tid >> 6);
    const int r32 = lane & 31, hh = lane >> 5;
    unsigned char* ws = p.ws;
    constexpr int ST = 59904, S_W = 0, S_QD = 16896, S_KDT = 33792, S_AT = 51200, L_OS = 2 * ST, OSB = 16896;
    static_assert(L_OS + 2 * OSB <= LDS_BYTES, "p4 lds");
    for (int bh = blockIdx.x; bh < 64; bh += gridDim.x) {
        const int b = bh >> 3, h = bh & 7;
        __syncthreads();
        if (wave >= 4) {
            const int lt = tid - 256;
            u32x4 rg[14];
            auto issue = [&](int n) {
                const size_t ug = (size_t)bh * 64 + n;
                const bf16_t* pw = (const bf16_t*)(ws + WS_PW) + ug * 8192; const bf16_t* pq = (const bf16_t*)(ws + WS_PQD) + ug * 8192;
                const bf16_t* pk = (const bf16_t*)(ws + WS_PKDT) + ug * 8192; const bf16_t* pa = (const bf16_t*)(ws + WS_PAT) + ug * 4096;
#pragma unroll
                for (int k = 0; k < 4; ++k) { const int ci = lt + 256 * k; rg[k] = *(const u32x4*)(pw + ci * 8); rg[4 + k] = *(const u32x4*)(pq + ci * 8); rg[8 + k] = *(const u32x4*)(pk + ci * 8); }
#pragma unroll
                for (int k = 0; k < 2; ++k) { const int ci = lt + 256 * k; rg[12 + k] = *(const u32x4*)(pa + ci * 8); }
            };
            auto commit = [&](int st) {
                LAS unsigned char* sb = lds + st * ST;
#pragma unroll
                for (int k = 0; k < 4; ++k) { const int ci = lt + 256 * k; const int row = ci >> 4, ch = ci & 15;
                    LAS u32x2* d0 = (LAS u32x2*)(sb + S_W + row * 264 + ch * 16); d0[0] = (u32x2){rg[k][0], rg[k][1]}; d0[1] = (u32x2){rg[k][2], rg[k][3]};
                    LAS u32x2* d1 = (LAS u32x2*)(sb + S_QD + row * 264 + ch * 16); d1[0] = (u32x2){rg[4 + k][0], rg[4 + k][1]}; d1[1] = (u32x2){rg[4 + k][2], rg[4 + k][3]};
                    const int row2 = ci >> 3, ch2 = ci & 7;
                    LAS u32x2* d2 = (LAS u32x2*)(sb + S_KDT + row2 * 136 + ch2 * 16); d2[0] = (u32x2){rg[8 + k][0], rg[8 + k][1]}; d2[1] = (u32x2){rg[8 + k][2], rg[8 + k][3]}; }
#pragma unroll
                for (int k = 0; k < 2; ++k) { const int ci = lt + 256 * k; const int row2 = ci >> 3, ch2 = ci & 7;
                    LAS u32x2* d3 = (LAS u32x2*)(sb + S_AT + row2 * 136 + ch2 * 16); d3[0] = (u32x2){rg[12 + k][0], rg[12 + k][1]}; d3[1] = (u32x2){rg[12 + k][2], rg[12 + k][3]}; }
            };
            issue(0); commit(0);
            __syncthreads();
            for (int n = 0; n <= 64; ++n) {
                if (n + 1 < 64) issue(n + 1);
                if (n >= 1) {
                    const int mstep = n - 1, row = lt >> 2, part = lt & 3;
                    const LAS unsigned char* ob = lds + L_OS + (mstep & 1) * OSB + row * 264 + part * 64;
                    float o[32]; float ss = 0.f;
#pragma unroll
                    for (int e = 0; e < 8; ++e) { const u32x2 v = *(const LAS u32x2*)(ob + e * 8); o[4 * e] = bflo(v[0]); o[4 * e + 1] = bfhi(v[0]); o[4 * e + 2] = bflo(v[1]); o[4 * e + 3] = bfhi(v[1]); }
#pragma unroll
                    for (int e = 0; e < 32; ++e) ss += o[e] * o[e];
                    ss += __shfl_xor(ss, 1); ss += __shfl_xor(ss, 2);
                    const float rstd = rsqrtf(ss * (1.f / 128.f) + EPS);
                    const size_t tok = (size_t)b * 4096 + mstep * 64 + row;
                    const bf16_t* zp = (const bf16_t*)p.out + tok * 1024 + h * 128 + part * 32;
                    bf16_t* yp = (bf16_t*)(ws + WS_RA) + tok * 1024 + h * 128 + part * 32;
                    const float* og = p.in[10] + part * 32;
#pragma unroll
                    for (int e = 0; e < 4; ++e) { const u32x4 zv = *(const u32x4*)(zp + 8 * e); u32x4 yo;
#pragma unroll
                        for (int f = 0; f < 4; ++f) { const float z0 = bflo(zv[f]), z1 = bfhi(zv[f]);
                            yo[f] = cvtpk(o[8 * e + 2 * f] * rstd * og[8 * e + 2 * f] * siluf(z0), o[8 * e + 2 * f + 1] * rstd * og[8 * e + 2 * f + 1] * siluf(z1)); }
                        *(u32x4*)(yp + 8 * e) = yo; }
                }
                if (n + 1 < 64) commit((n + 1) & 1);
                __syncthreads();
            }
        } else {
            const int sl = wave;
            f32x16 Sacc[4]; for (int kb = 0; kb < 4; ++kb) Sacc[kb] = zero16();
            u32x4 un[2][2]; float gln;
            auto uload = [&](int n) { const size_t ug = (size_t)bh * 64 + n;
                const bf16_t* up = (const bf16_t*)(ws + WS_PU) + (((ug * 4 + sl) * 2) * 64 + lane) * 16;
                un[0][0] = *(const u32x4*)up; un[0][1] = *(const u32x4*)(up + 8); un[1][0] = *(const u32x4*)(up + 1024); un[1][1] = *(const u32x4*)(up + 1032);
                gln = ((const float*)(ws + WS_GL))[ug]; };
            uload(0);
            __syncthreads();
            for (int n = 0; n <= 64; ++n) {
                if (n < 64) {
                    const LAS unsigned char* sb = lds + (n & 1) * ST;
                    u32x4 uc[2][2]; uc[0][0] = un[0][0]; uc[0][1] = un[0][1]; uc[1][0] = un[1][0]; uc[1][1] = un[1][1]; const float gl = gln;
                    if (n + 1 < 64) uload(n + 1);
                    f32x16 vacc[2], qacc[2];
                    vacc[0] = zero16(); vacc[1] = zero16(); qacc[0] = zero16(); qacc[1] = zero16();
                    {
                        const LAS unsigned char* wrow = sb + S_W + r32 * 264 + hh * 8;
                        const LAS unsigned char* qrow = sb + S_QD + r32 * 264 + hh * 8;
#pragma unroll
                        for (int kb = 0; kb < 4; ++kb)
#pragma unroll
                            for (int s2 = 0; s2 < 2; ++s2) {
                                const int ks = 2 * kb + s2;
                                const bf16x8 Sb = pack8(Sacc[kb], s2);
#pragma unroll
                                for (int mi = 0; mi < 2; ++mi) {
                                    vacc[mi] = MFMA32(lds2x64(wrow + mi * 32 * 264 + ks * 32, wrow + mi * 32 * 264 + ks * 32 + 16), Sb, vacc[mi]);
                                    qacc[mi] = MFMA32(lds2x64(qrow + mi * 32 * 264 + ks * 32, qrow + mi * 32 * 264 + ks * 32 + 16), Sb, qacc[mi]);
                                }
                            }
                    }
                    __builtin_amdgcn_sched_barrier(0);
                    bf16x8 Vb[4];
#pragma unroll
                    for (int mi = 0; mi < 2; ++mi) { f32x16 vn;
#pragma unroll
                        for (int e = 0; e < 4; ++e) { vn[2 * e] = bflo(uc[mi][0][e]) - vacc[mi][2 * e]; vn[2 * e + 1] = bfhi(uc[mi][0][e]) - vacc[mi][2 * e + 1];
                                                      vn[8 + 2 * e] = bflo(uc[mi][1][e]) - vacc[mi][8 + 2 * e]; vn[8 + 2 * e + 1] = bfhi(uc[mi][1][e]) - vacc[mi][8 + 2 * e + 1]; }
                        Vb[2 * mi] = pack8(vn, 0); Vb[2 * mi + 1] = pack8(vn, 1); }
#pragma unroll
                    for (int mo = 0; mo < 2; ++mo) {
                        const LAS unsigned char* arow = sb + S_AT + (32 * mo + r32) * 136 + hh * 8;
#pragma unroll
                        for (int ks = 0; ks < 4; ++ks) if (ks < 2 * (mo + 1)) qacc[mo] = MFMA32(lds2x64(arow + ks * 32, arow + ks * 32 + 16), Vb[ks], qacc[mo]);
                        LAS bf16_t* ob = (LAS bf16_t*)(lds + L_OS + (n & 1) * OSB);
#pragma unroll
                        for (int reg = 0; reg < 16; ++reg) ob[(32 * mo + crow(reg, hh)) * 132 + 32 * sl + r32] = f2bf(qacc[mo][reg]);
                    }
#pragma unroll
                    for (int kb = 0; kb < 4; ++kb) {
                        const LAS unsigned char* krow = sb + S_KDT + (32 * kb + r32) * 136 + hh * 8;
                        f32x16 sn = Sacc[kb] * gl;
#pragma unroll
                        for (int ks = 0; ks < 4; ++ks) sn = MFMA32(lds2x64(krow + ks * 32, krow + ks * 32 + 16), Vb[ks], sn);
                        Sacc[kb] = sn;
                    }
                }
                __syncthreads();
            }
        }
    }
}

DI void p8_compress(const Params& p, LAS unsigned char* lds) {
    const int tid = otid(), lane = tid & 63, wave = __builtin_amdgcn_readfirstlane(tid >> 6);
    const int r32 = lane & 31, hh = lane >> 5;
    unsigned char* ws = p.ws;
    constexpr int L_AS = 0  , L_BS = 4608  , L_HS = L_BS + 36864  , L_C1 = L_HS + 16896  ;
    const bf16_t* kv = (const bf16_t*)(ws + WS_KV);
    for (int u = blockIdx.x; u < 256; u += gridDim.x) {
        const int which = u >> 7, bg = (u >> 3) & 15, nb = u & 7, b = bg >> 1, g = bg & 1;
        __syncthreads();
        if (tid < 256) { float a = 0.f; for (int kc = 0; kc < 16; ++kc) a += ((const float*)(ws + WS_C1P))[(kc * 2 + which) * 256 + tid]; ((LAS float*)(lds + L_C1))[tid] = a; }
        const bf16_t* w1t = (const bf16_t*)(ws + WS_W1T) + (size_t)which * 256 * 2048;
        f32x16 acc = zero16();
        for (int l = 0; l < 32; ++l) {
            __syncthreads();
            if (tid < 256) { const int row = tid >> 3, ch = tid & 7; int tk = 16 * (32 * nb + row) + l; tk = tk > 4095 ? 4095 : tk;
                *(LAS u32x4*)(lds + L_AS + row * 144 + ch * 16) = *(const u32x4*)(kv + ((size_t)b * 4096 + tk) * 768 + which * 128 + g * 64 + ch * 8); }
#pragma unroll
            for (int k = 0; k < 4; ++k) { const int ci = tid + 512 * k; const int row = ci >> 3, ch = ci & 7;
                *(LAS u32x4*)(lds + L_BS + row * 144 + ch * 16) = *(const u32x4*)(w1t + (size_t)row * 2048 + l * 64 + ch * 8); }
            __syncthreads();
            const LAS unsigned char* ab = lds + L_AS + r32 * 144 + hh * 16;
            const LAS unsigned char* bb = lds + L_BS + (32 * wave + r32) * 144 + hh * 16;
#pragma unroll
            for (int ks = 0; ks < 4; ++ks) acc = MFMA32(lds128(ab + ks * 32), lds128(bb + ks * 32), acc);
        }
        {
            const float c1 = ((LAS float*)(lds + L_C1))[32 * wave + r32];
#pragma unroll
            for (int reg = 0; reg < 16; ++reg) *(LAS bf16_t*)(lds + L_HS + crow(reg, hh) * 528 + (32 * wave + r32) * 2) = f2bf(siluf(acc[reg] + c1));
        }
        __syncthreads();
        if (wave < 2) {
            const bf16_t* w2t = (const bf16_t*)(ws + WS_W2T) + (size_t)(which * 64 + 32 * wave + r32) * 256 + hh * 8;
            const LAS unsigned char* ab = lds + L_HS + r32 * 528 + hh * 16;
            f32x16 o = zero16();
#pragma unroll
            for (int ks = 0; ks < 16; ++ks) o = MFMA32(lds128(ab + ks * 32), *(const bf16x8*)(w2t + ks * 16), o);
            bf16_t* dst = (bf16_t*)(ws + WS_CMP) + (size_t)(which * 16 + bg) * 256 * 64;
#pragma unroll
            for (int reg = 0; reg < 16; ++reg) { const int n = 32 * nb + crow(reg, hh); dst[n * 64 + 32 * wave + r32] = (n < 255) ? f2bf(o[reg]) : (bf16_t)0; }
        }
    }
}

__device__ const unsigned char T5_BUCKET[128] = {0, 1, 2, 3, 4, 5, 6, 7, 8, 9, 10, 11, 12, 13, 14, 15, 16, 16, 16, 17, 17, 18, 18, 18, 19, 19, 19, 20, 20, 20, 20, 21, 21, 21, 21, 22, 22, 22, 22, 22, 23, 23, 23, 23, 23, 23, 24, 24, 24, 24, 24, 24, 25, 25, 25, 25, 25, 25, 25, 26, 26, 26, 26, 26, 26, 26, 26, 27, 27, 27, 27, 27, 27, 27, 27, 27, 27, 28, 28, 28, 28, 28, 28, 28, 28, 28, 28, 29, 29, 29, 29, 29, 29, 29, 29, 29, 29, 29, 29, 30, 30, 30, 30, 30, 30, 30, 30, 30, 30, 30, 30, 30, 30, 31, 31, 31, 31, 31, 31, 31, 31, 31, 31, 31, 31, 31, 31, 31};
constexpr float NEGBIG = -1e30f;

DI void p9_nsa(const Params& p, LAS unsigned char* lds) {
    const int tid0 = otid(); const int lane_k = tid0 & 63, wave = __builtin_amdgcn_readfirstlane(tid0 >> 6);
    unsigned char* ws = p.ws;
    constexpr int STG = 17920, L_K = 0, L_V = 9216, L_BT = 2 * STG, L_IA = L_BT + 4096, L_IB = L_IA + 8192, L_Y = L_IB + 8704;
    static_assert(L_Y + 65536 <= LDS_BYTES, "p9 lds");
    LAS float* YL = (LAS float*)(lds + L_Y) + wave * 2048;
    LAS float* BT = (LAS float*)(lds + L_BT);
    LAS float* IA = (LAS float*)(lds + L_IA) + wave * 256;
    LAS float* IB = (LAS float*)(lds + L_IB) + wave * 272;
    const bf16_t* kvb = (const bf16_t*)(ws + WS_KV);
    const bf16_t* cmpb = (const bf16_t*)(ws + WS_CMP);
    const bf16_t* projb = (const bf16_t*)(ws + WS_PROJB);
    const float* gates = (const float*)(ws + WS_GATES);
    const float* relb = p.in[2];
    for (int vc = blockIdx.x; vc < 256; vc += gridDim.x) {
        const int bg = vc >> 4, kk16 = vc & 15, b = bg >> 1, g = bg & 1;
        for (int ju = 0; ju < 8; ++ju) {
            int lane = lane_k; asm volatile("" : "+v"(lane));
            const int tid = wave * 64 + lane, r32 = lane & 31, hh = lane >> 5, tok = r32 >> 3, hd = r32 & 7;
            const int srow = tid >> 3, sch = tid & 7;
            const int ub = (ju & 1) ? (32 * (ju >> 1) + 31 - kk16) : (32 * (ju >> 1) + kk16);
            const int t0 = 32 * ub, cur = ub >> 1;
            const int tq = t0 + 4 * wave + tok, head = g * 8 + hd;
            const size_t trow = (size_t)b * 4096 + tq;
            __syncthreads();
            for (int idx = tid; idx < 1024; idx += 512) BT[idx] = relb[(int)T5_BUCKET[idx & 127] * 16 + g * 8 + (idx >> 7)];
            for (int idx = lane; idx < 256; idx += 64) IA[idx] = 0.f;
            for (int idx = lane; idx < 272; idx += 64) IB[idx] = 0.f;
            const float bfar = relb[31 * 16 + head];
            bf16x8 Qf[4];
#pragma unroll
            for (int ks = 0; ks < 4; ++ks) Qf[ks] = *(const bf16x8*)(projb + trow * 4096 + head * 64 + 16 * ks + 8 * hh);
            const int nct = (ub >> 5) + 1;
            const int wlo = (t0 - 511) > 0 ? ((t0 - 511) >> 6) : 0;
            const int nwin = cur - wlo + 1;
            const int NT = 2 * nct + (cur + 1) + nwin;
            u32x4 kreg, vreg;
            auto tload = [&](int i) {
                const bf16_t *kp, *vp; int stride;
                if (i < 2 * nct) { const int ti = i < nct ? i : i - nct; kp = cmpb + ((size_t)(0 * 16 + bg) * 256 + 64 * ti) * 64; vp = cmpb + ((size_t)(1 * 16 + bg) * 256 + 64 * ti) * 64; stride = 64; }
                else if (i < 2 * nct + cur + 1) { const int s = i - 2 * nct; kp = kvb + ((size_t)b * 4096 + 64 * s) * 768 + 256 + g * 64; vp = kp + 128; stride = 768; }
                else { const int blk = cur - (i - 2 * nct - cur - 1); kp = kvb + ((size_t)b * 4096 + 64 * blk) * 768 + 512 + g * 64; vp = kp + 128; stride = 768; }
                kreg = *(const u32x4*)(kp + (size_t)srow * stride + sch * 8); vreg = *(const u32x4*)(vp + (size_t)srow * stride + sch * 8);
            };
            auto twrite = [&](int st) {
                *(LAS u32x4*)(lds + st * STG + L_K + srow * 144 + sch * 16) = kreg;
                LAS bf16_t* vt = (LAS bf16_t*)(lds + st * STG + L_V);
#pragma unroll
                for (int e = 0; e < 4; ++e) { vt[(8 * sch + 2 * e) * 68 + srow] = (bf16_t)(vreg[e] & 0xffffu); vt[(8 * sch + 2 * e + 1) * 68 + srow] = (bf16_t)(vreg[e] >> 16); }
            };
            tload(0); twrite(0);
            __syncthreads();
            float m_run = NEGBIG, l_run = 0.f, m_c = NEGBIG, linv_c = 0.f;
            f32x16 O[2]; O[0] = zero16(); O[1] = zero16();
            unsigned long long mymask = 0ull, wmask = 0ull;
            auto finalize = [&](int br, bool normalized) {
                float inv = 1.f;
                if (!normalized) { const float L = l_run + __shfl_xor(l_run, 32); inv = 1.f / fmaxf(L, 1e-30f); }
                const float gt = gates[trow * 48 + br * 16 + head] * inv;
                const bf16_t* zp = projb + trow * 4096 + 1024 + br * 1024 + head * 64;
#pragma unroll
                for (int db = 0; db < 2; ++db)
#pragma unroll
                    for (int gi = 0; gi < 4; ++gi) { const u32x2 zv = *(const u32x2*)(zp + 32 * db + 8 * gi + 4 * hh);
                        LAS float* yl = YL + (db * 16 + 4 * gi) * 64 + lane;
                        const float c0 = gt * O[db][4 * gi + 0] * siluf(bflo(zv[0])), c1 = gt * O[db][4 * gi + 1] * siluf(bfhi(zv[0]));
                        const float c2 = gt * O[db][4 * gi + 2] * siluf(bflo(zv[1])), c3 = gt * O[db][4 * gi + 3] * siluf(bfhi(zv[1]));
                        if (br == 0) { yl[0] = c0; yl[64] = c1; yl[128] = c2; yl[192] = c3; }
                        else { yl[0] += c0; yl[64] += c1; yl[128] += c2; yl[192] += c3; } }
                O[0] = zero16(); O[1] = zero16(); m_run = NEGBIG; l_run = 0.f;
            };
            auto tile_body = [&](auto KT, const int i, const int tix) {
                constexpr int kind = decltype(KT)::value;
                if (i + 1 < NT) tload(i + 1);
                const LAS unsigned char* sb = lds + (i & 1) * STG;
                const bool skip = (kind == 2) && (((wmask >> tix) & 1ull) == 0ull);
                if (!skip) {
                    f32x16 st[2];
#pragma unroll
                    for (int kb = 0; kb < 2; ++kb) { st[kb] = zero16();
                        const LAS unsigned char* kr = sb + L_K + (32 * kb + r32) * 144 + hh * 16;
#pragma unroll
                        for (int ks = 0; ks < 4; ++ks) st[kb] = MFMA32(lds128(kr + ks * 32), Qf[ks], st[kb]); }
                    __builtin_amdgcn_sched_barrier(0);
                    const bool selected = (kind != 2) || (((mymask >> tix) & 1ull) != 0ull);
                    float mx = NEGBIG;
                    int dbase = (kind <= 1) ? (tq - 31 - 1024 * tix - 64 * hh) : (tq - 64 * tix - 4 * hh);
                    asm volatile("" : "+v"(dbase));
                    constexpr int dmul = (kind <= 1) ? 16 : 1;
                    constexpr int dlim = (kind == 3) ? 512 : 0x7fffffff;
                    const LAS float* btl = BT + hd * 128;
#pragma unroll
                    for (int kb = 0; kb < 2; ++kb)
#pragma unroll
                        for (int reg = 0; reg < 16; ++reg) {
                            const int dist = dbase - dmul * (32 * kb + (reg & 3) + 8 * (reg >> 2));
                            const bool valid = (dist >= 0) && selected && (dist < dlim);
                            const int di = dist < 0 ? 0 : (dist > 127 ? 127 : dist);
                            const float bias = dist < 128 ? btl[di] : bfar;
                            const float sv = valid ? st[kb][reg] + bias : NEGBIG;
                            st[kb][reg] = sv; mx = fmaxf(mx, sv);
                        }
                    if constexpr (kind != 1) {
                        mx = fmaxf(mx, __shfl_xor(mx, 32));
                        const float mnew = fmaxf(m_run, mx);
                        const float alpha = __expf(m_run - mnew);
                        float ls = 0.f;
#pragma unroll
                        for (int kb = 0; kb < 2; ++kb)
#pragma unroll
                            for (int reg = 0; reg < 16; ++reg) { const float sv = st[kb][reg]; const float pe = (sv > -1e29f) ? __expf(sv - mnew) : 0.f; st[kb][reg] = pe; ls += pe; }
                        l_run = l_run * alpha + ls; m_run = mnew;
                        if constexpr (kind != 0) { O[0] = O[0] * alpha; O[1] = O[1] * alpha; }
                    } else {
#pragma unroll
                        for (int kb = 0; kb < 2; ++kb) {
#pragma unroll
                            for (int reg = 0; reg < 16; ++reg) { const float sv = st[kb][reg]; st[kb][reg] = (sv > -1e29f) ? __expf(sv - m_c) * linv_c : 0.f; }
#pragma unroll
                            for (int gi = 0; gi < 4; ++gi) {
                                float a = 2.f * (st[kb][4 * gi] + st[kb][4 * gi + 1] + st[kb][4 * gi + 2]) + st[kb][4 * gi + 3], bq = st[kb][4 * gi + 3];
                                a += __shfl_xor(a, 1); a += __shfl_xor(a, 2); a += __shfl_xor(a, 4);
                                bq += __shfl_xor(bq, 1); bq += __shfl_xor(bq, 2); bq += __shfl_xor(bq, 4);
                                const int sidx = 16 * tix + 8 * kb + 2 * gi + hh;
                                if (hd == 0) { IA[tok * 64 + sidx] = a; IB[tok * 68 + sidx + 1] = bq; }
                            }
                        }
                    }
                    __builtin_amdgcn_sched_barrier(0);
                    if constexpr (kind != 0) {
                        bf16x8 Pf[4];
#pragma unroll
                        for (int kb = 0; kb < 2; ++kb) { Pf[2 * kb] = pack8(st[kb], 0); Pf[2 * kb + 1] = pack8(st[kb], 1); }
#pragma unroll
                        for (int db = 0; db < 2; ++db) {
                            const LAS unsigned char* vr = sb + L_V + (32 * db + r32) * 136 + hh * 8;
#pragma unroll
                            for (int ks = 0; ks < 4; ++ks) O[db] = MFMA32(lds2x64(vr + ks * 32, vr + ks * 32 + 16), Pf[ks], O[db]);
                            __builtin_amdgcn_sched_barrier(0);
                        }
                    }
                }
                if (i + 1 < NT) twrite((i + 1) & 1);
                __syncthreads();
            };
            int ti = 0;
#pragma unroll 1
            for (int t = 0; t < nct; ++t, ++ti) tile_body(std::integral_constant<int, 0>{}, ti, t);
            { const float L = l_run + __shfl_xor(l_run, 32); m_c = m_run; linv_c = 1.f / fmaxf(L, 1e-30f); m_run = NEGBIG; l_run = 0.f; }
#pragma unroll 1
            for (int t = 0; t < nct; ++t, ++ti) tile_body(std::integral_constant<int, 1>{}, ti, t);
            finalize(0, true);
            {
                wmask = 0ull; mymask = 0ull;
#pragma unroll 1
                for (int tk = 0; tk < 4; ++tk) {
                    float v = IA[tk * 64 + lane] + IB[tk * 68 + lane];
                    if (lane == 0 || lane == cur || lane == cur - 1) v = 1e9f; else if (lane > cur) v = -1e9f;
                    int rank = 0;
#pragma unroll 8
                    for (int j = 0; j < 64; ++j) { const float vj = __shfl(v, j); rank += ((vj > v) || (vj == v && j < lane)) ? 1 : 0; }
                    const unsigned long long mk = __ballot(rank < 16);
                    wmask |= mk; if (tok == tk) mymask = mk;
                }
            }
#pragma unroll 1
            for (int t = 0; t <= cur; ++t, ++ti) tile_body(std::integral_constant<int, 2>{}, ti, t);
            finalize(1, false);
#pragma unroll 1
            for (int t = 0; t < nwin; ++t, ++ti) tile_body(std::integral_constant<int, 3>{}, ti, cur - t);
            finalize(2, false);
            bf16_t* yp = (bf16_t*)(ws + WS_RA) + trow * 1024 + head * 64;
#pragma unroll
            for (int db = 0; db < 2; ++db)
#pragma unroll
                for (int gi = 0; gi < 4; ++gi) { const LAS float* yl = YL + (db * 16 + 4 * gi) * 64 + lane; u32x2 o; o.x = cvtpk(yl[0], yl[64]); o.y = cvtpk(yl[128], yl[192]);
                    *(u32x2*)(yp + 32 * db + 8 * gi + 4 * hh) = o; }
        }
    }
}

DI void p11_final(const Params& p) {
    const int tid = otid(), lane = tid & 63, wave = tid >> 6;
    const float* ssq = (const float*)(p.ws + WS_SSQ);
    for (int m = blockIdx.x * 8 + wave; m < M; m += gridDim.x * 8) {
        float s = 0.f;
#pragma unroll
        for (int j = 0; j < 16; ++j) s += ssq[(size_t)j * M + m];
        const float rstd = rsqrtf(s * (1.f / 1024.f) + EPS);
        f32x4* xr = (f32x4*)(p.out + (size_t)m * 1024) + lane;
#pragma unroll
        for (int j = 0; j < 4; ++j) { const f32x4 g4 = *((const f32x4*)p.in[22] + lane + 64 * j); xr[64 * j] = xr[64 * j] * rstd * g4; }
    }
}

template <int PH> DI void run_phase(const Params& p, LAS unsigned char* lds) {
    unsigned char* ws = p.ws;
    const int G = gridDim.x;
    bf16_t* h0 = (bf16_t*)((unsigned char*)p.out + 64 * MiB);
    if constexpr (PH == 0) p0_prologue(p, lds);
    if constexpr (PH == 1) norm_rows<0>(p, lds);
    if constexpr (PH == 2 || PH == 4) {
        constexpr int half = (PH - 2) / 2;
        pg8::Gemm g{h0, h0 + (size_t)half * 16384 * 1024, 0, (const bf16_t*)(ws + WS_WA), 16384, 4096, 1024}; pg8::StaticOrder S; S.init(16384, 4096, G, (int)blockIdx.x);
        EpiA E{(bf16_t*)(ws + WS_RA), (bf16_t*)p.out, half * 16384};
        pg8::gemm_phase<EpiA, true>(lds, g, S, E);
    }
    if constexpr (PH == 3 || PH == 5) p3_prep(p, lds, (PH - 3) / 2);
    if constexpr (PH == 6) p4_scan(p, lds);
    if constexpr (PH == 7) {
        const bf16_t* ya = (const bf16_t*)(ws + WS_RA);
        pg8::Gemm g{ya, ya, 0, (const bf16_t*)(ws + WS_WAO), M, 1024, 1024}; pg8::StaticOrder S; S.init(M, 1024, G, (int)blockIdx.x);
        EpiRes<false> E{p.in[0], p.out, (const float*)(ws + WS_MOD), nullptr};
        pg8::gemm_phase<EpiRes<false>, true>(lds, g, S, E);
    }
    if constexpr (PH == 8) norm_rows<1>(p, lds);
    if constexpr (PH == 9) {
        pg8::Gemm g{(const bf16_t*)(ws + WS_S), (const bf16_t*)(ws + WS_RA), 3, (const bf16_t*)(ws + WS_WCAT), M, 5120, 1024}; pg8::StaticOrder S; S.init(M, 5120, G, (int)blockIdx.x);
        EpiB E{(bf16_t*)(ws + WS_KV), (bf16_t*)(ws + WS_PROJB), (float*)(ws + WS_GATES)};
        pg8::gemm_phase<EpiB, true>(lds, g, S, E);
    }
    if constexpr (PH == 10) p8_compress(p, lds);
    if constexpr (PH == 11) p9_nsa(p, lds);
    if constexpr (PH == 12) {
        const bf16_t* yb = (const bf16_t*)(ws + WS_RA);
        pg8::Gemm g{yb, yb, 0, (const bf16_t*)(ws + WS_WBO), M, 1024, 1024}; pg8::StaticOrder S; S.init(M, 1024, G, (int)blockIdx.x);
        EpiRes<true> E{p.out, p.out, (const float*)(ws + WS_MOD) + 8 * 3072, (float*)(ws + WS_SSQ)};
        pg8::gemm_phase<EpiRes<true>, true>(lds, g, S, E);
    }
    if constexpr (PH == 13) p11_final(p);
}
#if MK_ONE_LAUNCH
__global__ void __launch_bounds__(512, 2) fwd_kernel(Params p) {
    extern __shared__ __attribute__((aligned(16))) unsigned char lds_raw[];
    LAS unsigned char* lds = (LAS unsigned char*)lds_raw;
    volatile LAS unsigned* misc = (volatile LAS unsigned*)(lds + LDS_BYTES - 64);
    if (threadIdx.x < 16) misc[threadIdx.x] = 0u;
    __syncthreads();
    XcdBarrier bar = xcd_barrier_post((unsigned*)(p.ws + WS_CTL) + 1024, misc);
    run_phase<0>(p, lds); xcd_barrier(bar);
    run_phase<1>(p, lds); xcd_barrier(bar);
    run_phase<2>(p, lds); xcd_barrier(bar);
    run_phase<3>(p, lds); xcd_barrier(bar);
    run_phase<4>(p, lds); xcd_barrier(bar);
    run_phase<5>(p, lds); xcd_barrier(bar);
    run_phase<6>(p, lds); xcd_barrier(bar);
    run_phase<7>(p, lds); xcd_barrier(bar);
    run_phase<8>(p, lds); xcd_barrier(bar);
    run_phase<9>(p, lds); xcd_barrier(bar);
    run_phase<10>(p, lds); xcd_barrier(bar);
    run_phase<11>(p, lds); xcd_barrier(bar);
    run_phase<12>(p, lds); xcd_barrier(bar);
    run_phase<13>(p, lds);
}
#else
template <int PH> __global__ void __launch_bounds__(512, 2) phase_kernel(Params p) {
    extern __shared__ __attribute__((aligned(16))) unsigned char lds_raw[];
    run_phase<PH>(p, (LAS unsigned char*)lds_raw);
}
template <int PH> static void launch_phase(const Params& a, int grid, hipStream_t stream) {
    static bool attr = false;
    if (!attr) { (void)hipFuncSetAttribute((const void*)phase_kernel<PH>, hipFuncAttributeMaxDynamicSharedMemorySize, LDS_BYTES); attr = true; }
    hipLaunchKernelGGL(phase_kernel<PH>, dim3(grid), dim3(512), LDS_BYTES, stream, a);
}
#endif

extern "C" void kernel_launch(void* const* d_in, const int* in_sizes, int n_in, void* d_out, int out_size, void* d_ws, size_t ws_size, hipStream_t stream) {
    static int grid = 0;
    if (grid == 0) {
        if (n_in != 23 || out_size != M * D || ws_size < WS_END) { fprintf(stderr, "kernel_launch: unexpected shapes (n_in %d out %d ws %zu)\n", n_in, out_size, ws_size); grid = -1; return; }
        int dev = 0, cus = 0;
        if (hipGetDevice(&dev) != hipSuccess || hipDeviceGetAttribute(&cus, hipDeviceAttributeMultiprocessorCount, dev) != hipSuccess) { grid = -1; return; }
#if MK_ONE_LAUNCH
        if (hipFuncSetAttribute((const void*)fwd_kernel, hipFuncAttributeMaxDynamicSharedMemorySize, LDS_BYTES) != hipSuccess) { fprintf(stderr, "kernel_launch: hipFuncSetAttribute failed\n"); grid = -1; return; }
        int per_cu = 0;
        if (hipOccupancyMaxActiveBlocksPerMultiprocessor(&per_cu, (const void*)fwd_kernel, 512, LDS_BYTES) != hipSuccess || per_cu < 1) fprintf(stderr, "kernel_launch: occupancy query says %d\n", per_cu);
        (void)hipGetLastError();
#endif
        grid = cus;
    }
    if (grid < 0) return;
    Params a{};
    for (int i = 0; i < 23; ++i) a.in[i] = (const float*)d_in[i];
    a.out = (float*)d_out; a.ws = (unsigned char*)d_ws;
    a.ph_lo = 0; a.ph_hi = NPH;
#if MK_ONE_LAUNCH
    hipMemsetAsync((char*)d_ws + WS_CTL, 0, 65536, stream);
    hipLaunchKernelGGL(fwd_kernel, dim3(grid), dim3(512), LDS_BYTES, stream, a);
#else
    launch_phase<0>(a, grid, stream); launch_phase<1>(a, grid, stream); launch_phase<2>(a, grid, stream); launch_phase<3>(a, grid, stream);
    launch_phase<4>(a, grid, stream); launch_phase<5>(a, grid, stream); launch_phase<6>(a, grid, stream); launch_phase<7>(a, grid, stream);
    launch_phase<8>(a, grid, stream); launch_phase<9>(a, grid, stream); launch_phase<10>(a, grid, stream); launch_phase<11>(a, grid, stream);
    launch_phase<12>(a, grid, stream); launch_phase<13>(a, grid, stream);
#endif
}
```

```cpp
#include <hip/hip_runtime.h>
#include <cstdio>
#include <cstdint>
#include <type_traits>

#define DI __device__ __forceinline__
#define LAS __attribute__((address_space(3)))
typedef unsigned short bf16_t;
typedef short bf16x8 __attribute__((ext_vector_type(8)));
typedef short s16x4 __attribute__((ext_vector_type(4)));
typedef float f32x4 __attribute__((ext_vector_type(4)));
typedef float f32x2 __attribute__((ext_vector_type(2)));
typedef float f32x16 __attribute__((ext_vector_type(16)));
typedef unsigned u32x4 __attribute__((ext_vector_type(4)));
typedef unsigned u32x2 __attribute__((ext_vector_type(2)));
typedef __bf16 bf16x2_t __attribute__((ext_vector_type(2)));

#ifndef DUP_MASK
#define DUP_MASK 0
#endif
#ifndef MK_ONE_LAUNCH
#define MK_ONE_LAUNCH 1
#endif

constexpr int NB = 8, T = 4096, D = 1024, M = NB * T;
constexpr int A_LD = 4112, B_LD = 4144;
constexpr float EPS = 1e-6f;
constexpr int NPH = 14;

constexpr size_t MiB = 1u << 20;
constexpr size_t WS_CTL = 0;
constexpr size_t WS_MODP = 1 * MiB;
constexpr size_t WS_WA = 4 * MiB;
constexpr size_t WS_WAO = 12 * MiB;
constexpr size_t WS_WCAT = 14 * MiB;
constexpr size_t WS_WBO = 24 * MiB;
constexpr size_t WS_W1T = 26 * MiB;
constexpr size_t WS_W2T = 28 * MiB;
constexpr size_t WS_C1P = 28 * MiB + 65536;
constexpr size_t WS_MOD = 28 * MiB + 131072;
constexpr size_t WS_SSQ = 28 * MiB + 524288;
constexpr size_t WS_BG = 31 * MiB;
constexpr size_t WS_GL = 33 * MiB;
constexpr size_t WS_RA = 34 * MiB;
constexpr size_t WS_RP = 130 * MiB;
constexpr size_t WS_PW = WS_RP;
constexpr size_t WS_PQD = WS_RP + 64 * MiB;
constexpr size_t WS_PKDT = WS_RP + 128 * MiB;
constexpr size_t WS_PU = WS_RP + 192 * MiB;
constexpr size_t WS_PAT = WS_RP + 256 * MiB;
constexpr size_t WS_PROJB = WS_RP;
constexpr size_t WS_S = WS_RP + 256 * MiB;
constexpr size_t WS_KV = WS_RP + 320 * MiB;
constexpr size_t WS_GATES = WS_RP + 368 * MiB;
constexpr size_t WS_CMP = WS_RP + 374 * MiB;
constexpr size_t WS_END = WS_RP + 375 * MiB;

constexpr int LDS_BYTES = 155648;

DI unsigned cvtpk(float lo, float hi) { f32x2 v = {lo, hi}; bf16x2_t b = __builtin_convertvector(v, bf16x2_t); return __builtin_bit_cast(unsigned, b); }
DI bf16_t f2bf(float f) { return (bf16_t)(cvtpk(f, 0.f) & 0xffffu); }
DI float bf2f(bf16_t v) { return __uint_as_float((unsigned)v << 16); }
DI float bflo(unsigned u) { return __uint_as_float(u << 16); }
DI float bfhi(unsigned u) { return __uint_as_float(u & 0xffff0000u); }
DI float sigm(float x) { return __builtin_amdgcn_rcpf(1.f + __builtin_amdgcn_exp2f(-1.4426950408889634f * x)); }
DI float siluf(float x) { return x * sigm(x); }
DI float wave_sum(float v) {
#pragma unroll
    for (int o = 1; o < 64; o <<= 1) v += __shfl_xor(v, o);
    return v;
}
DI int crow(int reg, int h) { return (reg & 3) + 8 * (reg >> 2) + 4 * h; }
#define MFMA32(a, b, c) __builtin_amdgcn_mfma_f32_32x32x16_bf16((a), (b), (c), 0, 0, 0)
DI bf16x8 pack8(const f32x16& x, const int s) {
    u32x4 p;
    p[0] = cvtpk(x[8 * s + 0], x[8 * s + 1]); p[1] = cvtpk(x[8 * s + 2], x[8 * s + 3]);
    p[2] = cvtpk(x[8 * s + 4], x[8 * s + 5]); p[3] = cvtpk(x[8 * s + 6], x[8 * s + 7]);
    return __builtin_bit_cast(bf16x8, p);
}
DI bf16x8 lds128(const LAS unsigned char* p) { return *(const LAS bf16x8*)p; }
DI bf16x8 lds2x64(const LAS unsigned char* lo, const LAS unsigned char* hi) {
    const s16x4 a = *(const LAS s16x4*)lo, b = *(const LAS s16x4*)hi;
    return __builtin_shufflevector(a, b, 0, 1, 2, 3, 4, 5, 6, 7);
}
DI int otid() { int t = threadIdx.x; asm volatile("" : "+v"(t)); return t; }
DI f32x16 zero16() { f32x16 z; for (int i = 0; i < 16; ++i) z[i] = 0.f; return z; }

struct Params { const float* in[23]; float* out; unsigned char* ws; int ph_lo, ph_hi, pad0, pad1; };

#define XB_TMO      128
#define XB_XCNT(j)  (256  + 64 * (j))
#define XB_XSUB(j)  (1280 + 64 * (j))
#define XB_XGEN(j)  (2304 + 64 * (j))
#define XB_TOP      3328
#define XB_TOPGEN   3392
#define XCD_BAR_WORDS 3456
#define XB_SPIN_CAP (1u << 22)
DI unsigned xb_ld(unsigned* p)              { return __hip_atomic_load(p, __ATOMIC_RELAXED, __HIP_MEMORY_SCOPE_AGENT); }
DI unsigned xb_add(unsigned* p, unsigned v) { return __hip_atomic_fetch_add(p, v, __ATOMIC_RELAXED, __HIP_MEMORY_SCOPE_AGENT); }
DI unsigned xb_xcc_id() { return (unsigned)__builtin_amdgcn_s_getreg((3 << 11) | 20) & 0xFu; }
#define XB_SPIN(cond, bar) do { unsigned _sp = 0; while (cond) { __builtin_amdgcn_s_sleep(1); \
    if ((++_sp & 255u) == 0u) { if (xb_ld(&(bar)[XB_TMO])) break; if (_sp > XB_SPIN_CAP) { atomicAdd(&(bar)[XB_TMO], 1u); break; } } } } while (0)
struct XcdBarrier { unsigned* bar; unsigned x; volatile LAS unsigned* st; };
DI XcdBarrier xcd_barrier_post(unsigned* bar, volatile LAS unsigned* st) {
    XcdBarrier b; b.bar = bar; b.x = xb_xcc_id(); b.st = st;
    if (threadIdx.x == 0) (void)xb_add(&bar[XB_XCNT(b.x)], 1u);
    return b;
}
DI void xcd_barrier_complete(unsigned* bar, unsigned x, unsigned& nloc, unsigned& nx) {
    const unsigned G = gridDim.x * gridDim.y * gridDim.z;
    unsigned sum, cnt, mine, sp = 0u;
    for (;;) {
        sum = 0u; cnt = 0u; mine = 0u;
#pragma unroll
        for (unsigned j = 0; j < 16; ++j) { const unsigned c = xb_ld(&bar[XB_XCNT(j)]); sum += c; cnt += (c > 0u) ? 1u : 0u; mine = (j == x) ? c : mine; }
        if (sum == G) break;
        __builtin_amdgcn_s_sleep(1);
        if ((++sp & 255u) == 0u) { if (xb_ld(&bar[XB_TMO])) break; if (sp > XB_SPIN_CAP) { atomicAdd(&bar[XB_TMO], 1u); break; } }
    }
    nloc = mine > 0u ? mine : 1u; nx = cnt > 0u ? cnt : 1u;
}
DI void xcd_barrier(const XcdBarrier& b) {
    asm volatile("s_waitcnt vmcnt(0)" ::: "memory");
    __syncthreads();
    if (threadIdx.x == 0) {
        unsigned* bar = b.bar;
        __builtin_amdgcn_s_waitcnt(0);
        unsigned nloc = b.st[0], nx = b.st[1];
        if (nloc == 0u) { xcd_barrier_complete(bar, b.x, nloc, nx); b.st[0] = nloc; b.st[1] = nx; }
        const unsigned old = xb_add(&bar[XB_XSUB(b.x)], 1u);
        const unsigned gen = old / nloc;
        if (old + 1u == (gen + 1u) * nloc) {
            __builtin_amdgcn_fence(__ATOMIC_RELEASE, "agent");
            asm volatile("s_waitcnt vmcnt(0)" ::: "memory");
            const unsigned og = xb_add(&bar[XB_TOP], 1u);
            const unsigned tg = og / nx;
            if (og + 1u == (tg + 1u) * nx) xb_add(&bar[XB_TOPGEN], 1u);
            else XB_SPIN(xb_ld(&bar[XB_TOPGEN]) == tg, bar);
            __builtin_amdgcn_fence(__ATOMIC_ACQUIRE, "agent");
            xb_add(&bar[XB_XGEN(b.x)], 1u);
            asm volatile("s_waitcnt vmcnt(0)" ::: "memory");
        } else {
            XB_SPIN(xb_ld(&bar[XB_XGEN(b.x)]) == gen, bar);
            __builtin_amdgcn_fence(__ATOMIC_ACQUIRE, "agent");
            asm volatile("s_waitcnt vmcnt(0)" ::: "memory");
        }
    }
    __syncthreads();
}

namespace pg8 {
constexpr int BM = 256, BK = 64, HALF = 128, HTB = HALF * BK * 2, STAGE_BYTES = 8 * HTB, NXCD = 8, WGM = 8;
DI int lds_byte(int r, int c) { const int st = (r >> 4) * 2 + (c >> 5), rr = r & 15, cc = c & 31, ob = rr * 64 + cc * 2; return st * 1024 + (ob ^ (((ob >> 9) & 1) << 5)); }
DI void stage_rc(int b, int& R, int& C) { const int st = b / 1024, sb = b % 1024, swz = sb ^ (((sb >> 9) & 1) << 5); R = (st >> 1) * 16 + swz / 64; C = (st & 1) * 32 + (swz % 64) / 2; }
DI int perm32(int rho) { const int n = rho >> 4, i = rho & 15; return 8 * (i >> 2) + 4 * n + (i & 3); }
struct Unit { int pm, pn; };
struct Gemm { const bf16_t* A0; const bf16_t* A1; int split; const bf16_t* Bt; int M, N, K; };
struct StaticOrder {
    int nM, nN, nwg, G, c;
    DI void init(int M_, int N_, int G_, int c_) { nM = M_ / BM; nN = N_ / BM; nwg = nM * nN; G = G_; c = c_; }
    DI bool next(int i, Unit& u) const {
        const long L = (long)i * G + c; if (L >= nwg) return false;
        int wgid = (int)L; { const int q = nwg / NXCD, r = nwg % NXCD, xcd = wgid % NXCD, off = wgid / NXCD; wgid = (xcd < r ? xcd * (q + 1) : r * (q + 1) + (xcd - r) * q) + off; }
        const int nig = WGM * nN, gid = wgid / nig, fm = gid * WGM, gsz = (nM - fm) < WGM ? (nM - fm) : WGM;
        u.pm = fm + ((wgid % nig) % gsz); u.pn = (wgid % nig) / gsz; return true;
    }
};
template <class Epi, bool ALIGN_EPI>
DI void gemm_phase(LAS unsigned char* lds, const Gemm g, const StaticOrder& S, const Epi& E) {
    const int tid = otid(), wid = __builtin_amdgcn_readfirstlane(tid >> 6), lane = tid & 63, wr = wid >> 2, wc = wid & 3, fr = lane & 15, fq = lane >> 4;
    const int K = g.K, nt = K / BK;
    unsigned voffA[2], voffB[2];
#pragma unroll
    for (int i = 0; i < 2; ++i) { int R, C; stage_rc(tid * 16 + i * 8192, R, C); const int Rb = Epi::PERM ? ((R & ~31) + perm32(R & 31)) : R;
        voffA[i] = (unsigned)(R * K + C) * 2u; voffB[i] = (unsigned)(Rb * K + C) * 2u; }
    const size_t kstep = (size_t)(BK * 2);
    const size_t hstep = (size_t)HALF * K * 2;
    const size_t tstep = 2 * hstep;
    const unsigned ldsw = (unsigned)wid * 1024u;
    const int aoff = lds_byte(wr * 64 + fr, fq * 8), boff = lds_byte(wc * 32 + fr, fq * 8);
#define PG8_SA(b, h) (((b) * 2 + (h)) * HTB)
#define PG8_SB(b, h) ((4 + (b) * 2 + (h)) * HTB)
#define PG8_STAGE(bufoff, gbase, voff) do { _Pragma("unroll") for (int _i = 0; _i < 2; ++_i) \
        __builtin_amdgcn_global_load_lds((const unsigned*)((const char*)(gbase) + (voff)[_i]), (LAS unsigned*)(lds + (bufoff) + ldsw + _i * 8192), 16, 0, 0); } while (0)
#define PG8_LDA(dst, b, h) do { _Pragma("unroll") for (int m = 0; m < 4; ++m) _Pragma("unroll") for (int k = 0; k < 2; ++k) dst[m][k] = *(const LAS bf16x8*)(lds + PG8_SA(b, h) + aoff + m * 2048 + k * 1024); } while (0)
#define PG8_LDB(dst, b, h) do { _Pragma("unroll") for (int n = 0; n < 2; ++n) _Pragma("unroll") for (int k = 0; k < 2; ++k) dst[n][k] = *(const LAS bf16x8*)(lds + PG8_SB(b, h) + boff + n * 2048 + k * 1024); } while (0)
#define PG8_MMA(ai, bj, At, Bt) do { __builtin_amdgcn_s_setprio(1); _Pragma("unroll") for (int m = 0; m < 4; ++m) _Pragma("unroll") for (int n = 0; n < 2; ++n) _Pragma("unroll") for (int k = 0; k < 2; ++k) \
        acc[ai][bj][m][n] = __builtin_amdgcn_mfma_f32_16x16x32_bf16(Bt[n][k], At[m][k], acc[ai][bj][m][n], 0, 0, 0); __builtin_amdgcn_s_setprio(0); } while (0)
#define PG8_WAIT_V(n) asm volatile("s_waitcnt vmcnt(" #n ")" ::: "memory")
#define PG8_WAIT_L(n) asm volatile("s_waitcnt lgkmcnt(" #n ")" ::: "memory")
#define PG8_BAR __builtin_amdgcn_s_barrier()
#define PG8_SCHED __builtin_amdgcn_sched_barrier(0)
    Unit cur, nxt; int ui = 0;
    if (!S.next(0, cur)) return;
    f32x4 acc[2][2][4][2];
#pragma unroll
    for (int a = 0; a < 2; ++a)
#pragma unroll
        for (int b = 0; b < 2; ++b)
#pragma unroll
            for (int m = 0; m < 4; ++m)
#pragma unroll
                for (int n = 0; n < 2; ++n) acc[a][b][m][n] = (f32x4){0.f, 0.f, 0.f, 0.f};
    bf16x8 At[4][2], B0[2][2], B1[2][2];
    const char* cA = (const char*)(cur.pn < g.split ? g.A0 : g.A1) + (size_t)cur.pm * tstep; const char* cB = (const char*)g.Bt + (size_t)cur.pn * tstep;
    PG8_STAGE(PG8_SB(0, 0), cB, voffB); PG8_STAGE(PG8_SB(0, 1), cB + hstep, voffB); PG8_STAGE(PG8_SA(0, 0), cA, voffA); PG8_STAGE(PG8_SA(0, 1), cA + hstep, voffA);
    if (wr == 1) PG8_BAR;
    PG8_WAIT_V(2); PG8_BAR;
    PG8_STAGE(PG8_SB(1, 0), cB + kstep, voffB); PG8_STAGE(PG8_SA(1, 0), cA + kstep, voffA); PG8_STAGE(PG8_SB(1, 1), cB + hstep + kstep, voffB);
    PG8_WAIT_V(6); PG8_BAR;
    for (;;) {
        const bool has_next = S.next(ui + 1, nxt);
        const char* nA = has_next ? (const char*)(nxt.pn < g.split ? g.A0 : g.A1) + (size_t)nxt.pm * tstep : cA; const char* nB = has_next ? (const char*)g.Bt + (size_t)nxt.pn * tstep : cB;
        for (int t = 0; t < nt; t += 2) {
            const bool last = (t == nt - 2);
            const char* a1 = cA + (size_t)(t + 1) * kstep;
            const char* a2 = last ? nA : cA + (size_t)(t + 2) * kstep; const char* b2 = last ? nB : cB + (size_t)(t + 2) * kstep;
            const char* a3 = a2 + kstep; const char* b3 = b2 + kstep;
            PG8_LDB(B0, 0, 0); PG8_LDB(B1, 0, 1); PG8_SCHED; PG8_LDA(At, 0, 0); PG8_STAGE(PG8_SA(1, 1), a1 + hstep, voffA);
            PG8_WAIT_V(8); PG8_WAIT_L(0); PG8_BAR; PG8_MMA(0, 0, At, B0); PG8_MMA(0, 1, At, B1); PG8_BAR; PG8_SCHED;
            PG8_LDA(At, 0, 1); PG8_STAGE(PG8_SB(0, 0), b2, voffB); PG8_STAGE(PG8_SB(0, 1), b2 + hstep, voffB); PG8_STAGE(PG8_SA(0, 0), a2, voffA);
            PG8_WAIT_V(8); PG8_WAIT_L(0); PG8_BAR; PG8_MMA(1, 0, At, B0); PG8_MMA(1, 1, At, B1); PG8_BAR; PG8_SCHED;
            PG8_LDB(B0, 1, 0); PG8_LDB(B1, 1, 1); PG8_SCHED; PG8_LDA(At, 1, 0); PG8_STAGE(PG8_SA(0, 1), a2 + hstep, voffA);
            PG8_WAIT_V(8); PG8_WAIT_L(0); PG8_BAR; PG8_MMA(0, 0, At, B0); PG8_MMA(0, 1, At, B1); PG8_BAR; PG8_SCHED;
            PG8_LDA(At, 1, 1); PG8_STAGE(PG8_SB(1, 0), b3, voffB); PG8_STAGE(PG8_SB(1, 1), b3 + hstep, voffB); PG8_STAGE(PG8_SA(1, 0), a3, voffA);
            PG8_WAIT_V(8); PG8_WAIT_L(0); PG8_BAR; PG8_MMA(1, 0, At, B0); PG8_MMA(1, 1, At, B1); PG8_BAR; PG8_SCHED;
        }
        if constexpr (ALIGN_EPI) { if (wr == 0) PG8_BAR; }
        E(acc, cur, wr, wc, fr, fq);
        if (!has_next) break;
#pragma unroll
        for (int a = 0; a < 2; ++a)
#pragma unroll
            for (int b = 0; b < 2; ++b)
#pragma unroll
                for (int m = 0; m < 4; ++m)
#pragma unroll
                    for (int n = 0; n < 2; ++n) acc[a][b][m][n] = (f32x4){0.f, 0.f, 0.f, 0.f};
        cur = nxt; cA = nA; cB = nB; ++ui;
        if constexpr (ALIGN_EPI) { if (wr == 1) PG8_BAR; }
    }
    PG8_WAIT_V(0);
    if constexpr (!ALIGN_EPI) { if (wr == 0) PG8_BAR; }
    PG8_BAR;
#undef PG8_SA
#undef PG8_SB
#undef PG8_STAGE
#undef PG8_LDA
#undef PG8_LDB
#undef PG8_MMA
#undef PG8_WAIT_V
#undef PG8_WAIT_L
#undef PG8_BAR
#undef PG8_SCHED
}
}

struct EpiA {
    static constexpr bool PERM = true;
    bf16_t* qkv; bf16_t* z; int row_off;
    DI void operator()(const f32x4 (&acc)[2][2][4][2], const pg8::Unit& u, int wr, int wc, int fr, int fq) const {
        const int row0 = u.pm * 256 + wr * 64 + fr; const int ct = u.pn * 256 + wc * 32 + 8 * fq;
        bf16_t* base; int ldc, col0;
        if (u.pn < 12) { base = qkv + (size_t)row0 * 3072; ldc = 3072; col0 = ct; } else { base = z + (size_t)(row_off + row0) * 1024; ldc = 1024; col0 = ct - 3072; }
#pragma unroll
        for (int ai = 0; ai < 2; ++ai)
#pragma unroll
            for (int m = 0; m < 4; ++m) { bf16_t* rowp = base + (size_t)(ai * 128 + m * 16) * ldc + col0;
#pragma unroll
                for (int bj = 0; bj < 2; ++bj) { const f32x4 v0 = acc[ai][bj][m][0], v1 = acc[ai][bj][m][1];
                    u32x4 w; w.x = cvtpk(v0[0], v0[1]); w.y = cvtpk(v0[2], v0[3]); w.z = cvtpk(v1[0], v1[1]); w.w = cvtpk(v1[2], v1[3]);
                    *(u32x4*)(rowp + bj * 128) = w; } }
    }
};
template <bool SSQ> struct EpiRes {
    static constexpr bool PERM = false;
    const float* base; float* out; const float* gate  ; float* ssq;
    DI void operator()(const f32x4 (&acc)[2][2][4][2], const pg8::Unit& u, int wr, int wc, int fr, int fq) const {
        const int col0 = u.pn * 256 + wc * 32 + 4 * fq; const int b = (u.pm * 256) >> 12;
        f32x4 gv[2][2];
#pragma unroll
        for (int bj = 0; bj < 2; ++bj)
#pragma unroll
            for (int n = 0; n < 2; ++n) gv[bj][n] = *(const f32x4*)(gate + (size_t)b * 3072 + 2048 + col0 + bj * 128 + n * 16);
#pragma unroll
        for (int ai = 0; ai < 2; ++ai)
#pragma unroll
            for (int m = 0; m < 4; ++m) { const int r = u.pm * 256 + ai * 128 + wr * 64 + m * 16 + fr; const size_t off = (size_t)r * 1024 + col0; float ss = 0.f;
#pragma unroll
                for (int bj = 0; bj < 2; ++bj)
#pragma unroll
                    for (int n = 0; n < 2; ++n) { const f32x4 bs = *(const f32x4*)(base + off + bj * 128 + n * 16); const f32x4 o = bs + gv[bj][n] * acc[ai][bj][m][n];
                        *(f32x4*)(out + off + bj * 128 + n * 16) = o; if (SSQ) ss += (o[0] * o[0] + o[1] * o[1]) + (o[2] * o[2] + o[3] * o[3]); }
                if (SSQ) { ss += __shfl_xor(ss, 16); ss += __shfl_xor(ss, 32); if (fq == 0) ssq[(size_t)(u.pn * 4 + wc) * M + r] = ss; } }
    }
};
struct EpiB {
    static constexpr bool PERM = true;
    bf16_t* kv; bf16_t* projb; float* gates;
    DI void operator()(const f32x4 (&acc)[2][2][4][2], const pg8::Unit& u, int wr, int wc, int fr, int fq) const {
        const int row0 = u.pm * 256 + wr * 64 + fr; const int cw = wc * 32 + 8 * fq;
        if (u.pn == 19) {
#pragma unroll
            for (int ai = 0; ai < 2; ++ai)
#pragma unroll
                for (int m = 0; m < 4; ++m) { float* rowp = gates + (size_t)(row0 + ai * 128 + m * 16) * 48;
                    if (cw < 48) {
#pragma unroll
                        for (int n = 0; n < 2; ++n) { const f32x4 v = acc[ai][0][m][n]; f32x4 o; o[0] = sigm(v[0]); o[1] = sigm(v[1]); o[2] = sigm(v[2]); o[3] = sigm(v[3]); *(f32x4*)(rowp + cw + 4 * n) = o; } } }
            return;
        }
        bf16_t* base; int ldc, col0; float sc = 1.f;
        if (u.pn < 3) { base = kv + (size_t)row0 * 768; ldc = 768; col0 = u.pn * 256 + cw; } else { base = projb + (size_t)row0 * 4096; ldc = 4096; col0 = (u.pn - 3) * 256 + cw; if (u.pn < 7) sc = 0.125f * 1.4426950408889634f; }
#pragma unroll
        for (int ai = 0; ai < 2; ++ai)
#pragma unroll
            for (int m = 0; m < 4; ++m) { bf16_t* rowp = base + (size_t)(ai * 128 + m * 16) * ldc + col0;
#pragma unroll
                for (int bj = 0; bj < 2; ++bj) { const f32x4 v0 = acc[ai][bj][m][0] * sc, v1 = acc[ai][bj][m][1] * sc;
                    u32x4 w; w.x = cvtpk(v0[0], v0[1]); w.y = cvtpk(v0[2], v0[3]); w.z = cvtpk(v1[0], v1[1]); w.w = cvtpk(v1[2], v1[3]);
                    *(u32x4*)(rowp + bj * 128) = w; } }
    }
};

DI void p0_transpose_item(const float* W, int ld, int col0, int nvalid, int K, bf16_t* WT, int row_off, LAS float* scr, int item, int nblk, int lane) {
    const int kb = item / nblk, nb = item % nblk, k0 = 64 * kb, n0 = 32 * nb;
    const int nn = n0 + (lane & 31);
#pragma unroll 8
    for (int i = 0; i < 32; ++i) { const int kk = 2 * i + (lane >> 5); scr[kk * 33 + (lane & 31)] = (nn < nvalid) ? W[(size_t)(k0 + kk) * ld + col0 + nn] : 0.f; }
    asm volatile("s_waitcnt lgkmcnt(0)" ::: "memory");
    const int c = lane & 7;
#pragma unroll
    for (int j = 0; j < 4; ++j) { const int n = (lane >> 3) + 8 * j; const LAS float* s = scr + (8 * c) * 33 + n;
        u32x4 o; o.x = cvtpk(s[0 * 33], s[1 * 33]); o.y = cvtpk(s[2 * 33], s[3 * 33]); o.z = cvtpk(s[4 * 33], s[5 * 33]); o.w = cvtpk(s[6 * 33], s[7 * 33]);
        *(u32x4*)(WT + (size_t)(row_off + n0 + n) * K + k0 + 8 * c) = o; }
    asm volatile("s_waitcnt lgkmcnt(0)" ::: "memory");
}
DI void p0_prologue(const Params& p, LAS unsigned char* lds) {
    const int tid = otid(), lane = tid & 63, wave = __builtin_amdgcn_readfirstlane(tid >> 6);
    LAS float* scr = (LAS float*)(lds + wave * 8704);
    const int gw = blockIdx.x * 8 + wave, NGW = gridDim.x * 8;
    unsigned char* ws = p.ws;
    constexpr int I_ADA = 1536, I_WA = 16 * 128, I_WAO = 16 * 32, I_KV = 16 * 24, I_WB = 16 * 128, I_WG = 16 * 8, I_WBO = 16 * 32, I_W1 = 32 * 8, I_W2 = 4 * 2, I_C1 = 128;
    constexpr int NITEMS = I_ADA + I_WA + I_WAO + I_KV + I_WB + I_WG + I_WBO + 2 * I_W1 + 2 * I_W2 + I_C1;
    for (int it0 = gw; it0 < NITEMS; it0 += NGW) {
        int r = __builtin_amdgcn_readfirstlane(it0);
        if (r < I_ADA) {
            const int l = r / 768, rem = r % 768, jc = rem / 16, kc = rem % 16;
            const float* c = p.in[1]; const float* w = p.in[3] + (size_t)l * 1024 * 3072;
            float a[8]; for (int b = 0; b < 8; ++b) a[b] = 0.f;
            const int j = jc * 64 + lane;
            for (int kk = 0; kk < 64; ++kk) { const int k = kc * 64 + kk; const float wv = w[(size_t)k * 3072 + j];
#pragma unroll
                for (int b = 0; b < 8; ++b) { const float cv = c[b * 1024 + k]; a[b] += siluf(cv) * wv; } }
            float* modp = (float*)(ws + WS_MODP);
#pragma unroll
            for (int b = 0; b < 8; ++b) modp[(size_t)((kc * 2 + l) * 8 + b) * 3072 + j] = a[b];
            continue;
        }
        r -= I_ADA;
        if (r < I_WA) { p0_transpose_item(p.in[6], A_LD, 0, 4096, 1024, (bf16_t*)(ws + WS_WA), 0, scr, r, 128, lane); continue; } r -= I_WA;
        if (r < I_WAO) { p0_transpose_item(p.in[11], 1024, 0, 1024, 1024, (bf16_t*)(ws + WS_WAO), 0, scr, r, 32, lane); continue; } r -= I_WAO;
        if (r < I_KV) { p0_transpose_item(p.in[13], 768, 0, 768, 1024, (bf16_t*)(ws + WS_WCAT), 0, scr, r, 24, lane); continue; } r -= I_KV;
        if (r < I_WB) { p0_transpose_item(p.in[20], B_LD, 0, 4096, 1024, (bf16_t*)(ws + WS_WCAT), 768, scr, r, 128, lane); continue; } r -= I_WB;
        if (r < I_WG) { p0_transpose_item(p.in[20], B_LD, 4096, 48, 1024, (bf16_t*)(ws + WS_WCAT), 4864, scr, r, 8, lane); continue; } r -= I_WG;
        if (r < I_WBO) { p0_transpose_item(p.in[21], 1024, 0, 1024, 1024, (bf16_t*)(ws + WS_WBO), 0, scr, r, 32, lane); continue; } r -= I_WBO;
        if (r < I_W1) { p0_transpose_item(p.in[16], 256, 0, 256, 2048, (bf16_t*)(ws + WS_W1T), 0, scr, r, 8, lane); continue; } r -= I_W1;
        if (r < I_W1) { p0_transpose_item(p.in[18], 256, 0, 256, 2048, (bf16_t*)(ws + WS_W1T), 256, scr, r, 8, lane); continue; } r -= I_W1;
        if (r < I_W2) { p0_transpose_item(p.in[17], 64, 0, 64, 256, (bf16_t*)(ws + WS_W2T), 0, scr, r, 2, lane); continue; } r -= I_W2;
        if (r < I_W2) { p0_transpose_item(p.in[19], 64, 0, 64, 256, (bf16_t*)(ws + WS_W2T), 64, scr, r, 2, lane); continue; } r -= I_W2;
        {
            const int which = r / 64, rem = r % 64, jc = rem / 16, kc = rem % 16;
            const float* pos = p.in[14 + which]; const float* w1 = p.in[16 + 2 * which];
            const int j = jc * 64 + lane; float a = 0.f;
            for (int kk = 0; kk < 128; ++kk) { const int k = kc * 128 + kk; a += pos[k] * w1[(size_t)k * 256 + j]; }
            ((float*)(ws + WS_C1P))[(kc * 2 + which) * 256 + j] = a;
        }
    }
}

template <int LAYER> DI void norm_rows(const Params& p, LAS unsigned char* lds) {
    const int tid = otid(), lane = tid & 63, wave = __builtin_amdgcn_readfirstlane(tid >> 6);
    unsigned char* ws = p.ws;
    LAS float* gs = (LAS float*)lds;
    LAS float* sh = gs + 1024;
    LAS float* g2 = sh + 1024;
    LAS float* wba = g2 + 1024;
    const float* xin = LAYER == 0 ? p.in[0] : p.out;
    bf16_t* hout = LAYER == 0 ? (bf16_t*)((unsigned char*)p.out + 64 * MiB) : (bf16_t*)(ws + WS_RA);
    bf16_t* sout = (bf16_t*)(ws + WS_S);
    const float* modp = (const float*)(ws + WS_MODP);
    float* mod = (float*)(ws + WS_MOD);
    for (int rb = blockIdx.x; rb < 256; rb += gridDim.x) {
        const int b = rb >> 5;
        __syncthreads();
        for (int k = tid; k < 1024; k += 512) {
            float v[3];
#pragma unroll
            for (int part = 0; part < 3; ++part) { float a = p.in[4][LAYER * 3072 + part * 1024 + k];
                for (int kc = 0; kc < 16; ++kc) a += modp[(size_t)((kc * 2 + LAYER) * 8 + b) * 3072 + part * 1024 + k];
                v[part] = a; if ((rb & 31) == 0) mod[(size_t)(LAYER * 8 + b) * 3072 + part * 1024 + k] = a; }
            gs[k] = p.in[5][LAYER * 1024 + k] * (1.f + v[1]); sh[k] = v[0];
            if (LAYER == 1) g2[k] = p.in[12][k];
        }
        if (LAYER == 0) for (int i = tid; i < 16 * 1024; i += 512) { const int c = i & 15, k = i >> 4; wba[c * 1024 + k] = p.in[6][(size_t)k * A_LD + 4096 + c]; }
        __syncthreads();
        for (int rr = 0; rr < 16; ++rr) {
            const int m = rb * 128 + wave * 16 + rr;
            const f32x4* xr = (const f32x4*)(xin + (size_t)m * 1024) + lane;
            f32x4 v[4]; float s = 0.f;
#pragma unroll
            for (int j = 0; j < 4; ++j) { v[j] = xr[64 * j]; s += (v[j][0] * v[j][0] + v[j][1] * v[j][1]) + (v[j][2] * v[j][2] + v[j][3] * v[j][3]); }
            const float rstd = rsqrtf(wave_sum(s) * (1.f / 1024.f) + EPS);
            f32x4 hv[4];
#pragma unroll
            for (int j = 0; j < 4; ++j) { const f32x4 g4 = *(const LAS f32x4*)(gs + 4 * lane + 256 * j), s4 = *(const LAS f32x4*)(sh + 4 * lane + 256 * j);
                const f32x4 xn = v[j] * rstd; hv[j] = xn * g4 + s4;
                u32x2 o; o.x = cvtpk(hv[j][0], hv[j][1]); o.y = cvtpk(hv[j][2], hv[j][3]);
                *((u32x2*)(hout + (size_t)m * 1024) + lane + 64 * j) = o;
                if (LAYER == 1) { const f32x4 k4 = *(const LAS f32x4*)(g2 + 4 * lane + 256 * j); const f32x4 sv = xn * k4; u32x2 o2; o2.x = cvtpk(sv[0], sv[1]); o2.y = cvtpk(sv[2], sv[3]);
                    *((u32x2*)(sout + (size_t)m * 1024) + lane + 64 * j) = o2; } }
            if (LAYER == 0) {
                float mine = 0.f;
#pragma unroll 2
                for (int c = 0; c < 16; ++c) { float a = 0.f;
#pragma unroll
                    for (int j = 0; j < 4; ++j) { const f32x4 w4 = *(const LAS f32x4*)(wba + c * 1024 + 4 * lane + 256 * j); a += (hv[j][0] * w4[0] + hv[j][1] * w4[1]) + (hv[j][2] * w4[2] + hv[j][3] * w4[3]); }
                    a = wave_sum(a); if (lane == c) mine = a; }
                if (lane < 16) { float o;
                    if (lane < 8) o = sigm(mine);
                    else { const float xx = mine + p.in[9][lane - 8]; const float sp = xx > 20.f ? xx : log1pf(__expf(xx)); o = -__expf(p.in[8][lane - 8]) * sp; }
                    ((float*)(ws + WS_BG))[(size_t)m * 16 + lane] = o; }
            }
        }
    }
}

DI void mm16_acc(float (&acc)[4], const LAS float* X, int px, const LAS float* Y, int py, int c, int q) {
    float y[16];
#pragma unroll
    for (int kk = 0; kk < 16; ++kk) y[kk] = Y[kk * py + c];
#pragma unroll
    for (int h2 = 0; h2 < 2; ++h2) {
        f32x4 xv[2][4];
#pragma unroll
        for (int rr = 0; rr < 2; ++rr)
#pragma unroll
            for (int k4 = 0; k4 < 4; ++k4) xv[rr][k4] = *(const LAS f32x4*)(X + (4 * q + 2 * h2 + rr) * px + 4 * k4);
#pragma unroll
        for (int k4 = 0; k4 < 4; ++k4)
#pragma unroll
            for (int rr = 0; rr < 2; ++rr)
                acc[2 * h2 + rr] += (xv[rr][k4][0] * y[4 * k4] + xv[rr][k4][1] * y[4 * k4 + 1]) + (xv[rr][k4][2] * y[4 * k4 + 2] + xv[rr][k4][3] * y[4 * k4 + 3]);
    }
}
template <int K> DI float row_bcast16(float v) {
    return __builtin_bit_cast(float, __builtin_amdgcn_update_dpp(0, __builtin_bit_cast(int, v), 0x150 + K, 0xf, 0xf, false));
}
template <int I, int K> struct InvRow {
    static DI void run(const float (&mcol)[16], const float (&tt)[16], float& s) { InvRow<I, K - 1>::run(mcol, tt, s); s += row_bcast16<K>(mcol[I]) * tt[K]; }
};
template <int I> struct InvRow<I, -1> { static DI void run(const float (&)[16], const float (&)[16], float&) {} };
template <int I> struct InvAll {
    static DI void run(const float (&mcol)[16], float (&tt)[16], int c) { InvAll<I - 1>::run(mcol, tt, c); float s = 0.f; InvRow<I, I - 1>::run(mcol, tt, s); tt[I] = (I == c ? 1.f : 0.f) - s;
        __builtin_amdgcn_sched_barrier(0); }
};
template <> struct InvAll<-1> { static DI void run(const float (&)[16], float (&)[16], int) {} };
DI void p3_prep(const Params& p, LAS unsigned char* lds, const int half) {
    const int tid = otid(), lane_k = tid & 63, wave = __builtin_amdgcn_readfirstlane(tid >> 6);
    unsigned char* ws = p.ws;
    constexpr int L_CW = 0, L_QS = 6144, L_KS = L_QS + 17408, L_VBT = L_KS + 17408, L_KBGT = L_VBT + 18432, L_KDT = L_KBGT + 18432,
                  L_LM = L_KDT + 18432, L_TM = L_LM + 17408, L_TB = L_TM + 17408, L_PM = L_TB + 9216, L_GC = L_PM + 1280, L_BETA = L_GC + 256, L_SS = L_BETA + 256;
    static_assert(L_SS + 4096 <= LDS_BYTES, "p3 lds");
    LAS float* Lm = (LAS float*)(lds + L_LM);
    LAS float* Tm = (LAS float*)(lds + L_TM);
    LAS float* Pm = (LAS float*)(lds + L_PM);
    LAS float* gcs = (LAS float*)(lds + L_GC);
    LAS float* betas = (LAS float*)(lds + L_BETA);
    const bf16_t* qkv = (const bf16_t*)(ws + WS_RA);
    const float* bg = (const float*)(ws + WS_BG);
    for (int g8 = blockIdx.x; g8 < 256; g8 += gridDim.x) {
        const int bl = g8 >> 6, h = (g8 >> 3) & 7, nbase = (g8 & 7) * 8;
        __syncthreads();
        float cwr[3][4][2];
#pragma unroll
        for (int X = 0; X < 3; ++X)
#pragma unroll
            for (int k = 0; k < 4; ++k) { const f32x2 w2 = *(const f32x2*)(p.in[7] + (size_t)k * 3072 + X * 1024 + h * 128 + 2 * lane_k); cwr[X][k][0] = w2[0]; cwr[X][k][1] = w2[1]; }
        for (int nn = 0; nn < 8; ++nn) {
            int lane = lane_k, r32, hh; asm volatile("" : "+v"(lane));
            r32 = lane & 31; hh = lane >> 5;
            const int tid = wave * 64 + lane;
            const int n = nbase + nn;
            const int bglob = half * 4 + bl;
            const int ug = (bglob * 8 + h) * 64 + n;
            if (wave == 0) {
                const size_t row = (size_t)bglob * 4096 + n * 64 + lane;
                float gv = bg[row * 16 + 8 + h];
#pragma unroll
                for (int o = 1; o < 64; o <<= 1) { const float t = __shfl_up(gv, o); if (lane >= o) gv += t; }
                gcs[lane] = gv; betas[lane] = bg[row * 16 + h];
            }
            __syncthreads();
            {
                const int tb = 8 * wave;
                const float gc_last = gcs[63];
#pragma unroll
                for (int X = 0; X < 3; ++X) {
                    float x0[11], x1[11];
#pragma unroll
                    for (int j = 0; j < 11; ++j) {
                        const int tt = n * 64 + tb + j - 3;
                        unsigned u = 0u;
                        if (tt >= 0) u = *(const unsigned*)(qkv + ((size_t)bl * 4096 + tt) * 3072 + X * 1024 + h * 128 + 2 * lane);
                        x0[j] = bflo(u); x1[j] = bfhi(u);
                    }
                    float y0[8], y1[8];
#pragma unroll
                    for (int tk = 0; tk < 8; ++tk) {
                        float a0 = 0.f, a1 = 0.f;
#pragma unroll
                        for (int k = 0; k < 4; ++k) { a0 += cwr[X][k][0] * x0[tk + k]; a1 += cwr[X][k][1] * x1[tk + k]; }
                        y0[tk] = siluf(a0); y1[tk] = siluf(a1);
                    }
                    if (X == 0) {
#pragma unroll
                        for (int tk = 0; tk < 8; ++tk) {
                            const int i = tb + tk;
                            const float rq = rsqrtf(wave_sum(y0[tk] * y0[tk] + y1[tk] * y1[tk]) + EPS) * 0.08838834764831845f;
                            const float q0 = y0[tk] * rq, q1 = y1[tk] * rq, eg = __expf(gcs[i]);
                            *(LAS unsigned*)(lds + L_QS + i * 272 + lane * 4) = cvtpk(q0, q1);
                            *(unsigned*)((bf16_t*)(ws + WS_PQD) + ((size_t)ug * 64 + i) * 128 + 2 * lane) = cvtpk(q0 * eg, q1 * eg);
                        }
                    } else if (X == 1) {
                        float b0[8], b1[8], d0[8], d1[8];
#pragma unroll
                        for (int tk = 0; tk < 8; ++tk) {
                            const int i = tb + tk;
                            const float rk = rsqrtf(wave_sum(y0[tk] * y0[tk] + y1[tk] * y1[tk]) + EPS);
                            const float k0 = y0[tk] * rk, k1 = y1[tk] * rk, gci = gcs[i];
                            const float fb = betas[i] * __expf(gci), fd = __expf(gc_last - gci);
                            *(LAS unsigned*)(lds + L_KS + i * 272 + lane * 4) = cvtpk(k0, k1);
                            b0[tk] = k0 * fb; b1[tk] = k1 * fb; d0[tk] = k0 * fd; d1[tk] = k1 * fd;
                        }
                        u32x4 w;
                        w.x = cvtpk(b0[0], b0[1]); w.y = cvtpk(b0[2], b0[3]); w.z = cvtpk(b0[4], b0[5]); w.w = cvtpk(b0[6], b0[7]); *(LAS u32x4*)(lds + L_KBGT + (2 * lane) * 144 + tb * 2) = w;
                        w.x = cvtpk(b1[0], b1[1]); w.y = cvtpk(b1[2], b1[3]); w.z = cvtpk(b1[4], b1[5]); w.w = cvtpk(b1[6], b1[7]); *(LAS u32x4*)(lds + L_KBGT + (2 * lane + 1) * 144 + tb * 2) = w;
                        w.x = cvtpk(d0[0], d0[1]); w.y = cvtpk(d0[2], d0[3]); w.z = cvtpk(d0[4], d0[5]); w.w = cvtpk(d0[6], d0[7]); *(LAS u32x4*)(lds + L_KDT + (2 * lane) * 144 + tb * 2) = w;
                        w.x = cvtpk(d1[0], d1[1]); w.y = cvtpk(d1[2], d1[3]); w.z = cvtpk(d1[4], d1[5]); w.w = cvtpk(d1[6], d1[7]); *(LAS u32x4*)(lds + L_KDT + (2 * lane + 1) * 144 + tb * 2) = w;
                    } else {
#pragma unroll
                        for (int tk = 0; tk < 8; ++tk) { const float bt = betas[tb + tk]; y0[tk] *= bt; y1[tk] *= bt; }
                        u32x4 w;
                        w.x = cvtpk(y0[0], y0[1]); w.y = cvtpk(y0[2], y0[3]); w.z = cvtpk(y0[4], y0[5]); w.w = cvtpk(y0[6], y0[7]); *(LAS u32x4*)(lds + L_VBT + (2 * lane) * 144 + tb * 2) = w;
                        w.x = cvtpk(y1[0], y1[1]); w.y = cvtpk(y1[2], y1[3]); w.z = cvtpk(y1[4], y1[5]); w.w = cvtpk(y1[6], y1[7]); *(LAS u32x4*)(lds + L_VBT + (2 * lane + 1) * 144 + tb * 2) = w;
                    }
                }
            }
            __syncthreads();
            {
                int lane_c = lane; asm volatile("" : "+v"(lane_c)); const int r32 = lane_c & 31, hh = lane_c >> 5;
                const int which = wave >> 2, mi = (wave >> 1) & 1, ni = wave & 1;
                f32x16 acc = zero16();
                if (!(mi == 0 && ni == 1)) {
                    const LAS unsigned char* ab = lds + (which ? L_QS : L_KS) + (32 * mi + r32) * 272 + hh * 16;
                    const LAS unsigned char* bb = lds + L_KS + (32 * ni + r32) * 272 + hh * 16;
#pragma unroll
                    for (int ks = 0; ks < 8; ++ks) acc = MFMA32(lds128(ab + ks * 32), lds128(bb + ks * 32), acc);
                }
                const int j = 32 * ni + r32; const float gcj = gcs[j];
                bf16_t* at = (bf16_t*)(ws + WS_PAT) + (size_t)ug * 4096;
#pragma unroll
                for (int reg = 0; reg < 16; ++reg) {
                    const int ii = 32 * mi + crow(reg, hh);
                    const float dec = (ii >= j) ? __expf(gcs[ii] - gcj) : 0.f;
                    if (which == 0) Lm[ii * 68 + j] = (ii > j) ? betas[ii] * acc[reg] * dec : 0.f;
                    else at[ii * 64 + j] = f2bf(acc[reg] * dec);
                }
            }
            __syncthreads();
            if (wave == 0) {
                const int a = lane >> 4, c = lane & 15;
                {
                    float mcol[16], tt[16];
#pragma unroll
                    for (int ii = 0; ii < 16; ++ii) mcol[ii] = Lm[(16 * a + ii) * 68 + 16 * a + c];
                    InvAll<15>::run(mcol, tt, c);
#pragma unroll
                    for (int ii = 0; ii < 16; ++ii) Tm[(16 * a + ii) * 68 + 16 * a + c] = tt[ii];
                }
                const int q = lane >> 4;
#pragma unroll
                for (int d = 1; d < 4; ++d)
#pragma unroll
                    for (int aa = d; aa < 4; ++aa) {
                        const int bb = aa - d;
                        float acc[4] = {0.f, 0.f, 0.f, 0.f};
                        for (int cc = bb; cc < aa; ++cc) mm16_acc(acc, Lm + (16 * aa) * 68 + 16 * cc, 68, Tm + (16 * cc) * 68 + 16 * bb, 68, c, q);
#pragma unroll
                        for (int rr = 0; rr < 4; ++rr) Pm[(4 * q + rr) * 20 + c] = acc[rr];
                        float acc2[4] = {0.f, 0.f, 0.f, 0.f};
                        mm16_acc(acc2, Tm + (16 * aa) * 68 + 16 * aa, 68, Pm, 20, c, q);
#pragma unroll
                        for (int rr = 0; rr < 4; ++rr) Tm[(16 * aa + 4 * q + rr) * 68 + 16 * bb + c] = -acc2[rr];
                    }
            } else {
                int tid_d = tid; asm volatile("" : "+v"(tid_d));
                bf16_t* dst = (bf16_t*)(ws + WS_PKDT) + (size_t)ug * 8192;
                for (int ci = tid_d - 64; ci < 1024; ci += 448) { const int row = ci >> 3, ch = ci & 7;
                    *(u32x4*)(dst + row * 64 + ch * 8) = *(const LAS u32x4*)(lds + L_KDT + row * 144 + ch * 16); }
                if (tid_d == 64) ((float*)(ws + WS_GL))[ug] = __expf(gcs[63]);
            }
            __syncthreads();
            for (int e = tid; e < 4096; e += 512) { const int ii = e >> 6, j = e & 63;
                *(LAS bf16_t*)(lds + L_TB + ii * 144 + j * 2) = ((j >> 4) > (ii >> 4)) ? (bf16_t)0 : f2bf(Tm[ii * 68 + j]); }
            __syncthreads();
            {
                int lane_e = lane; asm volatile("" : "+v"(lane_e)); const int r32 = lane_e & 31, hh = lane_e >> 5;
                const int mat = wave >> 2, nb = wave & 3;
                const LAS unsigned char* bb = lds + (mat ? L_KBGT : L_VBT) + (32 * nb + r32) * 144 + hh * 16;
#pragma unroll
                for (int mi = 0; mi < 2; ++mi) {
                    f32x16 acc = zero16();
                    const LAS unsigned char* ab = lds + L_TB + (32 * mi + r32) * 144 + hh * 16;
#pragma unroll
                    for (int ks = 0; ks < 4; ++ks) if (mi == 1 || ks < 2) acc = MFMA32(lds128(ab + ks * 32), lds128(bb + ks * 32), acc);
                    if (mat == 0) {
                        bf16_t* up = (bf16_t*)(ws + WS_PU) + ((((size_t)ug * 4 + nb) * 2 + mi) * 64 + lane_e) * 16;
                        u32x4 o0, o1;
#pragma unroll
                        for (int e = 0; e < 4; ++e) { o0[e] = cvtpk(acc[2 * e], acc[2 * e + 1]); o1[e] = cvtpk(acc[8 + 2 * e], acc[8 + 2 * e + 1]); }
                        *(u32x4*)up = o0; *(u32x4*)(up + 8) = o1;
                    } else {
                        bf16_t* wp = (bf16_t*)(ws + WS_PW) + (size_t)ug * 8192;
#pragma unroll
                        for (int reg = 0; reg < 16; ++reg) wp[(32 * mi + crow(reg, hh)) * 128 + 32 * nb + r32] = f2bf(acc[reg]);
                    }
                }
            }
            __syncthreads();
        }
    }
}

template <int PMODE> DI void p4_scan(const Params& p, LAS unsigned char* lds) {
    const int tid = otid(), lane = tid & 63, wave = __builtin_amdgcn_readfirstlane(tid >> 6);
    const int r32 = lane & 31, hh = lane >> 5;
    unsigned char* ws = p.ws;
    constexpr int ST = 59904, S_W = 0, S_QD = 16896, S_KDT = 33792, S_AT = 51200, L_OS = 2 * ST, OSB = 16896;
    static_assert(L_OS + 2 * OSB <= LDS_BYTES, "p4 lds");
    for (int bh = blockIdx.x; bh < 64; bh += gridDim.x) {
        const int b = bh >> 3, h = bh & 7;
        __syncthreads();
        if (wave >= 4) {
            const int lt_k = tid - 256;
            u32x4 rgA[14], rgB[14];
            auto issue = [&](u32x4 (&rg)[14], int n) {
                int lt = lt_k; asm volatile("" : "+v"(lt));
                const size_t ug = (size_t)bh * 64 + n;
                const bf16_t* pw = (const bf16_t*)(ws + WS_PW) + ug * 8192; const bf16_t* pq = (const bf16_t*)(ws + WS_PQD) + ug * 8192;
                const bf16_t* pk = (const bf16_t*)(ws + WS_PKDT) + ug * 8192; const bf16_t* pa = (const bf16_t*)(ws + WS_PAT) + ug * 4096;
#pragma unroll
                for (int k = 0; k < 4; ++k) { const int ci = lt + 256 * k; rg[k] = *(const u32x4*)(pw + ci * 8); rg[4 + k] = *(const u32x4*)(pq + ci * 8); rg[8 + k] = *(const u32x4*)(pk + ci * 8); }
#pragma unroll
                for (int k = 0; k < 2; ++k) { const int ci = lt + 256 * k; rg[12 + k] = *(const u32x4*)(pa + ci * 8); }
            };
            auto commit = [&](const u32x4 (&rg)[14], int st) {
                int lt = lt_k; asm volatile("" : "+v"(lt));
                LAS unsigned char* sb = lds + st * ST;
#pragma unroll
                for (int k = 0; k < 4; ++k) { const int ci = lt + 256 * k; const int row = ci >> 4, ch = ci & 15;
                    LAS u32x2* d0 = (LAS u32x2*)(sb + S_W + row * 264 + ch * 16); d0[0] = (u32x2){rg[k][0], rg[k][1]}; d0[1] = (u32x2){rg[k][2], rg[k][3]};
                    LAS u32x2* d1 = (LAS u32x2*)(sb + S_QD + row * 264 + ch * 16); d1[0] = (u32x2){rg[4 + k][0], rg[4 + k][1]}; d1[1] = (u32x2){rg[4 + k][2], rg[4 + k][3]};
                    const int row2 = ci >> 3, ch2 = ci & 7;
                    LAS u32x2* d2 = (LAS u32x2*)(sb + S_KDT + row2 * 136 + ch2 * 16); d2[0] = (u32x2){rg[8 + k][0], rg[8 + k][1]}; d2[1] = (u32x2){rg[8 + k][2], rg[8 + k][3]}; }
#pragma unroll
                for (int k = 0; k < 2; ++k) { const int ci = lt + 256 * k; const int row2 = ci >> 3, ch2 = ci & 7;
                    LAS u32x2* d3 = (LAS u32x2*)(sb + S_AT + row2 * 136 + ch2 * 16); d3[0] = (u32x2){rg[12 + k][0], rg[12 + k][1]}; d3[1] = (u32x2){rg[12 + k][2], rg[12 + k][3]}; }
            };
            auto ocopy = [&](int mstep) {
                int lt = lt_k; asm volatile("" : "+v"(lt));
                const int row = lt >> 2, part = lt & 3;
                const LAS unsigned char* ob = lds + L_OS + (mstep & 1) * OSB + row * 264 + part * 64;
                const size_t tok = (size_t)b * 4096 + mstep * 64 + row;
                bf16_t* yp = (bf16_t*)(ws + WS_RA) + tok * 1024 + h * 128 + part * 32;
#pragma unroll
                for (int e = 0; e < 4; ++e) { const u32x2 v0 = *(const LAS u32x2*)(ob + e * 16), v1 = *(const LAS u32x2*)(ob + e * 16 + 8); *(u32x4*)(yp + 8 * e) = (u32x4){v0[0], v0[1], v1[0], v1[1]}; }
            };
            issue(rgA, 0); commit(rgA, 0); issue(rgB, 1);
            __syncthreads();
            for (int n = 0; n <= 64; n += 2) {
                if (n + 2 < 64) issue(rgA, n + 2);
                if (PMODE == 0) { if (n >= 1) ocopy(n - 1); }
                if (n + 1 < 64) commit(rgB, (n + 1) & 1);
                __syncthreads();
                if (n + 1 <= 64) {
                    if (n + 3 < 64) issue(rgB, n + 3);
                    if (PMODE == 0) ocopy(n);
                    if (n + 2 < 64) commit(rgA, (n + 2) & 1);
                    __syncthreads();
                }
            }
        } else {
            const int sl = wave;
            f32x16 Sacc[4]; for (int kb = 0; kb < 4; ++kb) Sacc[kb] = zero16();
            u32x4 un[2][2]; float gln;
            auto uload = [&](int n) { const size_t ug = (size_t)bh * 64 + n;
                const bf16_t* up = (const bf16_t*)(ws + WS_PU) + (((ug * 4 + sl) * 2) * 64 + lane) * 16;
                un[0][0] = *(const u32x4*)up; un[0][1] = *(const u32x4*)(up + 8); un[1][0] = *(const u32x4*)(up + 1024); un[1][1] = *(const u32x4*)(up + 1032);
                gln = ((const float*)(ws + WS_GL))[ug]; };
            uload(0);
            __syncthreads();
            for (int n = 0; n <= 64; ++n) {
                if (n < 64 && PMODE != 1) {
                    const LAS unsigned char* sb = lds + (n & 1) * ST;
                    u32x4 uc[2][2]; uc[0][0] = un[0][0]; uc[0][1] = un[0][1]; uc[1][0] = un[1][0]; uc[1][1] = un[1][1]; const float gl = gln;
                    if (n + 1 < 64) uload(n + 1);
                    f32x16 vacc[2], qacc[2];
                    vacc[0] = zero16(); vacc[1] = zero16(); qacc[0] = zero16(); qacc[1] = zero16();
                    {
                        const LAS unsigned char* wrow = sb + S_W + r32 * 264 + hh * 8;
                        const LAS unsigned char* qrow = sb + S_QD + r32 * 264 + hh * 8;
#pragma unroll
                        for (int kb = 0; kb < 4; ++kb) {
                            bf16x8 fw[2][2], fq[2][2];
#pragma unroll
                            for (int s2 = 0; s2 < 2; ++s2)
#pragma unroll
                                for (int mi = 0; mi < 2; ++mi) { const int off = mi * 32 * 264 + (2 * kb + s2) * 32;
                                    fw[s2][mi] = lds2x64(wrow + off, wrow + off + 16); fq[s2][mi] = lds2x64(qrow + off, qrow + off + 16); }
                            const bf16x8 Sb0 = pack8(Sacc[kb], 0), Sb1 = pack8(Sacc[kb], 1);
                            __builtin_amdgcn_sched_barrier(0);
#pragma unroll
                            for (int mi = 0; mi < 2; ++mi) { vacc[mi] = MFMA32(fw[0][mi], Sb0, vacc[mi]); qacc[mi] = MFMA32(fq[0][mi], Sb0, qacc[mi]); }
#pragma unroll
                            for (int mi = 0; mi < 2; ++mi) { vacc[mi] = MFMA32(fw[1][mi], Sb1, vacc[mi]); qacc[mi] = MFMA32(fq[1][mi], Sb1, qacc[mi]); }
                        }
                    }
                    __builtin_amdgcn_sched_barrier(0);
                    bf16x8 Vb[4];
#pragma unroll
                    for (int mi = 0; mi < 2; ++mi) { f32x16 vn;
#pragma unroll
                        for (int e = 0; e < 4; ++e) { vn[2 * e] = bflo(uc[mi][0][e]) - vacc[mi][2 * e]; vn[2 * e + 1] = bfhi(uc[mi][0][e]) - vacc[mi][2 * e + 1];
                                                      vn[8 + 2 * e] = bflo(uc[mi][1][e]) - vacc[mi][8 + 2 * e]; vn[8 + 2 * e + 1] = bfhi(uc[mi][1][e]) - vacc[mi][8 + 2 * e + 1]; }
                        Vb[2 * mi] = pack8(vn, 0); Vb[2 * mi + 1] = pack8(vn, 1); }
                    {
                        bf16x8 fa[6];
                        const LAS unsigned char* arow = sb + S_AT + r32 * 136 + hh * 8;
                        fa[0] = lds2x64(arow, arow + 16); fa[1] = lds2x64(arow + 32, arow + 48);
#pragma unroll
                        for (int ks = 0; ks < 4; ++ks) fa[2 + ks] = lds2x64(arow + 32 * 136 + ks * 32, arow + 32 * 136 + ks * 32 + 16);
                        __builtin_amdgcn_sched_barrier(0);
                        qacc[0] = MFMA32(fa[0], Vb[0], qacc[0]); qacc[1] = MFMA32(fa[2], Vb[0], qacc[1]);
                        qacc[0] = MFMA32(fa[1], Vb[1], qacc[0]); qacc[1] = MFMA32(fa[3], Vb[1], qacc[1]);
                        qacc[1] = MFMA32(fa[4], Vb[2], qacc[1]); qacc[1] = MFMA32(fa[5], Vb[3], qacc[1]);
                    }
#pragma unroll
                    for (int kp = 0; kp < 2; ++kp) {
                        bf16x8 fk[2][4];
#pragma unroll
                        for (int k2 = 0; k2 < 2; ++k2)
#pragma unroll
                            for (int ks = 0; ks < 4; ++ks) { const LAS unsigned char* krow = sb + S_KDT + (32 * (2 * kp + k2) + r32) * 136 + hh * 8 + ks * 32; fk[k2][ks] = lds2x64(krow, krow + 16); }
                        f32x16 sn0 = Sacc[2 * kp] * gl, sn1 = Sacc[2 * kp + 1] * gl;
                        __builtin_amdgcn_sched_barrier(0);
#pragma unroll
                        for (int ks = 0; ks < 4; ++ks) { sn0 = MFMA32(fk[0][ks], Vb[ks], sn0); sn1 = MFMA32(fk[1][ks], Vb[ks], sn1); }
                        Sacc[2 * kp] = sn0; Sacc[2 * kp + 1] = sn1;
                    }
                    {
                        LAS bf16_t* ob = (LAS bf16_t*)(lds + L_OS + (n & 1) * OSB);
#pragma unroll
                        for (int mo = 0; mo < 2; ++mo)
#pragma unroll
                            for (int reg = 0; reg < 16; ++reg) ob[(32 * mo + crow(reg, hh)) * 132 + 32 * sl + r32] = f2bf(qacc[mo][reg]);
                    }
                }
                __syncthreads();
            }
        }
    }
}

DI void p4b_onorm(const Params& p) {
    const int tid = otid(), lane = tid & 63, wave = tid >> 6;
    bf16_t* ob = (bf16_t*)(p.ws + WS_RA);
    const bf16_t* zb = (const bf16_t*)p.out;
    const float* og = p.in[10] + (lane & 7) * 16;
    float g[16];
#pragma unroll
    for (int e = 0; e < 16; ++e) g[e] = og[e];
    for (int m = blockIdx.x * 8 + wave; m < M; m += gridDim.x * 8) {
        bf16_t* op = ob + (size_t)m * 1024 + lane * 16; const bf16_t* zp = zb + (size_t)m * 1024 + lane * 16;
        const u32x4 o0 = *(const u32x4*)op, o1 = *(const u32x4*)(op + 8), z0 = *(const u32x4*)zp, z1 = *(const u32x4*)(zp + 8);
        float ss = 0.f;
#pragma unroll
        for (int e = 0; e < 4; ++e) { const float a = bflo(o0[e]), b2 = bfhi(o0[e]), c = bflo(o1[e]), d = bfhi(o1[e]); ss += (a * a + b2 * b2) + (c * c + d * d); }
        ss += __shfl_xor(ss, 1); ss += __shfl_xor(ss, 2); ss += __shfl_xor(ss, 4);
        const float rstd = rsqrtf(ss * (1.f / 128.f) + EPS);
        u32x4 y0, y1;
#pragma unroll
        for (int e = 0; e < 4; ++e) {
            y0[e] = cvtpk(bflo(o0[e]) * rstd * g[2 * e] * siluf(bflo(z0[e])), bfhi(o0[e]) * rstd * g[2 * e + 1] * siluf(bfhi(z0[e])));
            y1[e] = cvtpk(bflo(o1[e]) * rstd * g[8 + 2 * e] * siluf(bflo(z1[e])), bfhi(o1[e]) * rstd * g[8 + 2 * e + 1] * siluf(bfhi(z1[e])));
        }
        *(u32x4*)op = y0; *(u32x4*)(op + 8) = y1;
    }
}

DI void p8_compress(const Params& p, LAS unsigned char* lds) {
    const int tid = otid(), lane = tid & 63, wave = __builtin_amdgcn_readfirstlane(tid >> 6);
    const int r32 = lane & 31, hh = lane >> 5;
    unsigned char* ws = p.ws;
    constexpr int L_AS = 0  , L_BS = 4608  , L_HS = L_BS + 36864  , L_C1 = L_HS + 16896  ;
    const bf16_t* kv = (const bf16_t*)(ws + WS_KV);
    for (int u = blockIdx.x; u < 256; u += gridDim.x) {
        const int which = u >> 7, bg = (u >> 3) & 15, nb = u & 7, b = bg >> 1, g = bg & 1;
        __syncthreads();
        if (tid < 256) { float a = 0.f; for (int kc = 0; kc < 16; ++kc) a += ((const float*)(ws + WS_C1P))[(kc * 2 + which) * 256 + tid]; ((LAS float*)(lds + L_C1))[tid] = a; }
        const bf16_t* w1t = (const bf16_t*)(ws + WS_W1T) + (size_t)which * 256 * 2048;
        f32x16 acc = zero16();
        for (int l = 0; l < 32; ++l) {
            __syncthreads();
            if (tid < 256) { const int row = tid >> 3, ch = tid & 7; int tk = 16 * (32 * nb + row) + l; tk = tk > 4095 ? 4095 : tk;
                *(LAS u32x4*)(lds + L_AS + row * 144 + ch * 16) = *(const u32x4*)(kv + ((size_t)b * 4096 + tk) * 768 + which * 128 + g * 64 + ch * 8); }
#pragma unroll
            for (int k = 0; k < 4; ++k) { const int ci = tid + 512 * k; const int row = ci >> 3, ch = ci & 7;
                *(LAS u32x4*)(lds + L_BS + row * 144 + ch * 16) = *(const u32x4*)(w1t + (size_t)row * 2048 + l * 64 + ch * 8); }
            __syncthreads();
            const LAS unsigned char* ab = lds + L_AS + r32 * 144 + hh * 16;
            const LAS unsigned char* bb = lds + L_BS + (32 * wave + r32) * 144 + hh * 16;
#pragma unroll
            for (int ks = 0; ks < 4; ++ks) acc = MFMA32(lds128(ab + ks * 32), lds128(bb + ks * 32), acc);
        }
        {
            const float c1 = ((LAS float*)(lds + L_C1))[32 * wave + r32];
#pragma unroll
            for (int reg = 0; reg < 16; ++reg) *(LAS bf16_t*)(lds + L_HS + crow(reg, hh) * 528 + (32 * wave + r32) * 2) = f2bf(siluf(acc[reg] + c1));
        }
        __syncthreads();
        if (wave < 2) {
            const bf16_t* w2t = (const bf16_t*)(ws + WS_W2T) + (size_t)(which * 64 + 32 * wave + r32) * 256 + hh * 8;
            const LAS unsigned char* ab = lds + L_HS + r32 * 528 + hh * 16;
            f32x16 o = zero16();
#pragma unroll
            for (int ks = 0; ks < 16; ++ks) o = MFMA32(lds128(ab + ks * 32), *(const bf16x8*)(w2t + ks * 16), o);
            bf16_t* dst = (bf16_t*)(ws + WS_CMP) + (size_t)(which * 16 + bg) * 256 * 64;
#pragma unroll
            for (int reg = 0; reg < 16; ++reg) { const int n = 32 * nb + crow(reg, hh); dst[n * 64 + 32 * wave + r32] = (n < 255) ? f2bf(o[reg]) : (bf16_t)0; }
        }
    }
}

__device__ const unsigned char T5_BUCKET[128] = {0, 1, 2, 3, 4, 5, 6, 7, 8, 9, 10, 11, 12, 13, 14, 15, 16, 16, 16, 17, 17, 18, 18, 18, 19, 19, 19, 20, 20, 20, 20, 21, 21, 21, 21, 22, 22, 22, 22, 22, 23, 23, 23, 23, 23, 23, 24, 24, 24, 24, 24, 24, 25, 25, 25, 25, 25, 25, 25, 26, 26, 26, 26, 26, 26, 26, 26, 27, 27, 27, 27, 27, 27, 27, 27, 27, 27, 28, 28, 28, 28, 28, 28, 28, 28, 28, 28, 29, 29, 29, 29, 29, 29, 29, 29, 29, 29, 29, 29, 30, 30, 30, 30, 30, 30, 30, 30, 30, 30, 30, 30, 30, 30, 31, 31, 31, 31, 31, 31, 31, 31, 31, 31, 31, 31, 31, 31, 31};
constexpr float NEGBIG = -1e30f;

DI void p9_nsa(const Params& p, LAS unsigned char* lds) {
    const int tid0 = otid(); const int lane_k = tid0 & 63, wave = __builtin_amdgcn_readfirstlane(tid0 >> 6);
    unsigned char* ws = p.ws;
    constexpr int STG = 17920, L_K = 0, L_V = 9216, L_BT = 2 * STG, L_IA = L_BT + 4224, L_IB = L_IA + 8192, L_Y = L_IB + 8704;
    static_assert(L_Y + 65536 <= LDS_BYTES, "p9 lds");
    constexpr float LOG2E = 1.4426950408889634f;
    LAS float* YL = (LAS float*)(lds + L_Y) + wave * 2048;
    LAS float* BT = (LAS float*)(lds + L_BT);
    LAS float* IA = (LAS float*)(lds + L_IA) + wave * 256;
    LAS float* IB = (LAS float*)(lds + L_IB) + wave * 272;
    const bf16_t* kvb = (const bf16_t*)(ws + WS_KV);
    const bf16_t* cmpb = (const bf16_t*)(ws + WS_CMP);
    const bf16_t* projb = (const bf16_t*)(ws + WS_PROJB);
    const float* gates = (const float*)(ws + WS_GATES);
    const float* relb = p.in[2];
    for (int vc = blockIdx.x; vc < 256; vc += gridDim.x) {
        const int bg = vc >> 4, kk16 = vc & 15, b = bg >> 1, g = bg & 1;
        for (int ju = 0; ju < 8; ++ju) {
            int lane = lane_k; asm volatile("" : "+v"(lane));
            const int tid = wave * 64 + lane, r32 = lane & 31, hh = lane >> 5, tok = r32 >> 3, hd = r32 & 7;
            const int srow = tid >> 3, sch = tid & 7;
            const int ub = (ju & 1) ? (32 * (ju >> 1) + 31 - kk16) : (32 * (ju >> 1) + kk16);
            const int t0 = 32 * ub, cur = ub >> 1;
            const int tq = t0 + 4 * wave + tok, head = g * 8 + hd;
            const int tqw = t0 + 4 * wave;
            const size_t trow = (size_t)b * 4096 + tq;
            __syncthreads();
            for (int idx = tid; idx < 1040; idx += 512) { const int hd_ = idx / 130, e = idx - hd_ * 130;
                BT[idx] = (e == 0) ? NEGBIG : relb[(e == 129 ? 31 : (int)T5_BUCKET[e - 1]) * 16 + g * 8 + hd_] * LOG2E; }
            for (int idx = lane; idx < 256; idx += 64) IA[idx] = 0.f;
            for (int idx = lane; idx < 272; idx += 64) IB[idx] = 0.f;
            const float bfar = relb[31 * 16 + head] * LOG2E;
            bf16x8 Qf[4];
#pragma unroll
            for (int ks = 0; ks < 4; ++ks) Qf[ks] = *(const bf16x8*)(projb + trow * 4096 + head * 64 + 16 * ks + 8 * hh);
            const int nct = (ub >> 5) + 1;
            const int wlo = (t0 - 511) > 0 ? ((t0 - 511) >> 6) : 0;
            const int nwin = cur - wlo + 1;
            const int NT = 2 * nct + (cur + 1) + nwin;
            u32x4 kregA, vregA, kregB, vregB;
            auto tload = [&](u32x4& kreg, u32x4& vreg, int i) {
                const bf16_t *kp, *vp; int stride;
                if (i < 2 * nct) { const int ti = i < nct ? i : i - nct; kp = cmpb + ((size_t)(0 * 16 + bg) * 256 + 64 * ti) * 64; vp = cmpb + ((size_t)(1 * 16 + bg) * 256 + 64 * ti) * 64; stride = 64; }
                else if (i < 2 * nct + cur + 1) { const int s_ = i - 2 * nct; kp = kvb + ((size_t)b * 4096 + 64 * s_) * 768 + 256 + g * 64; vp = kp + 128; stride = 768; }
                else { const int blk = cur - (i - 2 * nct - cur - 1); kp = kvb + ((size_t)b * 4096 + 64 * blk) * 768 + 512 + g * 64; vp = kp + 128; stride = 768; }
                kreg = *(const u32x4*)(kp + (size_t)srow * stride + sch * 8); vreg = *(const u32x4*)(vp + (size_t)srow * stride + sch * 8);
            };
            auto twrite = [&](const u32x4& kreg, const u32x4& vreg, int st) {
                *(LAS u32x4*)(lds + st * STG + L_K + srow * 144 + sch * 16) = kreg;
                LAS bf16_t* vt = (LAS bf16_t*)(lds + st * STG + L_V);
#pragma unroll
                for (int e = 0; e < 4; ++e) { vt[(8 * sch + 2 * e) * 68 + srow] = (bf16_t)(vreg[e] & 0xffffu); vt[(8 * sch + 2 * e + 1) * 68 + srow] = (bf16_t)(vreg[e] >> 16); }
            };
            tload(kregA, vregA, 0); twrite(kregA, vregA, 0);
            if (NT > 1) tload(kregB, vregB, 1);
            __syncthreads();
            float m_run = NEGBIG, l_run = 0.f, m_c = NEGBIG, linv_c = 0.f;
            f32x16 O[2]; O[0] = zero16(); O[1] = zero16();
            unsigned long long mymask = 0ull, wmask = 0ull;
            auto finalize = [&](int br, bool normalized) {
                float inv = 1.f;
                if (!normalized) { const float L = l_run + __shfl_xor(l_run, 32); inv = 1.f / fmaxf(L, 1e-30f); }
                const float gt = gates[trow * 48 + br * 16 + head] * inv;
                const bf16_t* zp = projb + trow * 4096 + 1024 + br * 1024 + head * 64;
#pragma unroll
                for (int db = 0; db < 2; ++db)
#pragma unroll
                    for (int gi = 0; gi < 4; ++gi) { const u32x2 zv = *(const u32x2*)(zp + 32 * db + 8 * gi + 4 * hh);
                        LAS float* yl = YL + (db * 16 + 4 * gi) * 64 + lane;
                        const float c0 = gt * O[db][4 * gi + 0] * siluf(bflo(zv[0])), c1 = gt * O[db][4 * gi + 1] * siluf(bfhi(zv[0]));
                        const float c2 = gt * O[db][4 * gi + 2] * siluf(bflo(zv[1])), c3 = gt * O[db][4 * gi + 3] * siluf(bfhi(zv[1]));
                        if (br == 0) { yl[0] = c0; yl[64] = c1; yl[128] = c2; yl[192] = c3; }
                        else { yl[0] += c0; yl[64] += c1; yl[128] += c2; yl[192] += c3; } }
                O[0] = zero16(); O[1] = zero16(); m_run = NEGBIG; l_run = 0.f;
            };
            auto tile_body_p = [&](auto KT, auto MD, auto PAR, const int i, const int tix) {
                constexpr int kind = decltype(KT)::value; constexpr int mode = decltype(MD)::value; constexpr int par = decltype(PAR)::value;
                if (i + 2 < NT) { if constexpr (par) tload(kregB, vregB, i + 2); else tload(kregA, vregA, i + 2); }
                const LAS unsigned char* sb = lds + (i & 1) * STG;
                const bool skip = (kind == 2) && (((wmask >> tix) & 1ull) == 0ull);
                if (!skip) {
                    bf16x8 kf[8];
#pragma unroll
                    for (int kb = 0; kb < 2; ++kb)
#pragma unroll
                        for (int ks = 0; ks < 4; ++ks) kf[kb * 4 + ks] = lds128(sb + L_K + (32 * kb + r32) * 144 + hh * 16 + ks * 32);
                    __builtin_amdgcn_sched_barrier(0);
                    f32x16 st[2];
#pragma unroll
                    for (int kb = 0; kb < 2; ++kb) { st[kb] = zero16();
#pragma unroll
                        for (int ks = 0; ks < 4; ++ks) st[kb] = MFMA32(kf[kb * 4 + ks], Qf[ks], st[kb]); }
                    bf16x8 vf[8];
                    if constexpr (kind != 0) {
#pragma unroll
                        for (int db = 0; db < 2; ++db)
#pragma unroll
                            for (int ks = 0; ks < 4; ++ks) { const LAS unsigned char* vr = sb + L_V + (32 * db + r32) * 136 + hh * 8 + ks * 32; vf[db * 4 + ks] = lds2x64(vr, vr + 16); }
                    }
                    __builtin_amdgcn_sched_barrier(0);
                    const bool selected = (kind != 2) || (((mymask >> tix) & 1ull) != 0ull);
                    float mx = NEGBIG;
                    if constexpr (mode == 1) {
                        int dbase = (kind <= 1) ? (tq - 30 - 1024 * tix - 64 * hh) : (tq + 1 - 64 * tix - 4 * hh);
                        asm volatile("" : "+v"(dbase));
                        constexpr int dmul = (kind <= 1) ? 16 : 1;
                        const LAS float* btl = BT + hd * 130;
#pragma unroll
                        for (int kb = 0; kb < 2; ++kb)
#pragma unroll
                            for (int reg = 0; reg < 16; ++reg) {
                                const int dr_ = dbase - dmul * (32 * kb + (reg & 3) + 8 * (reg >> 2)); const int di = dr_ < 0 ? 0 : (dr_ > 129 ? 129 : dr_);
                                const float sv = st[kb][reg] + btl[di];
                                st[kb][reg] = sv; mx = fmaxf(mx, sv);
                            }
                        if (!selected) mx = NEGBIG;
                    } else if constexpr (mode == 2) {
                        int dbase = tq - 64 * tix - 4 * hh; asm volatile("" : "+v"(dbase));
#pragma unroll
                        for (int kb = 0; kb < 2; ++kb)
#pragma unroll
                            for (int reg = 0; reg < 16; ++reg) {
                                const int dist = dbase - (32 * kb + (reg & 3) + 8 * (reg >> 2));
                                const float sv = dist < 512 ? st[kb][reg] + bfar : NEGBIG;
                                st[kb][reg] = sv; mx = fmaxf(mx, sv);
                            }
                    } else {
#pragma unroll
                        for (int kb = 0; kb < 2; ++kb)
#pragma unroll
                            for (int reg = 0; reg < 16; ++reg) mx = fmaxf(mx, st[kb][reg]);
                        mx = selected ? mx + bfar : NEGBIG;
                    }
                    if constexpr (kind != 1) {
                        mx = fmaxf(mx, __shfl_xor(mx, 32));
                        const float mnew = fmaxf(m_run, mx);
                        const float alpha = __builtin_amdgcn_exp2f(m_run - mnew);
                        const float msub = selected ? (mode == 0 ? mnew - bfar : mnew) : 1e30f;
                        float ls = 0.f;
#pragma unroll
                        for (int kb = 0; kb < 2; ++kb)
#pragma unroll
                            for (int reg = 0; reg < 16; ++reg) { const float pe = __builtin_amdgcn_exp2f(st[kb][reg] - msub); st[kb][reg] = pe; ls += pe; }
                        l_run = l_run * alpha + ls; m_run = mnew;
                        if constexpr (kind != 0) { if (__ballot(alpha != 1.f) != 0ull) { O[0] = O[0] * alpha; O[1] = O[1] * alpha; } }
                    } else {
#pragma unroll
                        for (int kb = 0; kb < 2; ++kb) {
#pragma unroll
                            for (int reg = 0; reg < 16; ++reg) st[kb][reg] = __builtin_amdgcn_exp2f(st[kb][reg] - m_c) * linv_c;
#pragma unroll
                            for (int gi = 0; gi < 4; ++gi) {
                                float a = 2.f * (st[kb][4 * gi] + st[kb][4 * gi + 1] + st[kb][4 * gi + 2]) + st[kb][4 * gi + 3], bq = st[kb][4 * gi + 3];
                                a += __shfl_xor(a, 1); a += __shfl_xor(a, 2); a += __shfl_xor(a, 4);
                                bq += __shfl_xor(bq, 1); bq += __shfl_xor(bq, 2); bq += __shfl_xor(bq, 4);
                                const int sidx = 16 * tix + 8 * kb + 2 * gi + hh;
                                if (hd == 0) { IA[tok * 64 + sidx] = a; IB[tok * 68 + sidx + 1] = bq; }
                            }
                        }
                    }
                    if constexpr (kind != 0) {
                        bf16x8 Pf[4];
#pragma unroll
                        for (int kb = 0; kb < 2; ++kb) { Pf[2 * kb] = pack8(st[kb], 0); Pf[2 * kb + 1] = pack8(st[kb], 1); }
                        __builtin_amdgcn_sched_barrier(0);
#pragma unroll
                        for (int ks = 0; ks < 4; ++ks)
#pragma unroll
                            for (int db = 0; db < 2; ++db) O[db] = MFMA32(vf[db * 4 + ks], Pf[ks], O[db]);
                    }
                }
                __builtin_amdgcn_sched_barrier(0);
                if (i + 1 < NT) { if constexpr (par) twrite(kregA, vregA, (i + 1) & 1); else twrite(kregB, vregB, (i + 1) & 1); }
                __syncthreads();
            };
            auto tile_body = [&](auto KT, auto MD, const int i, const int tix) {
                if (i & 1) tile_body_p(KT, MD, std::integral_constant<int, 1>{}, i, tix); else tile_body_p(KT, MD, std::integral_constant<int, 0>{}, i, tix);
            };
            using IC0 = std::integral_constant<int, 0>; using IC1 = std::integral_constant<int, 1>; using IC2 = std::integral_constant<int, 2>; using IC3 = std::integral_constant<int, 3>;
            int ti = 0;
#pragma unroll 1
            for (int t = 0; t < nct; ++t, ++ti) tile_body(IC0{}, IC1{}, ti, t);
            { const float L = l_run + __shfl_xor(l_run, 32); m_c = m_run; linv_c = (tq >= 31) ? 1.f / fmaxf(L, 1e-30f) : 0.f; m_run = NEGBIG; l_run = 0.f; }
#pragma unroll 1
            for (int t = 0; t < nct; ++t, ++ti) tile_body(IC1{}, IC1{}, ti, t);
            finalize(0, true);
            {
                wmask = 0ull; mymask = 0ull;
#pragma unroll 1
                for (int tk = 0; tk < 4; ++tk) {
                    float v = IA[tk * 64 + lane] + IB[tk * 68 + lane];
                    if (lane == 0 || lane == cur || lane == cur - 1) v = 1e9f; else if (lane > cur) v = -1e9f;
                    int rank = 0;
#pragma unroll 8
                    for (int j = 0; j < 64; ++j) { const float vj = __shfl(v, j); rank += ((vj > v) || (vj == v && j < lane)) ? 1 : 0; }
                    const unsigned long long mk = __ballot(rank < 16);
                    wmask |= mk; if (tok == tk) mymask = mk;
                }
            }
            const int nfar_s = (tqw - 176 >= 0) ? ((tqw - 176) >> 6) + 1 : 0;
#pragma unroll 1
            for (int t = 0; t <= cur; ++t, ++ti) { if (t < nfar_s) tile_body(IC2{}, IC0{}, ti, t); else tile_body(IC2{}, IC1{}, ti, t); }
            finalize(1, false);
#pragma unroll 1
            for (int t = 0; t < nwin; ++t, ++ti) { const int blk = cur - t;
                const bool oldw = (tqw + 3 - 64 * blk > 511), nearw = (tqw - 64 * blk - 63 < 113);
                if (oldw) tile_body(IC3{}, IC2{}, ti, blk); else if (nearw) tile_body(IC3{}, IC1{}, ti, blk); else tile_body(IC3{}, IC0{}, ti, blk); }
            finalize(2, false);
            bf16_t* yp = (bf16_t*)(ws + WS_RA) + trow * 1024 + head * 64;
#pragma unroll
            for (int db = 0; db < 2; ++db)
#pragma unroll
                for (int gi = 0; gi < 4; ++gi) { const LAS float* yl = YL + (db * 16 + 4 * gi) * 64 + lane; u32x2 o; o.x = cvtpk(yl[0], yl[64]); o.y = cvtpk(yl[128], yl[192]);
                    *(u32x2*)(yp + 32 * db + 8 * gi + 4 * hh) = o; }
        }
    }
}

DI void p11_final(const Params& p) {
    const int tid = otid(), lane = tid & 63, wave = tid >> 6;
    const float* ssq = (const float*)(p.ws + WS_SSQ);
    for (int m = blockIdx.x * 8 + wave; m < M; m += gridDim.x * 8) {
        float s = 0.f;
#pragma unroll
        for (int j = 0; j < 16; ++j) s += ssq[(size_t)j * M + m];
        const float rstd = rsqrtf(s * (1.f / 1024.f) + EPS);
        f32x4* xr = (f32x4*)(p.out + (size_t)m * 1024) + lane;
#pragma unroll
        for (int j = 0; j < 4; ++j) { const f32x4 g4 = *((const f32x4*)p.in[22] + lane + 64 * j); xr[64 * j] = xr[64 * j] * rstd * g4; }
    }
}

template <int PH> DI void run_phase(const Params& p, LAS unsigned char* lds) {
    unsigned char* ws = p.ws;
    const int G = gridDim.x;
    bf16_t* h0 = (bf16_t*)((unsigned char*)p.out + 64 * MiB);
    if constexpr (PH == 0) p0_prologue(p, lds);
    if constexpr (PH == 1) norm_rows<0>(p, lds);
    if constexpr (PH == 2 || PH == 4) {
        constexpr int half = (PH - 2) / 2;
        pg8::Gemm g{h0, h0 + (size_t)half * 16384 * 1024, 0, (const bf16_t*)(ws + WS_WA), 16384, 4096, 1024}; pg8::StaticOrder S; S.init(16384, 4096, G, (int)blockIdx.x);
        EpiA E{(bf16_t*)(ws + WS_RA), (bf16_t*)p.out, half * 16384};
        pg8::gemm_phase<EpiA, true>(lds, g, S, E);
    }
    if constexpr (PH == 3 || PH == 5) p3_prep(p, lds, (PH - 3) / 2);
    if constexpr (PH == 6) p4_scan<0>(p, lds);
    if constexpr (PH == 14) p4b_onorm(p);
    if constexpr (PH == 100) p4_scan<1>(p, lds);
    if constexpr (PH == 101) p4_scan<2>(p, lds);
    if constexpr (PH == 7) {
        const bf16_t* ya = (const bf16_t*)(ws + WS_RA);
        pg8::Gemm g{ya, ya, 0, (const bf16_t*)(ws + WS_WAO), M, 1024, 1024}; pg8::StaticOrder S; S.init(M, 1024, G, (int)blockIdx.x);
        EpiRes<false> E{p.in[0], p.out, (const float*)(ws + WS_MOD), nullptr};
        pg8::gemm_phase<EpiRes<false>, true>(lds, g, S, E);
    }
    if constexpr (PH == 8) norm_rows<1>(p, lds);
    if constexpr (PH == 9) {
        pg8::Gemm g{(const bf16_t*)(ws + WS_S), (const bf16_t*)(ws + WS_RA), 3, (const bf16_t*)(ws + WS_WCAT), M, 5120, 1024}; pg8::StaticOrder S; S.init(M, 5120, G, (int)blockIdx.x);
        EpiB E{(bf16_t*)(ws + WS_KV), (bf16_t*)(ws + WS_PROJB), (float*)(ws + WS_GATES)};
        pg8::gemm_phase<EpiB, true>(lds, g, S, E);
    }
    if constexpr (PH == 10) p8_compress(p, lds);
    if constexpr (PH == 11) p9_nsa(p, lds);
    if constexpr (PH == 12) {
        const bf16_t* yb = (const bf16_t*)(ws + WS_RA);
        pg8::Gemm g{yb, yb, 0, (const bf16_t*)(ws + WS_WBO), M, 1024, 1024}; pg8::StaticOrder S; S.init(M, 1024, G, (int)blockIdx.x);
        EpiRes<true> E{p.out, p.out, (const float*)(ws + WS_MOD) + 8 * 3072, (float*)(ws + WS_SSQ)};
        pg8::gemm_phase<EpiRes<true>, true>(lds, g, S, E);
    }
    if constexpr (PH == 13) p11_final(p);
}
#if MK_ONE_LAUNCH
__global__ void __launch_bounds__(512, 2) fwd_kernel(Params p) {
    extern __shared__ __attribute__((aligned(16))) unsigned char lds_raw[];
    LAS unsigned char* lds = (LAS unsigned char*)lds_raw;
    volatile LAS unsigned* misc = (volatile LAS unsigned*)(lds + LDS_BYTES - 64);
    if (threadIdx.x < 16) misc[threadIdx.x] = 0u;
    __syncthreads();
    XcdBarrier bar = xcd_barrier_post((unsigned*)(p.ws + WS_CTL) + 1024, misc);
    run_phase<0>(p, lds); xcd_barrier(bar); if (DUP_MASK & (1 << 0)) { run_phase<0>(p, lds); xcd_barrier(bar); }
    run_phase<1>(p, lds); xcd_barrier(bar); if (DUP_MASK & (1 << 1)) { run_phase<1>(p, lds); xcd_barrier(bar); }
    run_phase<2>(p, lds); xcd_barrier(bar); if (DUP_MASK & (1 << 2)) { run_phase<2>(p, lds); xcd_barrier(bar); }
    run_phase<3>(p, lds); xcd_barrier(bar); if (DUP_MASK & (1 << 3)) { run_phase<3>(p, lds); xcd_barrier(bar); }
    run_phase<4>(p, lds); xcd_barrier(bar); if (DUP_MASK & (1 << 4)) { run_phase<4>(p, lds); xcd_barrier(bar); }
    run_phase<5>(p, lds); xcd_barrier(bar); if (DUP_MASK & (1 << 5)) { run_phase<5>(p, lds); xcd_barrier(bar); }
    run_phase<6>(p, lds); xcd_barrier(bar); if (DUP_MASK & (1 << 6)) { run_phase<6>(p, lds); xcd_barrier(bar); }
#if defined(PROBE_SCAN)
    run_phase<PROBE_SCAN>(p, lds); xcd_barrier(bar);
#endif
    run_phase<14>(p, lds); xcd_barrier(bar);
    run_phase<7>(p, lds); xcd_barrier(bar); if (DUP_MASK & (1 << 7)) { run_phase<7>(p, lds); xcd_barrier(bar); }
    run_phase<8>(p, lds); xcd_barrier(bar); if (DUP_MASK & (1 << 8)) { run_phase<8>(p, lds); xcd_barrier(bar); }
    run_phase<9>(p, lds); xcd_barrier(bar); if (DUP_MASK & (1 << 9)) { run_phase<9>(p, lds); xcd_barrier(bar); }
    run_phase<10>(p, lds); xcd_barrier(bar); if (DUP_MASK & (1 << 10)) { run_phase<10>(p, lds); xcd_barrier(bar); }
    run_phase<11>(p, lds); xcd_barrier(bar); if (DUP_MASK & (1 << 11)) { run_phase<11>(p, lds); xcd_barrier(bar); }
    run_phase<12>(p, lds); xcd_barrier(bar); if (DUP_MASK & (1 << 12)) { run_phase<12>(p, lds); xcd_barrier(bar); }
    run_phase<13>(p, lds);
}
#else
template <int PH> __global__ void __launch_bounds__(512, 2) phase_kernel(Params p) {
    extern __shared__ __attribute__((aligned(16))) unsigned char lds_raw[];
    run_phase<PH>(p, (LAS unsigned char*)lds_raw);
}
template <int PH> static void launch_phase(const Params& a, int grid, hipStream_t stream) {
    static bool attr = false;
    if (!attr) { (void)hipFuncSetAttribute((const void*)phase_kernel<PH>, hipFuncAttributeMaxDynamicSharedMemorySize, LDS_BYTES); attr = true; }
    hipLaunchKernelGGL(phase_kernel<PH>, dim3(grid), dim3(512), LDS_BYTES, stream, a);
}
#endif

extern "C" void kernel_launch(void* const* d_in, const int* in_sizes, int n_in, void* d_out, int out_size, void* d_ws, size_t ws_size, hipStream_t stream) {
    static int grid = 0;
    if (grid == 0) {
        if (n_in != 23 || out_size != M * D || ws_size < WS_END) { fprintf(stderr, "kernel_launch: unexpected shapes (n_in %d out %d ws %zu)\n", n_in, out_size, ws_size); grid = -1; return; }
        int dev = 0, cus = 0;
        if (hipGetDevice(&dev) != hipSuccess || hipDeviceGetAttribute(&cus, hipDeviceAttributeMultiprocessorCount, dev) != hipSuccess) { grid = -1; return; }
#if MK_ONE_LAUNCH
        if (hipFuncSetAttribute((const void*)fwd_kernel, hipFuncAttributeMaxDynamicSharedMemorySize, LDS_BYTES) != hipSuccess) { fprintf(stderr, "kernel_launch: hipFuncSetAttribute failed\n"); grid = -1; return; }
        int per_cu = 0;
        if (hipOccupancyMaxActiveBlocksPerMultiprocessor(&per_cu, (const void*)fwd_kernel, 512, LDS_BYTES) != hipSuccess || per_cu < 1) fprintf(stderr, "kernel_launch: occupancy query says %d\n", per_cu);
        (void)hipGetLastError();
#endif
        grid = cus;
    }
    if (grid < 0) return;
    Params a{};
    for (int i = 0; i < 23; ++i) a.in[i] = (const float*)d_in[i];
    a.out = (float*)d_out; a.ws = (unsigned char*)d_ws;
    a.ph_lo = 0; a.ph_hi = NPH;
#if MK_ONE_LAUNCH
    hipMemsetAsync((char*)d_ws + WS_CTL, 0, 65536, stream);
    hipLaunchKernelGGL(fwd_kernel, dim3(grid), dim3(512), LDS_BYTES, stream, a);
#else
    launch_phase<0>(a, grid, stream); launch_phase<1>(a, grid, stream); launch_phase<2>(a, grid, stream); launch_phase<3>(a, grid, stream);
    launch_phase<4>(a, grid, stream); launch_phase<5>(a, grid, stream); launch_phase<6>(a, grid, stream); launch_phase<14>(a, grid, stream); launch_phase<7>(a, grid, stream);
    launch_phase<8>(a, grid, stream); launch_phase<9>(a, grid, stream); launch_phase<10>(a, grid, stream); launch_phase<11>(a, grid, stream);
    launch_phase<12>(a, grid, stream); launch_phase<13>(a, grid, stream);
#endif
}
```

```cpp
#include <hip/hip_runtime.h>
#include <cstdio>
#include <cstdint>
#include <type_traits>

#define DI __device__ __forceinline__
#define LAS __attribute__((address_space(3)))
typedef unsigned short bf16_t;
typedef short bf16x8 __attribute__((ext_vector_type(8)));
typedef short s16x4 __attribute__((ext_vector_type(4)));
typedef float f32x4 __attribute__((ext_vector_type(4)));
typedef float f32x2 __attribute__((ext_vector_type(2)));
typedef float f32x16 __attribute__((ext_vector_type(16)));
typedef unsigned u32x4 __attribute__((ext_vector_type(4)));
typedef unsigned u32x2 __attribute__((ext_vector_type(2)));
typedef __bf16 bf16x2_t __attribute__((ext_vector_type(2)));

#ifndef DUP_MASK
#define DUP_MASK 0
#endif
#ifndef MK_ONE_LAUNCH
#define MK_ONE_LAUNCH 1
#endif

constexpr int NB = 8, T = 4096, D = 1024, M = NB * T;
constexpr int A_LD = 4112, B_LD = 4144;
constexpr float EPS = 1e-6f;
constexpr int NPH = 14;

constexpr size_t MiB = 1u << 20;
constexpr size_t WS_CTL = 0;
constexpr size_t WS_MODP = 1 * MiB;
constexpr size_t WS_WA = 4 * MiB;
constexpr size_t WS_WAO = 12 * MiB;
constexpr size_t WS_WCAT = 14 * MiB;
constexpr size_t WS_WBO = 24 * MiB;
constexpr size_t WS_W1T = 26 * MiB;
constexpr size_t WS_W2T = 28 * MiB;
constexpr size_t WS_C1P = 28 * MiB + 65536;
constexpr size_t WS_MOD = 28 * MiB + 131072;
constexpr size_t WS_SSQ = 28 * MiB + 524288;
constexpr size_t WS_BG = 31 * MiB;
constexpr size_t WS_GL = 33 * MiB;
constexpr size_t WS_RA = 34 * MiB;
constexpr size_t WS_RP = 130 * MiB;
constexpr size_t WS_PW = WS_RP;
constexpr size_t WS_PQD = WS_RP + 64 * MiB;
constexpr size_t WS_PKDT = WS_RP + 128 * MiB;
constexpr size_t WS_PU = WS_RP + 192 * MiB;
constexpr size_t WS_PAT = WS_RP + 256 * MiB;
constexpr size_t WS_PROJB = WS_RP;
constexpr size_t WS_S = WS_RP + 256 * MiB;
constexpr size_t WS_KV = WS_RP + 320 * MiB;
constexpr size_t WS_GATES = WS_RP + 368 * MiB;
constexpr size_t WS_CMP = WS_RP + 374 * MiB;
constexpr size_t WS_END = WS_RP + 375 * MiB;
constexpr size_t WS_VT = WS_RA + 64 * MiB;

constexpr int LDS_BYTES = 155648;

DI unsigned cvtpk(float lo, float hi) { f32x2 v = {lo, hi}; bf16x2_t b = __builtin_convertvector(v, bf16x2_t); return __builtin_bit_cast(unsigned, b); }
DI bf16_t f2bf(float f) { return (bf16_t)(cvtpk(f, 0.f) & 0xffffu); }
DI float bf2f(bf16_t v) { return __uint_as_float((unsigned)v << 16); }
DI float bflo(unsigned u) { return __uint_as_float(u << 16); }
DI float bfhi(unsigned u) { return __uint_as_float(u & 0xffff0000u); }
DI float sigm(float x) { return __builtin_amdgcn_rcpf(1.f + __builtin_amdgcn_exp2f(-1.4426950408889634f * x)); }
DI float siluf(float x) { return x * sigm(x); }
DI float wave_sum(float v) {
#pragma unroll
    for (int o = 1; o < 64; o <<= 1) v += __shfl_xor(v, o);
    return v;
}
DI int crow(int reg, int h) { return (reg & 3) + 8 * (reg >> 2) + 4 * h; }
#define MFMA32(a, b, c) __builtin_amdgcn_mfma_f32_32x32x16_bf16((a), (b), (c), 0, 0, 0)
DI bf16x8 pack8(const f32x16& x, const int s) {
    u32x4 p;
    p[0] = cvtpk(x[8 * s + 0], x[8 * s + 1]); p[1] = cvtpk(x[8 * s + 2], x[8 * s + 3]);
    p[2] = cvtpk(x[8 * s + 4], x[8 * s + 5]); p[3] = cvtpk(x[8 * s + 6], x[8 * s + 7]);
    return __builtin_bit_cast(bf16x8, p);
}
DI bf16x8 lds128(const LAS unsigned char* p) { return *(const LAS bf16x8*)p; }
DI bf16x8 lds2x64(const LAS unsigned char* lo, const LAS unsigned char* hi) {
    const s16x4 a = *(const LAS s16x4*)lo, b = *(const LAS s16x4*)hi;
    return __builtin_shufflevector(a, b, 0, 1, 2, 3, 4, 5, 6, 7);
}
DI int otid() { int t = threadIdx.x; asm volatile("" : "+v"(t)); return t; }
DI f32x16 zero16() { f32x16 z; for (int i = 0; i < 16; ++i) z[i] = 0.f; return z; }

struct Params { const float* in[23]; float* out; unsigned char* ws; int ph_lo, ph_hi, pad0, pad1; };

#define XB_TMO      128
#define XB_XCNT(j)  (256  + 64 * (j))
#define XB_XSUB(j)  (1280 + 64 * (j))
#define XB_XGEN(j)  (2304 + 64 * (j))
#define XB_TOP      3328
#define XB_TOPGEN   3392
#define XCD_BAR_WORDS 3456
#define XB_SPIN_CAP (1u << 22)
DI unsigned xb_ld(unsigned* p)              { return __hip_atomic_load(p, __ATOMIC_RELAXED, __HIP_MEMORY_SCOPE_AGENT); }
DI unsigned xb_add(unsigned* p, unsigned v) { return __hip_atomic_fetch_add(p, v, __ATOMIC_RELAXED, __HIP_MEMORY_SCOPE_AGENT); }
DI unsigned xb_xcc_id() { return (unsigned)__builtin_amdgcn_s_getreg((3 << 11) | 20) & 0xFu; }
#define XB_SPIN(cond, bar) do { unsigned _sp = 0; while (cond) { __builtin_amdgcn_s_sleep(1); \
    if ((++_sp & 255u) == 0u) { if (xb_ld(&(bar)[XB_TMO])) break; if (_sp > XB_SPIN_CAP) { atomicAdd(&(bar)[XB_TMO], 1u); break; } } } } while (0)
struct XcdBarrier { unsigned* bar; unsigned x; volatile LAS unsigned* st; };
DI XcdBarrier xcd_barrier_post(unsigned* bar, volatile LAS unsigned* st) {
    XcdBarrier b; b.bar = bar; b.x = xb_xcc_id(); b.st = st;
    if (threadIdx.x == 0) (void)xb_add(&bar[XB_XCNT(b.x)], 1u);
    return b;
}
DI void xcd_barrier_complete(unsigned* bar, unsigned x, unsigned& nloc, unsigned& nx) {
    const unsigned G = gridDim.x * gridDim.y * gridDim.z;
    unsigned sum, cnt, mine, sp = 0u;
    for (;;) {
        sum = 0u; cnt = 0u; mine = 0u;
#pragma unroll
        for (unsigned j = 0; j < 16; ++j) { const unsigned c = xb_ld(&bar[XB_XCNT(j)]); sum += c; cnt += (c > 0u) ? 1u : 0u; mine = (j == x) ? c : mine; }
        if (sum == G) break;
        __builtin_amdgcn_s_sleep(1);
        if ((++sp & 255u) == 0u) { if (xb_ld(&bar[XB_TMO])) break; if (sp > XB_SPIN_CAP) { atomicAdd(&bar[XB_TMO], 1u); break; } }
    }
    nloc = mine > 0u ? mine : 1u; nx = cnt > 0u ? cnt : 1u;
}
DI void xcd_barrier(const XcdBarrier& b) {
    asm volatile("s_waitcnt vmcnt(0)" ::: "memory");
    __syncthreads();
    if (threadIdx.x == 0) {
        unsigned* bar = b.bar;
        __builtin_amdgcn_s_waitcnt(0);
        unsigned nloc = b.st[0], nx = b.st[1];
        if (nloc == 0u) { xcd_barrier_complete(bar, b.x, nloc, nx); b.st[0] = nloc; b.st[1] = nx; }
        const unsigned old = xb_add(&bar[XB_XSUB(b.x)], 1u);
        const unsigned gen = old / nloc;
        if (old + 1u == (gen + 1u) * nloc) {
            __builtin_amdgcn_fence(__ATOMIC_RELEASE, "agent");
            asm volatile("s_waitcnt vmcnt(0)" ::: "memory");
            const unsigned og = xb_add(&bar[XB_TOP], 1u);
            const unsigned tg = og / nx;
            if (og + 1u == (tg + 1u) * nx) xb_add(&bar[XB_TOPGEN], 1u);
            else XB_SPIN(xb_ld(&bar[XB_TOPGEN]) == tg, bar);
            __builtin_amdgcn_fence(__ATOMIC_ACQUIRE, "agent");
            xb_add(&bar[XB_XGEN(b.x)], 1u);
            asm volatile("s_waitcnt vmcnt(0)" ::: "memory");
        } else {
            XB_SPIN(xb_ld(&bar[XB_XGEN(b.x)]) == gen, bar);
            __builtin_amdgcn_fence(__ATOMIC_ACQUIRE, "agent");
            asm volatile("s_waitcnt vmcnt(0)" ::: "memory");
        }
    }
    __syncthreads();
}

namespace pg8 {
constexpr int BM = 256, BK = 64, HALF = 128, HTB = HALF * BK * 2, STAGE_BYTES = 8 * HTB, NXCD = 8, WGM = 8;
DI int lds_byte(int r, int c) { const int st = (r >> 4) * 2 + (c >> 5), rr = r & 15, cc = c & 31, ob = rr * 64 + cc * 2; return st * 1024 + (ob ^ (((ob >> 9) & 1) << 5)); }
DI void stage_rc(int b, int& R, int& C) { const int st = b / 1024, sb = b % 1024, swz = sb ^ (((sb >> 9) & 1) << 5); R = (st >> 1) * 16 + swz / 64; C = (st & 1) * 32 + (swz % 64) / 2; }
DI int perm32(int rho) { const int n = rho >> 4, i = rho & 15; return 8 * (i >> 2) + 4 * n + (i & 3); }
struct Unit { int pm, pn; };
struct Gemm { const bf16_t* A0; const bf16_t* A1; int split; const bf16_t* Bt; int M, N, K; };
struct StaticOrder {
    int nM, nN, nwg, G, c;
    DI void init(int M_, int N_, int G_, int c_) { nM = M_ / BM; nN = N_ / BM; nwg = nM * nN; G = G_; c = c_; }
    DI bool next(int i, Unit& u) const {
        const long L = (long)i * G + c; if (L >= nwg) return false;
        int wgid = (int)L; { const int q = nwg / NXCD, r = nwg % NXCD, xcd = wgid % NXCD, off = wgid / NXCD; wgid = (xcd < r ? xcd * (q + 1) : r * (q + 1) + (xcd - r) * q) + off; }
        const int nig = WGM * nN, gid = wgid / nig, fm = gid * WGM, gsz = (nM - fm) < WGM ? (nM - fm) : WGM;
        u.pm = fm + ((wgid % nig) % gsz); u.pn = (wgid % nig) / gsz; return true;
    }
};
template <class Epi, bool ALIGN_EPI>
DI void gemm_phase(LAS unsigned char* lds, const Gemm g, const StaticOrder& S, const Epi& E) {
    const int tid = otid(), wid = __builtin_amdgcn_readfirstlane(tid >> 6), lane = tid & 63, wr = wid >> 2, wc = wid & 3, fr = lane & 15, fq = lane >> 4;
    const int K = g.K, nt = K / BK;
    unsigned voffA[2], voffB[2];
#pragma unroll
    for (int i = 0; i < 2; ++i) { int R, C; stage_rc(tid * 16 + i * 8192, R, C); const int Rb = Epi::PERM ? ((R & ~31) + perm32(R & 31)) : R;
        voffA[i] = (unsigned)(R * K + C) * 2u; voffB[i] = (unsigned)(Rb * K + C) * 2u; }
    const size_t kstep = (size_t)(BK * 2);
    const size_t hstep = (size_t)HALF * K * 2;
    const size_t tstep = 2 * hstep;
    const unsigned ldsw = (unsigned)wid * 1024u;
    const int aoff = lds_byte(wr * 64 + fr, fq * 8), boff = lds_byte(wc * 32 + fr, fq * 8);
#define PG8_SA(b, h) (((b) * 2 + (h)) * HTB)
#define PG8_SB(b, h) ((4 + (b) * 2 + (h)) * HTB)
#define PG8_STAGE(bufoff, gbase, voff) do { _Pragma("unroll") for (int _i = 0; _i < 2; ++_i) \
        __builtin_amdgcn_global_load_lds((const unsigned*)((const char*)(gbase) + (voff)[_i]), (LAS unsigned*)(lds + (bufoff) + ldsw + _i * 8192), 16, 0, 0); } while (0)
#define PG8_LDA(dst, b, h) do { _Pragma("unroll") for (int m = 0; m < 4; ++m) _Pragma("unroll") for (int k = 0; k < 2; ++k) dst[m][k] = *(const LAS bf16x8*)(lds + PG8_SA(b, h) + aoff + m * 2048 + k * 1024); } while (0)
#define PG8_LDB(dst, b, h) do { _Pragma("unroll") for (int n = 0; n < 2; ++n) _Pragma("unroll") for (int k = 0; k < 2; ++k) dst[n][k] = *(const LAS bf16x8*)(lds + PG8_SB(b, h) + boff + n * 2048 + k * 1024); } while (0)
#define PG8_MMA(ai, bj, At, Bt) do { __builtin_amdgcn_s_setprio(1); _Pragma("unroll") for (int m = 0; m < 4; ++m) _Pragma("unroll") for (int n = 0; n < 2; ++n) _Pragma("unroll") for (int k = 0; k < 2; ++k) \
        acc[ai][bj][m][n] = __builtin_amdgcn_mfma_f32_16x16x32_bf16(Bt[n][k], At[m][k], acc[ai][bj][m][n], 0, 0, 0); __builtin_amdgcn_s_setprio(0); } while (0)
#define PG8_WAIT_V(n) asm volatile("s_waitcnt vmcnt(" #n ")" ::: "memory")
#define PG8_WAIT_L(n) asm volatile("s_waitcnt lgkmcnt(" #n ")" ::: "memory")
#define PG8_BAR __builtin_amdgcn_s_barrier()
#define PG8_SCHED __builtin_amdgcn_sched_barrier(0)
    Unit cur, nxt; int ui = 0;
    if (!S.next(0, cur)) return;
    f32x4 acc[2][2][4][2];
#pragma unroll
    for (int a = 0; a < 2; ++a)
#pragma unroll
        for (int b = 0; b < 2; ++b)
#pragma unroll
            for (int m = 0; m < 4; ++m)
#pragma unroll
                for (int n = 0; n < 2; ++n) acc[a][b][m][n] = (f32x4){0.f, 0.f, 0.f, 0.f};
    bf16x8 At[4][2], B0[2][2], B1[2][2];
    const char* cA = (const char*)(cur.pn < g.split ? g.A0 : g.A1) + (size_t)cur.pm * tstep; const char* cB = (const char*)g.Bt + (size_t)cur.pn * tstep;
    PG8_STAGE(PG8_SB(0, 0), cB, voffB); PG8_STAGE(PG8_SB(0, 1), cB + hstep, voffB); PG8_STAGE(PG8_SA(0, 0), cA, voffA); PG8_STAGE(PG8_SA(0, 1), cA + hstep, voffA);
    if (wr == 1) PG8_BAR;
    PG8_WAIT_V(2); PG8_BAR;
    PG8_STAGE(PG8_SB(1, 0), cB + kstep, voffB); PG8_STAGE(PG8_SA(1, 0), cA + kstep, voffA); PG8_STAGE(PG8_SB(1, 1), cB + hstep + kstep, voffB);
    PG8_WAIT_V(6); PG8_BAR;
    for (;;) {
        const bool has_next = S.next(ui + 1, nxt);
        const char* nA = has_next ? (const char*)(nxt.pn < g.split ? g.A0 : g.A1) + (size_t)nxt.pm * tstep : cA; const char* nB = has_next ? (const char*)g.Bt + (size_t)nxt.pn * tstep : cB;
        for (int t = 0; t < nt; t += 2) {
            const bool last = (t == nt - 2);
            const char* a1 = cA + (size_t)(t + 1) * kstep;
            const char* a2 = last ? nA : cA + (size_t)(t + 2) * kstep; const char* b2 = last ? nB : cB + (size_t)(t + 2) * kstep;
            const char* a3 = a2 + kstep; const char* b3 = b2 + kstep;
            PG8_LDB(B0, 0, 0); PG8_LDB(B1, 0, 1); PG8_SCHED; PG8_LDA(At, 0, 0); PG8_STAGE(PG8_SA(1, 1), a1 + hstep, voffA);
            PG8_WAIT_V(8); PG8_WAIT_L(0); PG8_BAR; PG8_MMA(0, 0, At, B0); PG8_MMA(0, 1, At, B1); PG8_BAR; PG8_SCHED;
            PG8_LDA(At, 0, 1); PG8_STAGE(PG8_SB(0, 0), b2, voffB); PG8_STAGE(PG8_SB(0, 1), b2 + hstep, voffB); PG8_STAGE(PG8_SA(0, 0), a2, voffA);
            PG8_WAIT_V(8); PG8_WAIT_L(0); PG8_BAR; PG8_MMA(1, 0, At, B0); PG8_MMA(1, 1, At, B1); PG8_BAR; PG8_SCHED;
            PG8_LDB(B0, 1, 0); PG8_LDB(B1, 1, 1); PG8_SCHED; PG8_LDA(At, 1, 0); PG8_STAGE(PG8_SA(0, 1), a2 + hstep, voffA);
            PG8_WAIT_V(8); PG8_WAIT_L(0); PG8_BAR; PG8_MMA(0, 0, At, B0); PG8_MMA(0, 1, At, B1); PG8_BAR; PG8_SCHED;
            PG8_LDA(At, 1, 1); PG8_STAGE(PG8_SB(1, 0), b3, voffB); PG8_STAGE(PG8_SB(1, 1), b3 + hstep, voffB); PG8_STAGE(PG8_SA(1, 0), a3, voffA);
            PG8_WAIT_V(8); PG8_WAIT_L(0); PG8_BAR; PG8_MMA(1, 0, At, B0); PG8_MMA(1, 1, At, B1); PG8_BAR; PG8_SCHED;
        }
        if constexpr (ALIGN_EPI) { if (wr == 0) PG8_BAR; }
        E(acc, cur, wr, wc, fr, fq);
        if (!has_next) break;
#pragma unroll
        for (int a = 0; a < 2; ++a)
#pragma unroll
            for (int b = 0; b < 2; ++b)
#pragma unroll
                for (int m = 0; m < 4; ++m)
#pragma unroll
                    for (int n = 0; n < 2; ++n) acc[a][b][m][n] = (f32x4){0.f, 0.f, 0.f, 0.f};
        cur = nxt; cA = nA; cB = nB; ++ui;
        if constexpr (ALIGN_EPI) { if (wr == 1) PG8_BAR; }
    }
    PG8_WAIT_V(0);
    if constexpr (!ALIGN_EPI) { if (wr == 0) PG8_BAR; }
    PG8_BAR;
#undef PG8_SA
#undef PG8_SB
#undef PG8_STAGE
#undef PG8_LDA
#undef PG8_LDB
#undef PG8_MMA
#undef PG8_WAIT_V
#undef PG8_WAIT_L
#undef PG8_BAR
#undef PG8_SCHED
}
}

struct EpiA {
    static constexpr bool PERM = true;
    bf16_t* qkv; bf16_t* z; int row_off;
    DI void operator()(const f32x4 (&acc)[2][2][4][2], const pg8::Unit& u, int wr, int wc, int fr, int fq) const {
        const int row0 = u.pm * 256 + wr * 64 + fr; const int ct = u.pn * 256 + wc * 32 + 8 * fq;
        bf16_t* base; int ldc, col0;
        if (u.pn < 12) { base = qkv + (size_t)row0 * 3072; ldc = 3072; col0 = ct; } else { base = z + (size_t)(row_off + row0) * 1024; ldc = 1024; col0 = ct - 3072; }
#pragma unroll
        for (int ai = 0; ai < 2; ++ai)
#pragma unroll
            for (int m = 0; m < 4; ++m) { bf16_t* rowp = base + (size_t)(ai * 128 + m * 16) * ldc + col0;
#pragma unroll
                for (int bj = 0; bj < 2; ++bj) { const f32x4 v0 = acc[ai][bj][m][0], v1 = acc[ai][bj][m][1];
                    u32x4 w; w.x = cvtpk(v0[0], v0[1]); w.y = cvtpk(v0[2], v0[3]); w.z = cvtpk(v1[0], v1[1]); w.w = cvtpk(v1[2], v1[3]);
                    *(u32x4*)(rowp + bj * 128) = w; } }
    }
};
template <bool SSQ> struct EpiRes {
    static constexpr bool PERM = false;
    const float* base; float* out; const float* gate  ; float* ssq;
    DI void operator()(const f32x4 (&acc)[2][2][4][2], const pg8::Unit& u, int wr, int wc, int fr, int fq) const {
        const int col0 = u.pn * 256 + wc * 32 + 4 * fq; const int b = (u.pm * 256) >> 12;
        f32x4 gv[2][2];
#pragma unroll
        for (int bj = 0; bj < 2; ++bj)
#pragma unroll
            for (int n = 0; n < 2; ++n) gv[bj][n] = *(const f32x4*)(gate + (size_t)b * 3072 + 2048 + col0 + bj * 128 + n * 16);
#pragma unroll
        for (int ai = 0; ai < 2; ++ai)
#pragma unroll
            for (int m = 0; m < 4; ++m) { const int r = u.pm * 256 + ai * 128 + wr * 64 + m * 16 + fr; const size_t off = (size_t)r * 1024 + col0; float ss = 0.f;
#pragma unroll
                for (int bj = 0; bj < 2; ++bj)
#pragma unroll
                    for (int n = 0; n < 2; ++n) { const f32x4 bs = *(const f32x4*)(base + off + bj * 128 + n * 16); const f32x4 o = bs + gv[bj][n] * acc[ai][bj][m][n];
                        *(f32x4*)(out + off + bj * 128 + n * 16) = o; if (SSQ) ss += (o[0] * o[0] + o[1] * o[1]) + (o[2] * o[2] + o[3] * o[3]); }
                if (SSQ) { ss += __shfl_xor(ss, 16); ss += __shfl_xor(ss, 32); if (fq == 0) ssq[(size_t)(u.pn * 4 + wc) * M + r] = ss; } }
    }
};
struct EpiB {
    static constexpr bool PERM = true;
    bf16_t* kv; bf16_t* projb; float* gates; bf16_t* vt;
    DI void operator()(const f32x4 (&acc)[2][2][4][2], const pg8::Unit& u, int wr, int wc, int fr, int fq) const {
        const int row0 = u.pm * 256 + wr * 64 + fr; const int cw = wc * 32 + 8 * fq;
        if (u.pn == 19) {
#pragma unroll
            for (int ai = 0; ai < 2; ++ai)
#pragma unroll
                for (int m = 0; m < 4; ++m) { float* rowp = gates + (size_t)(row0 + ai * 128 + m * 16) * 48;
                    if (cw < 48) {
#pragma unroll
                        for (int n = 0; n < 2; ++n) { const f32x4 v = acc[ai][0][m][n]; f32x4 o; o[0] = sigm(v[0]); o[1] = sigm(v[1]); o[2] = sigm(v[2]); o[3] = sigm(v[3]); *(f32x4*)(rowp + cw + 4 * n) = o; } } }
            return;
        }
        if (u.pn == 1 || u.pn == 2) {
            const int gq = wc >> 1, d0 = (wc & 1) * 32 + 8 * fq;
#pragma unroll
            for (int ai = 0; ai < 2; ++ai)
#pragma unroll
                for (int m = 0; m < 4; ++m) { const int row = row0 + ai * 128 + m * 16; const int bb = row >> 12, t = row & 4095;
                    bf16_t* vp = vt + ((size_t)(((u.pn - 1) * 8 + bb) * 2 + gq) * 64 + d0) * 4096 + t;
                    const f32x4 v0 = acc[ai][1][m][0], v1 = acc[ai][1][m][1];
                    vp[0 * 4096] = f2bf(v0[0]); vp[1 * 4096] = f2bf(v0[1]); vp[2 * 4096] = f2bf(v0[2]); vp[3 * 4096] = f2bf(v0[3]);
                    vp[4 * 4096] = f2bf(v1[0]); vp[5 * 4096] = f2bf(v1[1]); vp[6 * 4096] = f2bf(v1[2]); vp[7 * 4096] = f2bf(v1[3]); }
        }
        bf16_t* base; int ldc, col0; float sc = 1.f;
        if (u.pn < 3) { base = kv + (size_t)row0 * 768; ldc = 768; col0 = u.pn * 256 + cw; } else { base = projb + (size_t)row0 * 4096; ldc = 4096; col0 = (u.pn - 3) * 256 + cw; if (u.pn < 7) sc = 0.125f * 1.4426950408889634f; }
#pragma unroll
        for (int ai = 0; ai < 2; ++ai)
#pragma unroll
            for (int m = 0; m < 4; ++m) { bf16_t* rowp = base + (size_t)(ai * 128 + m * 16) * ldc + col0;
#pragma unroll
                for (int bj = 0; bj < 2; ++bj) { const f32x4 v0 = acc[ai][bj][m][0] * sc, v1 = acc[ai][bj][m][1] * sc;
                    u32x4 w; w.x = cvtpk(v0[0], v0[1]); w.y = cvtpk(v0[2], v0[3]); w.z = cvtpk(v1[0], v1[1]); w.w = cvtpk(v1[2], v1[3]);
                    *(u32x4*)(rowp + bj * 128) = w; } }
    }
};

DI void p0_transpose_item(const float* W, int ld, int col0, int nvalid, int K, bf16_t* WT, int row_off, LAS float* scr, int item, int nblk, int lane) {
    const int kb = item / nblk, nb = item % nblk, k0 = 64 * kb, n0 = 32 * nb;
    const int nn = n0 + (lane & 31);
#pragma unroll 8
    for (int i = 0; i < 32; ++i) { const int kk = 2 * i + (lane >> 5); scr[kk * 33 + (lane & 31)] = (nn < nvalid) ? W[(size_t)(k0 + kk) * ld + col0 + nn] : 0.f; }
    asm volatile("s_waitcnt lgkmcnt(0)" ::: "memory");
    const int c = lane & 7;
#pragma unroll
    for (int j = 0; j < 4; ++j) { const int n = (lane >> 3) + 8 * j; const LAS float* s = scr + (8 * c) * 33 + n;
        u32x4 o; o.x = cvtpk(s[0 * 33], s[1 * 33]); o.y = cvtpk(s[2 * 33], s[3 * 33]); o.z = cvtpk(s[4 * 33], s[5 * 33]); o.w = cvtpk(s[6 * 33], s[7 * 33]);
        *(u32x4*)(WT + (size_t)(row_off + n0 + n) * K + k0 + 8 * c) = o; }
    asm volatile("s_waitcnt lgkmcnt(0)" ::: "memory");
}
DI void p0_prologue(const Params& p, LAS unsigned char* lds) {
    const int tid = otid(), lane = tid & 63, wave = __builtin_amdgcn_readfirstlane(tid >> 6);
    LAS float* scr = (LAS float*)(lds + wave * 8704);
    const int gw = blockIdx.x * 8 + wave, NGW = gridDim.x * 8;
    unsigned char* ws = p.ws;
    constexpr int I_ADA = 1536, I_WA = 16 * 128, I_WAO = 16 * 32, I_KV = 16 * 24, I_WB = 16 * 128, I_WG = 16 * 8, I_WBO = 16 * 32, I_W1 = 32 * 8, I_W2 = 4 * 2, I_C1 = 128;
    constexpr int NITEMS = I_ADA + I_WA + I_WAO + I_KV + I_WB + I_WG + I_WBO + 2 * I_W1 + 2 * I_W2 + I_C1;
    for (int it0 = gw; it0 < NITEMS; it0 += NGW) {
        int r = __builtin_amdgcn_readfirstlane(it0);
        if (r < I_ADA) {
            const int l = r / 768, rem = r % 768, jc = rem / 16, kc = rem % 16;
            const float* c = p.in[1]; const float* w = p.in[3] + (size_t)l * 1024 * 3072;
            float a[8]; for (int b = 0; b < 8; ++b) a[b] = 0.f;
            const int j = jc * 64 + lane;
            for (int kk = 0; kk < 64; ++kk) { const int k = kc * 64 + kk; const float wv = w[(size_t)k * 3072 + j];
#pragma unroll
                for (int b = 0; b < 8; ++b) { const float cv = c[b * 1024 + k]; a[b] += siluf(cv) * wv; } }
            float* modp = (float*)(ws + WS_MODP);
#pragma unroll
            for (int b = 0; b < 8; ++b) modp[(size_t)((kc * 2 + l) * 8 + b) * 3072 + j] = a[b];
            continue;
        }
        r -= I_ADA;
        if (r < I_WA) { p0_transpose_item(p.in[6], A_LD, 0, 4096, 1024, (bf16_t*)(ws + WS_WA), 0, scr, r, 128, lane); continue; } r -= I_WA;
        if (r < I_WAO) { p0_transpose_item(p.in[11], 1024, 0, 1024, 1024, (bf16_t*)(ws + WS_WAO), 0, scr, r, 32, lane); continue; } r -= I_WAO;
        if (r < I_KV) { p0_transpose_item(p.in[13], 768, 0, 768, 1024, (bf16_t*)(ws + WS_WCAT), 0, scr, r, 24, lane); continue; } r -= I_KV;
        if (r < I_WB) { p0_transpose_item(p.in[20], B_LD, 0, 4096, 1024, (bf16_t*)(ws + WS_WCAT), 768, scr, r, 128, lane); continue; } r -= I_WB;
        if (r < I_WG) { p0_transpose_item(p.in[20], B_LD, 4096, 48, 1024, (bf16_t*)(ws + WS_WCAT), 4864, scr, r, 8, lane); continue; } r -= I_WG;
        if (r < I_WBO) { p0_transpose_item(p.in[21], 1024, 0, 1024, 1024, (bf16_t*)(ws + WS_WBO), 0, scr, r, 32, lane); continue; } r -= I_WBO;
        if (r < I_W1) { p0_transpose_item(p.in[16], 256, 0, 256, 2048, (bf16_t*)(ws + WS_W1T), 0, scr, r, 8, lane); continue; } r -= I_W1;
        if (r < I_W1) { p0_transpose_item(p.in[18], 256, 0, 256, 2048, (bf16_t*)(ws + WS_W1T), 256, scr, r, 8, lane); continue; } r -= I_W1;
        if (r < I_W2) { p0_transpose_item(p.in[17], 64, 0, 64, 256, (bf16_t*)(ws + WS_W2T), 0, scr, r, 2, lane); continue; } r -= I_W2;
        if (r < I_W2) { p0_transpose_item(p.in[19], 64, 0, 64, 256, (bf16_t*)(ws + WS_W2T), 64, scr, r, 2, lane); continue; } r -= I_W2;
        {
            const int which = r / 64, rem = r % 64, jc = rem / 16, kc = rem % 16;
            const float* pos = p.in[14 + which]; const float* w1 = p.in[16 + 2 * which];
            const int j = jc * 64 + lane; float a = 0.f;
            for (int kk = 0; kk < 128; ++kk) { const int k = kc * 128 + kk; a += pos[k] * w1[(size_t)k * 256 + j]; }
            ((float*)(ws + WS_C1P))[(kc * 2 + which) * 256 + j] = a;
        }
    }
}

template <int LAYER> DI void norm_rows(const Params& p, LAS unsigned char* lds) {
    const int tid = otid(), lane = tid & 63, wave = __builtin_amdgcn_readfirstlane(tid >> 6);
    unsigned char* ws = p.ws;
    LAS float* gs = (LAS float*)lds;
    LAS float* sh = gs + 1024;
    LAS float* g2 = sh + 1024;
    LAS float* wba = g2 + 1024;
    const float* xin = LAYER == 0 ? p.in[0] : p.out;
    bf16_t* hout = LAYER == 0 ? (bf16_t*)((unsigned char*)p.out + 64 * MiB) : (bf16_t*)(ws + WS_RA);
    bf16_t* sout = (bf16_t*)(ws + WS_S);
    const float* modp = (const float*)(ws + WS_MODP);
    float* mod = (float*)(ws + WS_MOD);
    for (int rb = blockIdx.x; rb < 256; rb += gridDim.x) {
        const int b = rb >> 5;
        __syncthreads();
        for (int k = tid; k < 1024; k += 512) {
            float v[3];
#pragma unroll
            for (int part = 0; part < 3; ++part) { float a = p.in[4][LAYER * 3072 + part * 1024 + k];
                for (int kc = 0; kc < 16; ++kc) a += modp[(size_t)((kc * 2 + LAYER) * 8 + b) * 3072 + part * 1024 + k];
                v[part] = a; if ((rb & 31) == 0) mod[(size_t)(LAYER * 8 + b) * 3072 + part * 1024 + k] = a; }
            gs[k] = p.in[5][LAYER * 1024 + k] * (1.f + v[1]); sh[k] = v[0];
            if (LAYER == 1) g2[k] = p.in[12][k];
        }
        if (LAYER == 0) for (int i = tid; i < 16 * 1024; i += 512) { const int c = i & 15, k = i >> 4; wba[c * 1024 + k] = p.in[6][(size_t)k * A_LD + 4096 + c]; }
        __syncthreads();
        f32x4 vn[4];
        { const f32x4* xr0 = (const f32x4*)(xin + (size_t)(rb * 128 + wave * 16) * 1024) + lane;
#pragma unroll
          for (int j = 0; j < 4; ++j) vn[j] = xr0[64 * j]; }
        for (int rr = 0; rr < 16; ++rr) {
            const int m = rb * 128 + wave * 16 + rr;
            f32x4 v[4]; float s = 0.f;
#pragma unroll
            for (int j = 0; j < 4; ++j) { v[j] = vn[j]; s += (v[j][0] * v[j][0] + v[j][1] * v[j][1]) + (v[j][2] * v[j][2] + v[j][3] * v[j][3]); }
            if (rr + 1 < 16) { const f32x4* xr1 = (const f32x4*)(xin + (size_t)(m + 1) * 1024) + lane;
#pragma unroll
                for (int j = 0; j < 4; ++j) vn[j] = xr1[64 * j]; }
            const float rstd = rsqrtf(wave_sum(s) * (1.f / 1024.f) + EPS);
            f32x4 hv[4];
#pragma unroll
            for (int j = 0; j < 4; ++j) { const f32x4 g4 = *(const LAS f32x4*)(gs + 4 * lane + 256 * j), s4 = *(const LAS f32x4*)(sh + 4 * lane + 256 * j);
                const f32x4 xn = v[j] * rstd; hv[j] = xn * g4 + s4;
                u32x2 o; o.x = cvtpk(hv[j][0], hv[j][1]); o.y = cvtpk(hv[j][2], hv[j][3]);
                *((u32x2*)(hout + (size_t)m * 1024) + lane + 64 * j) = o;
                if (LAYER == 1) { const f32x4 k4 = *(const LAS f32x4*)(g2 + 4 * lane + 256 * j); const f32x4 sv = xn * k4; u32x2 o2; o2.x = cvtpk(sv[0], sv[1]); o2.y = cvtpk(sv[2], sv[3]);
                    *((u32x2*)(sout + (size_t)m * 1024) + lane + 64 * j) = o2; } }
            if (LAYER == 0) {
                float pa[16];
#pragma unroll
                for (int c = 0; c < 16; ++c) { float a = 0.f;
#pragma unroll
                    for (int j = 0; j < 4; ++j) { const f32x4 w4 = *(const LAS f32x4*)(wba + c * 1024 + 4 * lane + 256 * j); a += (hv[j][0] * w4[0] + hv[j][1] * w4[1]) + (hv[j][2] * w4[2] + hv[j][3] * w4[3]); }
                    pa[c] = a; if (c & 1) __builtin_amdgcn_sched_barrier(0); }
                {
                    const bool up = (lane & 32) != 0; float q[8];
#pragma unroll
                    for (int c = 0; c < 8; ++c) { const float keep = up ? pa[8 + c] : pa[c], give = up ? pa[c] : pa[8 + c]; q[c] = keep + __shfl_xor(give, 32); }
                    const bool up2 = (lane & 16) != 0; float r4[4];
#pragma unroll
                    for (int c = 0; c < 4; ++c) { const float keep = up2 ? q[4 + c] : q[c], give = up2 ? q[c] : q[4 + c]; r4[c] = keep + __shfl_xor(give, 16); }
                    const bool up3 = (lane & 8) != 0; float r2[2];
#pragma unroll
                    for (int c = 0; c < 2; ++c) { const float keep = up3 ? r4[2 + c] : r4[c], give = up3 ? r4[c] : r4[2 + c]; r2[c] = keep + __shfl_xor(give, 8); }
                    const bool up4 = (lane & 4) != 0;
                    const float keep = up4 ? r2[1] : r2[0], give = up4 ? r2[0] : r2[1];
                    float r1 = keep + __shfl_xor(give, 4);
                    r1 += __shfl_xor(r1, 2); r1 += __shfl_xor(r1, 1);
                    pa[0] = r1;
                }
                const int mycol = ((lane >> 5) & 1) * 8 + ((lane >> 4) & 1) * 4 + ((lane >> 3) & 1) * 2 + ((lane >> 2) & 1);
                const float mine = pa[0];
                if ((lane & 3) == 0) { float o; const int cc = mycol;
                    if (cc < 8) o = sigm(mine);
                    else { const float xx = mine + p.in[9][cc - 8]; const float sp = xx > 20.f ? xx : log1pf(__expf(xx)); o = -__expf(p.in[8][cc - 8]) * sp; }
                    ((float*)(ws + WS_BG))[(size_t)m * 16 + cc] = o; }
            }
        }
    }
}

DI void mm16_acc(float (&acc)[4], const LAS float* X, int px, const LAS float* Y, int py, int c, int q) {
    float y[16];
#pragma unroll
    for (int kk = 0; kk < 16; ++kk) y[kk] = Y[kk * py + c];
#pragma unroll
    for (int h2 = 0; h2 < 2; ++h2) {
        f32x4 xv[2][4];
#pragma unroll
        for (int rr = 0; rr < 2; ++rr)
#pragma unroll
            for (int k4 = 0; k4 < 4; ++k4) xv[rr][k4] = *(const LAS f32x4*)(X + (4 * q + 2 * h2 + rr) * px + 4 * k4);
#pragma unroll
        for (int k4 = 0; k4 < 4; ++k4)
#pragma unroll
            for (int rr = 0; rr < 2; ++rr)
                acc[2 * h2 + rr] += (xv[rr][k4][0] * y[4 * k4] + xv[rr][k4][1] * y[4 * k4 + 1]) + (xv[rr][k4][2] * y[4 * k4 + 2] + xv[rr][k4][3] * y[4 * k4 + 3]);
    }
}
template <int K> DI float row_bcast16(float v) {
    return __builtin_bit_cast(float, __builtin_amdgcn_update_dpp(0, __builtin_bit_cast(int, v), 0x150 + K, 0xf, 0xf, false));
}
template <int I, int K> struct InvRow {
    static DI void run(const float (&mcol)[16], const float (&tt)[16], float& s) { InvRow<I, K - 1>::run(mcol, tt, s); s += row_bcast16<K>(mcol[I]) * tt[K]; }
};
template <int I> struct InvRow<I, -1> { static DI void run(const float (&)[16], const float (&)[16], float&) {} };
template <int I> struct InvAll {
    static DI void run(const float (&mcol)[16], float (&tt)[16], int c) { InvAll<I - 1>::run(mcol, tt, c); float s = 0.f; InvRow<I, I - 1>::run(mcol, tt, s); tt[I] = (I == c ? 1.f : 0.f) - s;
        __builtin_amdgcn_sched_barrier(0); }
};
template <> struct InvAll<-1> { static DI void run(const float (&)[16], float (&)[16], int) {} };
DI void p3_prep(const Params& p, LAS unsigned char* lds, const int half) {
    const int tid = otid(), lane_k = tid & 63, wave = __builtin_amdgcn_readfirstlane(tid >> 6);
    unsigned char* ws = p.ws;
    constexpr int L_CW = 0, L_QS = 6144, L_KS = L_QS + 17408, L_VBT = L_KS + 17408, L_KBGT = L_VBT + 18432, L_KDT = L_KBGT + 18432,
                  L_LM = L_KDT + 18432, L_TM = L_LM + 17408, L_TB = L_TM + 17408  , L_PM = L_TB + 9216, L_GC = L_PM + 2560, L_BETA = L_GC + 256, L_SS = L_BETA + 256;
    static_assert(L_SS + 4096 <= LDS_BYTES, "p3 lds");
    LAS float* Lm = (LAS float*)(lds + L_LM);
    LAS float* Tm = (LAS float*)(lds + L_TM);
    LAS float* Pm = (LAS float*)(lds + L_PM);
    LAS float* gcs = (LAS float*)(lds + L_GC);
    LAS float* betas = (LAS float*)(lds + L_BETA);
    const bf16_t* qkv = (const bf16_t*)(ws + WS_RA);
    const float* bg = (const float*)(ws + WS_BG);
    for (int g8 = blockIdx.x; g8 < 256; g8 += gridDim.x) {
        const int bl = g8 >> 6, h = (g8 >> 3) & 7, nbase = (g8 & 7) * 8;
        __syncthreads();
        float cwr[3][4][2];
#pragma unroll
        for (int X = 0; X < 3; ++X)
#pragma unroll
            for (int k = 0; k < 4; ++k) { const f32x2 w2 = *(const f32x2*)(p.in[7] + (size_t)k * 3072 + X * 1024 + h * 128 + 2 * lane_k); cwr[X][k][0] = w2[0]; cwr[X][k][1] = w2[1]; }
        unsigned xr[3][11];
        float gpre = 0.f, bpre = 0.f;
        auto xload = [&](int n_) {
            int ln = lane_k; asm volatile("" : "+v"(ln));
#pragma unroll
            for (int X = 0; X < 3; ++X)
#pragma unroll
                for (int j = 0; j < 11; ++j) { const int tt = n_ * 64 + 8 * wave + j - 3;
                    xr[X][j] = (tt >= 0) ? *(const unsigned*)(qkv + ((size_t)bl * 4096 + tt) * 3072 + X * 1024 + h * 128 + 2 * ln) : 0u; }
        };
        auto gload = [&](int n_) { if (wave == 0) { const size_t row = (size_t)(half * 4 + bl) * 4096 + n_ * 64 + lane_k; gpre = bg[row * 16 + 8 + h]; bpre = bg[row * 16 + h]; } };
        xload(nbase); gload(nbase);
        for (int nn = 0; nn < 8; ++nn) {
            int lane = lane_k, r32, hh; asm volatile("" : "+v"(lane));
            r32 = lane & 31; hh = lane >> 5;
            const int tid = wave * 64 + lane;
            const int n = nbase + nn;
            const int bglob = half * 4 + bl;
            const int ug = (bglob * 8 + h) * 64 + n;
            if (wave == 0) {
                float gv = gpre;
#pragma unroll
                for (int o = 1; o < 64; o <<= 1) { const float t = __shfl_up(gv, o); if (lane >= o) gv += t; }
                gcs[lane] = gv; betas[lane] = bpre;
            }
            if (nn + 1 < 8) gload(n + 1);
            __syncthreads();
            {
                const int tb = 8 * wave;
                const float gc_last = gcs[63];
#pragma unroll
                for (int X = 0; X < 3; ++X) {
                    float x0[11], x1[11];
#pragma unroll
                    for (int j = 0; j < 11; ++j) { x0[j] = bflo(xr[X][j]); x1[j] = bfhi(xr[X][j]); }
                    float y0[8], y1[8];
#pragma unroll
                    for (int tk = 0; tk < 8; ++tk) {
                        float a0 = 0.f, a1 = 0.f;
#pragma unroll
                        for (int k = 0; k < 4; ++k) { a0 += cwr[X][k][0] * x0[tk + k]; a1 += cwr[X][k][1] * x1[tk + k]; }
                        y0[tk] = siluf(a0); y1[tk] = siluf(a1);
                    }
                    if (X == 0) {
#pragma unroll
                        for (int tk = 0; tk < 8; ++tk) {
                            const int i = tb + tk;
                            const float rq = rsqrtf(wave_sum(y0[tk] * y0[tk] + y1[tk] * y1[tk]) + EPS) * 0.08838834764831845f;
                            const float q0 = y0[tk] * rq, q1 = y1[tk] * rq, eg = __expf(gcs[i]);
                            *(LAS unsigned*)(lds + L_QS + i * 272 + lane * 4) = cvtpk(q0, q1);
                            *(unsigned*)((bf16_t*)(ws + WS_PQD) + ((size_t)ug * 64 + i) * 128 + 2 * lane) = cvtpk(q0 * eg, q1 * eg);
                        }
                    } else if (X == 1) {
                        float b0[8], b1[8], d0[8], d1[8];
#pragma unroll
                        for (int tk = 0; tk < 8; ++tk) {
                            const int i = tb + tk;
                            const float rk = rsqrtf(wave_sum(y0[tk] * y0[tk] + y1[tk] * y1[tk]) + EPS);
                            const float k0 = y0[tk] * rk, k1 = y1[tk] * rk, gci = gcs[i];
                            const float fb = betas[i] * __expf(gci), fd = __expf(gc_last - gci);
                            *(LAS unsigned*)(lds + L_KS + i * 272 + lane * 4) = cvtpk(k0, k1);
                            b0[tk] = k0 * fb; b1[tk] = k1 * fb; d0[tk] = k0 * fd; d1[tk] = k1 * fd;
                        }
                        u32x4 w;
                        w.x = cvtpk(b0[0], b0[1]); w.y = cvtpk(b0[2], b0[3]); w.z = cvtpk(b0[4], b0[5]); w.w = cvtpk(b0[6], b0[7]); *(LAS u32x4*)(lds + L_KBGT + (2 * lane) * 144 + tb * 2) = w;
                        w.x = cvtpk(b1[0], b1[1]); w.y = cvtpk(b1[2], b1[3]); w.z = cvtpk(b1[4], b1[5]); w.w = cvtpk(b1[6], b1[7]); *(LAS u32x4*)(lds + L_KBGT + (2 * lane + 1) * 144 + tb * 2) = w;
                        w.x = cvtpk(d0[0], d0[1]); w.y = cvtpk(d0[2], d0[3]); w.z = cvtpk(d0[4], d0[5]); w.w = cvtpk(d0[6], d0[7]); *(LAS u32x4*)(lds + L_KDT + (2 * lane) * 144 + tb * 2) = w;
                        w.x = cvtpk(d1[0], d1[1]); w.y = cvtpk(d1[2], d1[3]); w.z = cvtpk(d1[4], d1[5]); w.w = cvtpk(d1[6], d1[7]); *(LAS u32x4*)(lds + L_KDT + (2 * lane + 1) * 144 + tb * 2) = w;
                    } else {
#pragma unroll
                        for (int tk = 0; tk < 8; ++tk) { const float bt = betas[tb + tk]; y0[tk] *= bt; y1[tk] *= bt; }
                        u32x4 w;
                        w.x = cvtpk(y0[0], y0[1]); w.y = cvtpk(y0[2], y0[3]); w.z = cvtpk(y0[4], y0[5]); w.w = cvtpk(y0[6], y0[7]); *(LAS u32x4*)(lds + L_VBT + (2 * lane) * 144 + tb * 2) = w;
                        w.x = cvtpk(y1[0], y1[1]); w.y = cvtpk(y1[2], y1[3]); w.z = cvtpk(y1[4], y1[5]); w.w = cvtpk(y1[6], y1[7]); *(LAS u32x4*)(lds + L_VBT + (2 * lane + 1) * 144 + tb * 2) = w;
                    }
                }
            }
            if (nn + 1 < 8) xload(n + 1);
            __syncthreads();
            {
                int lane_c = lane; asm volatile("" : "+v"(lane_c)); const int r32 = lane_c & 31, hh = lane_c >> 5;
                const int which = wave >> 2, mi = (wave >> 1) & 1, ni = wave & 1;
                f32x16 acc = zero16();
                if (!(mi == 0 && ni == 1)) {
                    const LAS unsigned char* ab = lds + (which ? L_QS : L_KS) + (32 * mi + r32) * 272 + hh * 16;
                    const LAS unsigned char* bb = lds + L_KS + (32 * ni + r32) * 272 + hh * 16;
#pragma unroll
                    for (int ks = 0; ks < 8; ++ks) acc = MFMA32(lds128(ab + ks * 32), lds128(bb + ks * 32), acc);
                }
                const int j = 32 * ni + r32; const float gcj = gcs[j];
                bf16_t* at = (bf16_t*)(ws + WS_PAT) + (size_t)ug * 4096;
#pragma unroll
                for (int reg = 0; reg < 16; ++reg) {
                    const int ii = 32 * mi + crow(reg, hh);
                    const float dec = (ii >= j) ? __expf(gcs[ii] - gcj) : 0.f;
                    if (which == 0) Lm[ii * 68 + j] = (ii > j) ? betas[ii] * acc[reg] * dec : 0.f;
                    else at[ii * 64 + j] = f2bf(acc[reg] * dec);
                }
            }
            __syncthreads();
            if (wave == 0) {
                const int a = lane >> 4, c = lane & 15;
                float mcol[16], tt[16];
#pragma unroll
                for (int ii = 0; ii < 16; ++ii) mcol[ii] = Lm[(16 * a + ii) * 68 + 16 * a + c];
                InvAll<15>::run(mcol, tt, c);
#pragma unroll
                for (int ii = 0; ii < 16; ++ii) Tm[(16 * a + ii) * 68 + 16 * a + c] = tt[ii];
            } else {
                int tid_d = tid; asm volatile("" : "+v"(tid_d));
                bf16_t* dst = (bf16_t*)(ws + WS_PKDT) + (size_t)ug * 8192;
                for (int ci = tid_d - 64; ci < 1024; ci += 448) { const int row = ci >> 3, ch = ci & 7;
                    *(u32x4*)(dst + row * 64 + ch * 8) = *(const LAS u32x4*)(lds + L_KDT + row * 144 + ch * 16); }
                if (tid_d == 64) ((float*)(ws + WS_GL))[ug] = __expf(gcs[63]);
            }
            __syncthreads();
            if (wave < 2) {
                const int aa = 2 * wave + 1, bb = 2 * wave, c = lane & 15, q = lane >> 4;
                LAS float* Pw = Pm + wave * 320;
                float acc[4] = {0.f, 0.f, 0.f, 0.f};
                mm16_acc(acc, Lm + (16 * aa) * 68 + 16 * bb, 68, Tm + (16 * bb) * 68 + 16 * bb, 68, c, q);
#pragma unroll
                for (int rr = 0; rr < 4; ++rr) Pw[(4 * q + rr) * 20 + c] = acc[rr];
                float acc2[4] = {0.f, 0.f, 0.f, 0.f};
                mm16_acc(acc2, Tm + (16 * aa) * 68 + 16 * aa, 68, Pw, 20, c, q);
#pragma unroll
                for (int rr = 0; rr < 4; ++rr) Tm[(16 * aa + 4 * q + rr) * 68 + 16 * bb + c] = -acc2[rr];
            }
            __syncthreads();
            for (int e = tid; e < 3072; e += 512) { const int which = e >> 10, ii = (e >> 5) & 31, j = e & 31;
                float v;
                if (which == 2) v = -Lm[(32 + ii) * 68 + j];
                else { const int o = 32 * which; v = ((j >> 4) > (ii >> 4)) ? 0.f : Tm[(o + ii) * 68 + o + j]; }
                *(LAS bf16_t*)(lds + L_TB + which * 2560 + ii * 80 + j * 2) = f2bf(v); }
            __syncthreads();
            {
                int lane_e = lane; asm volatile("" : "+v"(lane_e)); const int r32 = lane_e & 31, hh = lane_e >> 5;
                const int mat = wave >> 2, nb = wave & 3;
                const LAS unsigned char* xt = lds + (mat ? L_KBGT : L_VBT) + (32 * nb + r32) * 144;
                const LAS unsigned char* td0 = lds + L_TB + r32 * 80, *td1 = td0 + 2560, *nm = td0 + 5120;
                f32x16 acc0 = zero16();
#pragma unroll
                for (int ks = 0; ks < 2; ++ks) acc0 = MFMA32(lds128(td0 + hh * 16 + ks * 32), lds128(xt + hh * 16 + ks * 32), acc0);
                f32x16 acc1;
#pragma unroll
                for (int gq = 0; gq < 4; ++gq) { const u32x2 v = *(const LAS u32x2*)(xt + (32 + 8 * gq + 4 * hh) * 2);
                    acc1[4 * gq] = bflo(v[0]); acc1[4 * gq + 1] = bfhi(v[0]); acc1[4 * gq + 2] = bflo(v[1]); acc1[4 * gq + 3] = bfhi(v[1]); }
#pragma unroll
                for (int s2 = 0; s2 < 2; ++s2) acc1 = MFMA32(lds2x64(nm + hh * 8 + s2 * 32, nm + hh * 8 + s2 * 32 + 16), pack8(acc0, s2), acc1);
                f32x16 acc2 = zero16();
#pragma unroll
                for (int s2 = 0; s2 < 2; ++s2) acc2 = MFMA32(lds2x64(td1 + hh * 8 + s2 * 32, td1 + hh * 8 + s2 * 32 + 16), pack8(acc1, s2), acc2);
#pragma unroll
                for (int mi = 0; mi < 2; ++mi) {
                    const f32x16 acc = mi ? acc2 : acc0;
                    if (mat == 0) {
                        bf16_t* up = (bf16_t*)(ws + WS_PU) + ((((size_t)ug * 4 + nb) * 2 + mi) * 64 + lane_e) * 16;
                        u32x4 o0, o1;
#pragma unroll
                        for (int e = 0; e < 4; ++e) { o0[e] = cvtpk(acc[2 * e], acc[2 * e + 1]); o1[e] = cvtpk(acc[8 + 2 * e], acc[8 + 2 * e + 1]); }
                        *(u32x4*)up = o0; *(u32x4*)(up + 8) = o1;
                    } else {
                        bf16_t* wp = (bf16_t*)(ws + WS_PW) + (size_t)ug * 8192;
#pragma unroll
                        for (int reg = 0; reg < 16; ++reg) wp[(32 * mi + crow(reg, hh)) * 128 + 32 * nb + r32] = f2bf(acc[reg]);
                    }
                }
            }
            __syncthreads();
        }
    }
}

template <int PMODE> DI void p4_scan(const Params& p, LAS unsigned char* lds) {
    const int tid = otid(), lane = tid & 63, wave = __builtin_amdgcn_readfirstlane(tid >> 6);
    const int r32 = lane & 31, hh = lane >> 5;
    unsigned char* ws = p.ws;
    constexpr int ST = 59904, S_W = 0, S_QD = 16896, S_KDT = 33792, S_AT = 51200, L_OS = 2 * ST, OSB = 16896;
    static_assert(L_OS + 2 * OSB <= LDS_BYTES, "p4 lds");
    for (int bh = blockIdx.x; bh < 64; bh += gridDim.x) {
        const int b = bh >> 3, h = bh & 7;
        __syncthreads();
        if (wave >= 4) {
            const int lt_k = tid - 256;
            u32x4 rgA[14], rgB[14];
            auto issue = [&](u32x4 (&rg)[14], int n) {
                int lt = lt_k; asm volatile("" : "+v"(lt));
                const size_t ug = (size_t)bh * 64 + n;
                const bf16_t* pw = (const bf16_t*)(ws + WS_PW) + ug * 8192; const bf16_t* pq = (const bf16_t*)(ws + WS_PQD) + ug * 8192;
                const bf16_t* pk = (const bf16_t*)(ws + WS_PKDT) + ug * 8192; const bf16_t* pa = (const bf16_t*)(ws + WS_PAT) + ug * 4096;
#pragma unroll
                for (int k = 0; k < 4; ++k) { const int ci = lt + 256 * k; rg[k] = *(const u32x4*)(pw + ci * 8); rg[4 + k] = *(const u32x4*)(pq + ci * 8); rg[8 + k] = *(const u32x4*)(pk + ci * 8); }
#pragma unroll
                for (int k = 0; k < 2; ++k) { const int ci = lt + 256 * k; rg[12 + k] = *(const u32x4*)(pa + ci * 8); }
            };
            auto commit = [&](const u32x4 (&rg)[14], int st) {
                int lt = lt_k; asm volatile("" : "+v"(lt));
                LAS unsigned char* sb = lds + st * ST;
#pragma unroll
                for (int k = 0; k < 4; ++k) { const int ci = lt + 256 * k; const int row = ci >> 4, ch = ci & 15;
                    LAS u32x2* d0 = (LAS u32x2*)(sb + S_W + row * 264 + ch * 16); d0[0] = (u32x2){rg[k][0], rg[k][1]}; d0[1] = (u32x2){rg[k][2], rg[k][3]};
                    LAS u32x2* d1 = (LAS u32x2*)(sb + S_QD + row * 264 + ch * 16); d1[0] = (u32x2){rg[4 + k][0], rg[4 + k][1]}; d1[1] = (u32x2){rg[4 + k][2], rg[4 + k][3]};
                    const int row2 = ci >> 3, ch2 = ci & 7;
                    LAS u32x2* d2 = (LAS u32x2*)(sb + S_KDT + row2 * 136 + ch2 * 16); d2[0] = (u32x2){rg[8 + k][0], rg[8 + k][1]}; d2[1] = (u32x2){rg[8 + k][2], rg[8 + k][3]}; }
#pragma unroll
                for (int k = 0; k < 2; ++k) { const int ci = lt + 256 * k; const int row2 = ci >> 3, ch2 = ci & 7;
                    LAS u32x2* d3 = (LAS u32x2*)(sb + S_AT + row2 * 136 + ch2 * 16); d3[0] = (u32x2){rg[12 + k][0], rg[12 + k][1]}; d3[1] = (u32x2){rg[12 + k][2], rg[12 + k][3]}; }
            };
            auto ocopy = [&](int mstep) {
                int lt = lt_k; asm volatile("" : "+v"(lt));
                const int row = lt >> 2, part = lt & 3;
                const LAS unsigned char* ob = lds + L_OS + (mstep & 1) * OSB + row * 264 + part * 64;
                const size_t tok = (size_t)b * 4096 + mstep * 64 + row;
                bf16_t* yp = (bf16_t*)(ws + WS_RA) + tok * 1024 + h * 128 + part * 32;
#pragma unroll
                for (int e = 0; e < 4; ++e) { const u32x2 v0 = *(const LAS u32x2*)(ob + e * 16), v1 = *(const LAS u32x2*)(ob + e * 16 + 8); *(u32x4*)(yp + 8 * e) = (u32x4){v0[0], v0[1], v1[0], v1[1]}; }
            };
            issue(rgA, 0); commit(rgA, 0); issue(rgB, 1);
            __syncthreads();
            for (int n = 0; n <= 64; n += 2) {
                if (n + 2 < 64) issue(rgA, n + 2);
                if (PMODE == 0) { if (n >= 1) ocopy(n - 1); }
                if (n + 1 < 64) commit(rgB, (n + 1) & 1);
                __syncthreads();
                if (n + 1 <= 64) {
                    if (n + 3 < 64) issue(rgB, n + 3);
                    if (PMODE == 0) ocopy(n);
                    if (n + 2 < 64) commit(rgA, (n + 2) & 1);
                    __syncthreads();
                }
            }
        } else {
            const int sl = wave;
            f32x16 Sacc[4]; for (int kb = 0; kb < 4; ++kb) Sacc[kb] = zero16();
            u32x4 un[2][2]; float gln;
            auto uload = [&](int n) { const size_t ug = (size_t)bh * 64 + n;
                const bf16_t* up = (const bf16_t*)(ws + WS_PU) + (((ug * 4 + sl) * 2) * 64 + lane) * 16;
                un[0][0] = *(const u32x4*)up; un[0][1] = *(const u32x4*)(up + 8); un[1][0] = *(const u32x4*)(up + 1024); un[1][1] = *(const u32x4*)(up + 1032);
                gln = ((const float*)(ws + WS_GL))[ug]; };
            uload(0);
            __syncthreads();
            for (int n = 0; n <= 64; ++n) {
                if (n < 64 && PMODE != 1) {
                    const LAS unsigned char* sb = lds + (n & 1) * ST;
                    u32x4 uc[2][2]; uc[0][0] = un[0][0]; uc[0][1] = un[0][1]; uc[1][0] = un[1][0]; uc[1][1] = un[1][1]; const float gl = gln;
                    if (n + 1 < 64) uload(n + 1);
                    f32x16 vacc[2], qacc[2];
                    vacc[0] = zero16(); vacc[1] = zero16(); qacc[0] = zero16(); qacc[1] = zero16();
                    {
                        const LAS unsigned char* wrow = sb + S_W + r32 * 264 + hh * 8;
                        const LAS unsigned char* qrow = sb + S_QD + r32 * 264 + hh * 8;
#pragma unroll
                        for (int kb = 0; kb < 4; ++kb) {
                            bf16x8 fw[2][2], fq[2][2];
#pragma unroll
                            for (int s2 = 0; s2 < 2; ++s2)
#pragma unroll
                                for (int mi = 0; mi < 2; ++mi) { const int off = mi * 32 * 264 + (2 * kb + s2) * 32;
                                    fw[s2][mi] = lds2x64(wrow + off, wrow + off + 16); fq[s2][mi] = lds2x64(qrow + off, qrow + off + 16); }
                            const bf16x8 Sb0 = pack8(Sacc[kb], 0), Sb1 = pack8(Sacc[kb], 1);
                            __builtin_amdgcn_sched_barrier(0);
#pragma unroll
                            for (int mi = 0; mi < 2; ++mi) { vacc[mi] = MFMA32(fw[0][mi], Sb0, vacc[mi]); qacc[mi] = MFMA32(fq[0][mi], Sb0, qacc[mi]); }
#pragma unroll
                            for (int mi = 0; mi < 2; ++mi) { vacc[mi] = MFMA32(fw[1][mi], Sb1, vacc[mi]); qacc[mi] = MFMA32(fq[1][mi], Sb1, qacc[mi]); }
                        }
                    }
                    __builtin_amdgcn_sched_barrier(0);
                    bf16x8 Vb[4];
#pragma unroll
                    for (int mi = 0; mi < 2; ++mi) { f32x16 vn;
#pragma unroll
                        for (int e = 0; e < 4; ++e) { vn[2 * e] = bflo(uc[mi][0][e]) - vacc[mi][2 * e]; vn[2 * e + 1] = bfhi(uc[mi][0][e]) - vacc[mi][2 * e + 1];
                                                      vn[8 + 2 * e] = bflo(uc[mi][1][e]) - vacc[mi][8 + 2 * e]; vn[8 + 2 * e + 1] = bfhi(uc[mi][1][e]) - vacc[mi][8 + 2 * e + 1]; }
                        Vb[2 * mi] = pack8(vn, 0); Vb[2 * mi + 1] = pack8(vn, 1); }
                    {
                        bf16x8 fa[6];
                        const LAS unsigned char* arow = sb + S_AT + r32 * 136 + hh * 8;
                        fa[0] = lds2x64(arow, arow + 16); fa[1] = lds2x64(arow + 32, arow + 48);
#pragma unroll
                        for (int ks = 0; ks < 4; ++ks) fa[2 + ks] = lds2x64(arow + 32 * 136 + ks * 32, arow + 32 * 136 + ks * 32 + 16);
                        __builtin_amdgcn_sched_barrier(0);
                        qacc[0] = MFMA32(fa[0], Vb[0], qacc[0]); qacc[1] = MFMA32(fa[2], Vb[0], qacc[1]);
                        qacc[0] = MFMA32(fa[1], Vb[1], qacc[0]); qacc[1] = MFMA32(fa[3], Vb[1], qacc[1]);
                        qacc[1] = MFMA32(fa[4], Vb[2], qacc[1]); qacc[1] = MFMA32(fa[5], Vb[3], qacc[1]);
                    }
#pragma unroll
                    for (int kp = 0; kp < 2; ++kp) {
                        bf16x8 fk[2][4];
#pragma unroll
                        for (int k2 = 0; k2 < 2; ++k2)
#pragma unroll
                            for (int ks = 0; ks < 4; ++ks) { const LAS unsigned char* krow = sb + S_KDT + (32 * (2 * kp + k2) + r32) * 136 + hh * 8 + ks * 32; fk[k2][ks] = lds2x64(krow, krow + 16); }
                        f32x16 sn0 = Sacc[2 * kp] * gl, sn1 = Sacc[2 * kp + 1] * gl;
                        __builtin_amdgcn_sched_barrier(0);
#pragma unroll
                        for (int ks = 0; ks < 4; ++ks) { sn0 = MFMA32(fk[0][ks], Vb[ks], sn0); sn1 = MFMA32(fk[1][ks], Vb[ks], sn1); }
                        Sacc[2 * kp] = sn0; Sacc[2 * kp + 1] = sn1;
                    }
                    {
                        LAS bf16_t* ob = (LAS bf16_t*)(lds + L_OS + (n & 1) * OSB);
#pragma unroll
                        for (int mo = 0; mo < 2; ++mo)
#pragma unroll
                            for (int reg = 0; reg < 16; ++reg) ob[(32 * mo + crow(reg, hh)) * 132 + 32 * sl + r32] = f2bf(qacc[mo][reg]);
                    }
                }
                __syncthreads();
            }
        }
    }
}

DI void p4b_onorm(const Params& p) {
    const int tid = otid(), lane = tid & 63, wave = tid >> 6;
    bf16_t* ob = (bf16_t*)(p.ws + WS_RA);
    const bf16_t* zb = (const bf16_t*)p.out;
    const float* og = p.in[10] + (lane & 7) * 16;
    float g[16];
#pragma unroll
    for (int e = 0; e < 16; ++e) g[e] = og[e];
    const int stride = gridDim.x * 8;
    int m = blockIdx.x * 8 + wave;
    u32x4 no0, no1, nz0, nz1;
    auto ld = [&](int mm) { const bf16_t* op = ob + (size_t)mm * 1024 + lane * 16; const bf16_t* zp = zb + (size_t)mm * 1024 + lane * 16;
        no0 = *(const u32x4*)op; no1 = *(const u32x4*)(op + 8); nz0 = *(const u32x4*)zp; nz1 = *(const u32x4*)(zp + 8); };
    if (m < M) ld(m);
    for (; m < M; m += stride) {
        bf16_t* op = ob + (size_t)m * 1024 + lane * 16;
        const u32x4 o0 = no0, o1 = no1, z0 = nz0, z1 = nz1;
        if (m + stride < M) ld(m + stride);
        float ss = 0.f;
#pragma unroll
        for (int e = 0; e < 4; ++e) { const float a = bflo(o0[e]), b2 = bfhi(o0[e]), c = bflo(o1[e]), d = bfhi(o1[e]); ss += (a * a + b2 * b2) + (c * c + d * d); }
        ss += __shfl_xor(ss, 1); ss += __shfl_xor(ss, 2); ss += __shfl_xor(ss, 4);
        const float rstd = rsqrtf(ss * (1.f / 128.f) + EPS);
        u32x4 y0, y1;
#pragma unroll
        for (int e = 0; e < 4; ++e) {
            y0[e] = cvtpk(bflo(o0[e]) * rstd * g[2 * e] * siluf(bflo(z0[e])), bfhi(o0[e]) * rstd * g[2 * e + 1] * siluf(bfhi(z0[e])));
            y1[e] = cvtpk(bflo(o1[e]) * rstd * g[8 + 2 * e] * siluf(bflo(z1[e])), bfhi(o1[e]) * rstd * g[8 + 2 * e + 1] * siluf(bfhi(z1[e])));
        }
        *(u32x4*)op = y0; *(u32x4*)(op + 8) = y1;
    }
}

DI void p8_compress(const Params& p, LAS unsigned char* lds) {
    const int tid = otid(), lane = tid & 63, wave = __builtin_amdgcn_readfirstlane(tid >> 6);
    const int r32 = lane & 31, hh = lane >> 5;
    unsigned char* ws = p.ws;
    constexpr int L_AS = 0  , L_BS = 4608  , L_HS = L_BS + 36864  , L_C1 = L_HS + 16896  ;
    const bf16_t* kv = (const bf16_t*)(ws + WS_KV);
    for (int u = blockIdx.x; u < 256; u += gridDim.x) {
        const int which = u >> 7, bg = (u >> 3) & 15, nb = u & 7, b = bg >> 1, g = bg & 1;
        __syncthreads();
        if (tid < 256) { float a = 0.f; for (int kc = 0; kc < 16; ++kc) a += ((const float*)(ws + WS_C1P))[(kc * 2 + which) * 256 + tid]; ((LAS float*)(lds + L_C1))[tid] = a; }
        const bf16_t* w1t = (const bf16_t*)(ws + WS_W1T) + (size_t)which * 256 * 2048;
        f32x16 acc = zero16();
        for (int l = 0; l < 32; ++l) {
            __syncthreads();
            if (tid < 256) { const int row = tid >> 3, ch = tid & 7; int tk = 16 * (32 * nb + row) + l; tk = tk > 4095 ? 4095 : tk;
                *(LAS u32x4*)(lds + L_AS + row * 144 + ch * 16) = *(const u32x4*)(kv + ((size_t)b * 4096 + tk) * 768 + which * 128 + g * 64 + ch * 8); }
#pragma unroll
            for (int k = 0; k < 4; ++k) { const int ci = tid + 512 * k; const int row = ci >> 3, ch = ci & 7;
                *(LAS u32x4*)(lds + L_BS + row * 144 + ch * 16) = *(const u32x4*)(w1t + (size_t)row * 2048 + l * 64 + ch * 8); }
            __syncthreads();
            const LAS unsigned char* ab = lds + L_AS + r32 * 144 + hh * 16;
            const LAS unsigned char* bb = lds + L_BS + (32 * wave + r32) * 144 + hh * 16;
#pragma unroll
            for (int ks = 0; ks < 4; ++ks) acc = MFMA32(lds128(ab + ks * 32), lds128(bb + ks * 32), acc);
        }
        {
            const float c1 = ((LAS float*)(lds + L_C1))[32 * wave + r32];
#pragma unroll
            for (int reg = 0; reg < 16; ++reg) *(LAS bf16_t*)(lds + L_HS + crow(reg, hh) * 528 + (32 * wave + r32) * 2) = f2bf(siluf(acc[reg] + c1));
        }
        __syncthreads();
        if (wave < 2) {
            const bf16_t* w2t = (const bf16_t*)(ws + WS_W2T) + (size_t)(which * 64 + 32 * wave + r32) * 256 + hh * 8;
            const LAS unsigned char* ab = lds + L_HS + r32 * 528 + hh * 16;
            f32x16 o = zero16();
#pragma unroll
            for (int ks = 0; ks < 16; ++ks) o = MFMA32(lds128(ab + ks * 32), *(const bf16x8*)(w2t + ks * 16), o);
            bf16_t* dst = (bf16_t*)(ws + WS_CMP) + (size_t)(which * 16 + bg) * 256 * 64;
#pragma unroll
            for (int reg = 0; reg < 16; ++reg) { const int n = 32 * nb + crow(reg, hh); const bf16_t val = (n < 255) ? f2bf(o[reg]) : (bf16_t)0;
                if (which == 0) dst[n * 64 + 32 * wave + r32] = val; else dst[(32 * wave + r32) * 256 + n] = val; }
        }
    }
}

__device__ const unsigned char T5_BUCKET[128] = {0, 1, 2, 3, 4, 5, 6, 7, 8, 9, 10, 11, 12, 13, 14, 15, 16, 16, 16, 17, 17, 18, 18, 18, 19, 19, 19, 20, 20, 20, 20, 21, 21, 21, 21, 22, 22, 22, 22, 22, 23, 23, 23, 23, 23, 23, 24, 24, 24, 24, 24, 24, 25, 25, 25, 25, 25, 25, 25, 26, 26, 26, 26, 26, 26, 26, 26, 27, 27, 27, 27, 27, 27, 27, 27, 27, 27, 28, 28, 28, 28, 28, 28, 28, 28, 28, 28, 29, 29, 29, 29, 29, 29, 29, 29, 29, 29, 29, 29, 30, 30, 30, 30, 30, 30, 30, 30, 30, 30, 30, 30, 30, 30, 31, 31, 31, 31, 31, 31, 31, 31, 31, 31, 31, 31, 31, 31, 31};
constexpr float NEGBIG = -1e30f;

template <int PMODE> DI void p9_nsa(const Params& p, LAS unsigned char* lds) {
    const int tid0 = otid(); const int lane_k = tid0 & 63, wave = __builtin_amdgcn_readfirstlane(tid0 >> 6);
    unsigned char* ws = p.ws;
    constexpr int STG = 17920, L_K = 0, L_V = 9216, L_BT = 2 * STG, L_IA = L_BT + 4224, L_IB = L_IA + 8192, L_Y = L_IB + 8704;
    static_assert(L_Y + 65536 <= LDS_BYTES, "p9 lds");
    constexpr float LOG2E = 1.4426950408889634f;
    LAS float* YL = (LAS float*)(lds + L_Y) + wave * 2048;
    LAS float* BT = (LAS float*)(lds + L_BT);
    LAS float* IA = (LAS float*)(lds + L_IA) + wave * 256;
    LAS float* IB = (LAS float*)(lds + L_IB) + wave * 272;
    const bf16_t* kvb = (const bf16_t*)(ws + WS_KV);
    const bf16_t* cmpb = (const bf16_t*)(ws + WS_CMP);
    const bf16_t* vtb = (const bf16_t*)(ws + WS_VT);
    const bf16_t* projb = (const bf16_t*)(ws + WS_PROJB);
    const float* gates = (const float*)(ws + WS_GATES);
    const float* relb = p.in[2];
    for (int vc = blockIdx.x; vc < 256; vc += gridDim.x) {
        const int bg = vc >> 4, kk16 = vc & 15, b = bg >> 1, g = bg & 1;
        __syncthreads();
        for (int idx = otid(); idx < 1040; idx += 512) { const int hd_ = idx / 130, e = idx - hd_ * 130;
            BT[idx] = (e == 0) ? NEGBIG : relb[(e == 129 ? 31 : (int)T5_BUCKET[e - 1]) * 16 + g * 8 + hd_] * LOG2E; }
        for (int ju = 0; ju < 8; ++ju) {
            int lane = lane_k; asm volatile("" : "+v"(lane));
            const int tid = wave * 64 + lane, r32 = lane & 31, hh = lane >> 5, tok = r32 >> 3, hd = r32 & 7;
            const int srow = tid >> 3, sch = tid & 7;
            const int ub = (ju & 1) ? (32 * (ju >> 1) + 31 - kk16) : (32 * (ju >> 1) + kk16);
            const int t0 = 32 * ub, cur = ub >> 1;
            const int tq = t0 + 4 * wave + tok, head = g * 8 + hd;
            const int tqw = t0 + 4 * wave;
            const size_t trow = (size_t)b * 4096 + tq;
            __syncthreads();
            for (int idx = lane; idx < 256; idx += 64) IA[idx] = 0.f;
            for (int idx = lane; idx < 272; idx += 64) IB[idx] = 0.f;
            const float bfar = relb[31 * 16 + head] * LOG2E;
            bf16x8 Qf[4];
#pragma unroll
            for (int ks = 0; ks < 4; ++ks) Qf[ks] = *(const bf16x8*)(projb + trow * 4096 + head * 64 + 16 * ks + 8 * hh);
            const int nct = (ub >> 5) + 1;
            const int wlo = (t0 - 511) > 0 ? ((t0 - 511) >> 6) : 0;
            const int nwin = cur - wlo + 1;
            const int NT = 2 * nct + (cur + 1) + nwin;
            u32x4 kregA, vregA, kregB, vregB;
            auto tload = [&](u32x4& kreg, u32x4& vreg, int i) {
                const bf16_t *kp, *vp; int kstride, vstride;
                if (i < 2 * nct) { const int ti = i < nct ? i : i - nct; kp = cmpb + ((size_t)(0 * 16 + bg) * 256 + 64 * ti) * 64; kstride = 64; vp = cmpb + (size_t)(1 * 16 + bg) * 256 * 64 + 64 * ti; vstride = 256; }
                else if (i < 2 * nct + cur + 1) { const int s_ = i - 2 * nct; kp = kvb + ((size_t)b * 4096 + 64 * s_) * 768 + 256 + g * 64; kstride = 768; vp = vtb + (size_t)((0 * 8 + b) * 2 + g) * 64 * 4096 + 64 * s_; vstride = 4096; }
                else { const int blk = cur - (i - 2 * nct - cur - 1); kp = kvb + ((size_t)b * 4096 + 64 * blk) * 768 + 512 + g * 64; kstride = 768; vp = vtb + (size_t)((1 * 8 + b) * 2 + g) * 64 * 4096 + 64 * blk; vstride = 4096; }
                kreg = *(const u32x4*)(kp + (size_t)srow * kstride + sch * 8); vreg = *(const u32x4*)(vp + (size_t)srow * vstride + sch * 8);
            };
            auto twrite = [&](const u32x4& kreg, const u32x4& vreg, int st) {
                *(LAS u32x4*)(lds + st * STG + L_K + srow * 144 + sch * 16) = kreg;
                LAS u32x2* vd = (LAS u32x2*)(lds + st * STG + L_V + srow * 136 + sch * 16);
                vd[0] = (u32x2){vreg[0], vreg[1]}; vd[1] = (u32x2){vreg[2], vreg[3]};
            };
            tload(kregA, vregA, 0); twrite(kregA, vregA, 0);
            if (NT > 1) tload(kregB, vregB, 1);
            __syncthreads();
            float m_run = NEGBIG, l_run = 0.f, m_c = NEGBIG, linv_c = 0.f;
            f32x16 O[2]; O[0] = zero16(); O[1] = zero16();
            unsigned long long mymask = 0ull, wmask = 0ull;
            u32x2 zpre[8]; float gpre;
            auto zfetch = [&](int br) {
                int l2 = lane; asm volatile("" : "+v"(l2)); const int hh2 = l2 >> 5;
                gpre = gates[trow * 48 + br * 16 + head];
                const bf16_t* zp = projb + trow * 4096 + 1024 + br * 1024 + head * 64;
#pragma unroll
                for (int db = 0; db < 2; ++db)
#pragma unroll
                    for (int gi = 0; gi < 4; ++gi) zpre[db * 4 + gi] = *(const u32x2*)(zp + 32 * db + 8 * gi + 4 * hh2);
            };
            zfetch(0);
            auto finalize = [&](int br, bool normalized) {
                float inv = 1.f;
                if (!normalized) { const float L = l_run + __shfl_xor(l_run, 32); inv = 1.f / fmaxf(L, 1e-30f); }
                const float gt = gpre * inv;
#pragma unroll
                for (int db = 0; db < 2; ++db)
#pragma unroll
                    for (int gi = 0; gi < 4; ++gi) { const u32x2 zv = zpre[db * 4 + gi];
                        LAS float* yl = YL + (db * 16 + 4 * gi) * 64 + lane;
                        const float c0 = gt * O[db][4 * gi + 0] * siluf(bflo(zv[0])), c1 = gt * O[db][4 * gi + 1] * siluf(bfhi(zv[0]));
                        const float c2 = gt * O[db][4 * gi + 2] * siluf(bflo(zv[1])), c3 = gt * O[db][4 * gi + 3] * siluf(bfhi(zv[1]));
                        if (br == 0) { yl[0] = c0; yl[64] = c1; yl[128] = c2; yl[192] = c3; }
                        else { yl[0] += c0; yl[64] += c1; yl[128] += c2; yl[192] += c3; } }
                O[0] = zero16(); O[1] = zero16(); m_run = NEGBIG; l_run = 0.f;
                if (br < 2) zfetch(br + 1);
            };
            auto tile_body_p = [&](auto KT, auto MD, auto PAR, const int i, const int tix) {
                constexpr int kind = decltype(KT)::value; constexpr int mode = decltype(MD)::value; constexpr int par = decltype(PAR)::value;
                if (i + 2 < NT) { if constexpr (par) tload(kregB, vregB, i + 2); else tload(kregA, vregA, i + 2); }
                const LAS unsigned char* sb = lds + (i & 1) * STG;
                const bool skip = ((kind == 2) && (((wmask >> tix) & 1ull) == 0ull)) || PMODE == 1;
                if (!skip) {
                    bf16x8 kf[8];
#pragma unroll
                    for (int kb = 0; kb < 2; ++kb)
#pragma unroll
                        for (int ks = 0; ks < 4; ++ks) kf[kb * 4 + ks] = lds128(sb + L_K + (32 * kb + r32) * 144 + hh * 16 + ks * 32);
                    __builtin_amdgcn_sched_barrier(0);
                    f32x16 st[2];
#pragma unroll
                    for (int kb = 0; kb < 2; ++kb) { st[kb] = zero16();
#pragma unroll
                        for (int ks = 0; ks < 4; ++ks) st[kb] = MFMA32(kf[kb * 4 + ks], Qf[ks], st[kb]); }
                    bf16x8 vf[8];
                    if constexpr (kind != 0) {
#pragma unroll
                        for (int db = 0; db < 2; ++db)
#pragma unroll
                            for (int ks = 0; ks < 4; ++ks) { const LAS unsigned char* vr = sb + L_V + (32 * db + r32) * 136 + hh * 8 + ks * 32; vf[db * 4 + ks] = lds2x64(vr, vr + 16); }
                    }
                    __builtin_amdgcn_sched_barrier(0);
                    const bool selected = (kind != 2) || (((mymask >> tix) & 1ull) != 0ull);
                    float mx = NEGBIG;
                    if constexpr (mode == 1) {
                        int dbase = (kind <= 1) ? (tq - 30 - 1024 * tix - 64 * hh) : (tq + 1 - 64 * tix - 4 * hh);
                        asm volatile("" : "+v"(dbase));
                        constexpr int dmul = (kind <= 1) ? 16 : 1;
                        const LAS float* btl = BT + hd * 130;
                        float man[4] = {NEGBIG, NEGBIG, NEGBIG, NEGBIG};
#pragma unroll
                        for (int kb = 0; kb < 2; ++kb)
#pragma unroll
                            for (int reg = 0; reg < 16; ++reg) {
                                const int dr_ = dbase - dmul * (32 * kb + (reg & 3) + 8 * (reg >> 2)); const int di = dr_ < 0 ? 0 : (dr_ > 129 ? 129 : dr_);
                                const float sv = st[kb][reg] + btl[di];
                                st[kb][reg] = sv; man[reg & 3] = fmaxf(man[reg & 3], sv);
                            }
                        mx = fmaxf(fmaxf(man[0], man[1]), fmaxf(man[2], man[3]));
                        if (!selected) mx = NEGBIG;
                    } else if constexpr (mode == 2) {
                        int dbase = tq - 64 * tix - 4 * hh; asm volatile("" : "+v"(dbase));
#pragma unroll
                        for (int kb = 0; kb < 2; ++kb)
#pragma unroll
                            for (int reg = 0; reg < 16; ++reg) {
                                const int dist = dbase - (32 * kb + (reg & 3) + 8 * (reg >> 2));
                                const float sv = dist < 512 ? st[kb][reg] + bfar : NEGBIG;
                                st[kb][reg] = sv; mx = fmaxf(mx, sv);
                            }
                    } else {
                        float ma[4] = {NEGBIG, NEGBIG, NEGBIG, NEGBIG};
#pragma unroll
                        for (int kb = 0; kb < 2; ++kb)
#pragma unroll
                            for (int reg = 0; reg < 16; ++reg) ma[reg & 3] = fmaxf(ma[reg & 3], st[kb][reg]);
                        mx = fmaxf(fmaxf(ma[0], ma[1]), fmaxf(ma[2], ma[3]));
                        mx = selected ? mx + bfar : NEGBIG;
                    }
                    if constexpr (kind != 1) {
                        mx = fmaxf(mx, __shfl_xor(mx, 32));
                        const float mnew = fmaxf(m_run, mx);
                        const float alpha = __builtin_amdgcn_exp2f(m_run - mnew);
                        const float msub = selected ? (mode == 0 ? mnew - bfar : mnew) : 1e30f;
                        float ls;
                        {
                            const f32x2 ms2 = {msub, msub}; f32x2 acc2[4] = {{0.f, 0.f}, {0.f, 0.f}, {0.f, 0.f}, {0.f, 0.f}};
#pragma unroll
                            for (int kb = 0; kb < 2; ++kb)
#pragma unroll
                                for (int r2 = 0; r2 < 8; ++r2) { f32x2 v = {st[kb][2 * r2], st[kb][2 * r2 + 1]}; v = v - ms2;
                                    v[0] = __builtin_amdgcn_exp2f(v[0]); v[1] = __builtin_amdgcn_exp2f(v[1]); acc2[r2 & 3] = acc2[r2 & 3] + v; st[kb][2 * r2] = v[0]; st[kb][2 * r2 + 1] = v[1]; }
                            const f32x2 t2 = (acc2[0] + acc2[1]) + (acc2[2] + acc2[3]);
                            ls = t2[0] + t2[1];
                        }
                        l_run = l_run * alpha + ls; m_run = mnew;
                        if constexpr (kind != 0) { if (__ballot(alpha != 1.f) != 0ull) { O[0] = O[0] * alpha; O[1] = O[1] * alpha; } }
                    } else {
#pragma unroll
                        for (int kb = 0; kb < 2; ++kb) {
#pragma unroll
                            for (int reg = 0; reg < 16; ++reg) st[kb][reg] = __builtin_amdgcn_exp2f(st[kb][reg] - m_c) * linv_c;
#pragma unroll
                            for (int gi = 0; gi < 4; ++gi) {
                                float a = 2.f * (st[kb][4 * gi] + st[kb][4 * gi + 1] + st[kb][4 * gi + 2]) + st[kb][4 * gi + 3], bq = st[kb][4 * gi + 3];
                                a += __shfl_xor(a, 1); a += __shfl_xor(a, 2); a += __shfl_xor(a, 4);
                                bq += __shfl_xor(bq, 1); bq += __shfl_xor(bq, 2); bq += __shfl_xor(bq, 4);
                                const int sidx = 16 * tix + 8 * kb + 2 * gi + hh;
                                if (hd == 0) { IA[tok * 64 + sidx] = a; IB[tok * 68 + sidx + 1] = bq; }
                            }
                        }
                    }
                    if constexpr (kind != 0 && PMODE != 2) {
                        bf16x8 Pf[4];
#pragma unroll
                        for (int kb = 0; kb < 2; ++kb) { Pf[2 * kb] = pack8(st[kb], 0); Pf[2 * kb + 1] = pack8(st[kb], 1); }
                        __builtin_amdgcn_sched_barrier(0);
#pragma unroll
                        for (int ks = 0; ks < 4; ++ks)
#pragma unroll
                            for (int db = 0; db < 2; ++db) O[db] = MFMA32(vf[db * 4 + ks], Pf[ks], O[db]);
                    }
                }
                __builtin_amdgcn_sched_barrier(0);
                if (i + 1 < NT) { if constexpr (par) twrite(kregA, vregA, (i + 1) & 1); else twrite(kregB, vregB, (i + 1) & 1); }
                __syncthreads();
            };
            auto tile_body = [&](auto KT, auto MD, const int i, const int tix) {
                if (i & 1) tile_body_p(KT, MD, std::integral_constant<int, 1>{}, i, tix); else tile_body_p(KT, MD, std::integral_constant<int, 0>{}, i, tix);
            };
            using IC0 = std::integral_constant<int, 0>; using IC1 = std::integral_constant<int, 1>; using IC2 = std::integral_constant<int, 2>; using IC3 = std::integral_constant<int, 3>;
            int ti = 0;
#pragma unroll 1
            for (int t = 0; t < nct; ++t, ++ti) tile_body(IC0{}, IC1{}, ti, t);
            { const float L = l_run + __shfl_xor(l_run, 32); m_c = m_run; linv_c = (tq >= 31) ? 1.f / fmaxf(L, 1e-30f) : 0.f; m_run = NEGBIG; l_run = 0.f; }
#pragma unroll 1
            for (int t = 0; t < nct; ++t, ++ti) tile_body(IC1{}, IC1{}, ti, t);
            finalize(0, true);
            {
                wmask = 0ull; mymask = 0ull;
#pragma unroll 1
                for (int tk = 0; tk < 4; ++tk) {
                    float v = IA[tk * 64 + lane] + IB[tk * 68 + lane];
                    if (lane == 0 || lane == cur || lane == cur - 1) v = 1e9f; else if (lane > cur) v = -1e9f;
                    int rank = 0;
#pragma unroll 8
                    for (int j = 0; j < 64; ++j) { const float vj = __shfl(v, j); rank += ((vj > v) || (vj == v && j < lane)) ? 1 : 0; }
                    const unsigned long long mk = __ballot(rank < 16);
                    wmask |= mk; if (tok == tk) mymask = mk;
                }
            }
            const int nfar_s = (tqw - 176 >= 0) ? ((tqw - 176) >> 6) + 1 : 0;
#pragma unroll 1
            for (int t = 0; t <= cur; ++t, ++ti) { if (t < nfar_s) tile_body(IC2{}, IC0{}, ti, t); else tile_body(IC2{}, IC1{}, ti, t); }
            finalize(1, false);
#pragma unroll 1
            for (int t = 0; t < nwin; ++t, ++ti) { const int blk = cur - t;
                const bool oldw = (tqw + 3 - 64 * blk > 511), nearw = (tqw - 64 * blk - 63 < 113);
                if (oldw) tile_body(IC3{}, IC2{}, ti, blk); else if (nearw) tile_body(IC3{}, IC1{}, ti, blk); else tile_body(IC3{}, IC0{}, ti, blk); }
            finalize(2, false);
            if (PMODE != 0) continue;
            bf16_t* yp = (bf16_t*)(ws + WS_RA) + trow * 1024 + head * 64;
#pragma unroll
            for (int db = 0; db < 2; ++db)
#pragma unroll
                for (int gi = 0; gi < 4; ++gi) { const LAS float* yl = YL + (db * 16 + 4 * gi) * 64 + lane; u32x2 o; o.x = cvtpk(yl[0], yl[64]); o.y = cvtpk(yl[128], yl[192]);
                    *(u32x2*)(yp + 32 * db + 8 * gi + 4 * hh) = o; }
        }
    }
}

DI void p11_final(const Params& p) {
    const int tid = otid(), lane = tid & 63, wave = tid >> 6;
    const float* ssq = (const float*)(p.ws + WS_SSQ);
    f32x4 g4[4];
#pragma unroll
    for (int j = 0; j < 4; ++j) g4[j] = *((const f32x4*)p.in[22] + lane + 64 * j);
    const int stride = gridDim.x * 8;
    int m = blockIdx.x * 8 + wave;
    f32x4 vn[4]; float sn = 0.f;
    auto ld = [&](int mm) { f32x4* xr = (f32x4*)(p.out + (size_t)mm * 1024) + lane;
#pragma unroll
        for (int j = 0; j < 4; ++j) vn[j] = xr[64 * j];
        sn = (lane < 16) ? ssq[(size_t)lane * M + mm] : 0.f; };
    if (m < M) ld(m);
    for (; m < M; m += stride) {
        f32x4 v[4]; for (int j = 0; j < 4; ++j) v[j] = vn[j]; float s = sn;
        if (m + stride < M) ld(m + stride);
        s += __shfl_xor(s, 1); s += __shfl_xor(s, 2); s += __shfl_xor(s, 4); s += __shfl_xor(s, 8);
        s = __shfl(s, 0);
        const float rstd = rsqrtf(s * (1.f / 1024.f) + EPS);
        f32x4* xr = (f32x4*)(p.out + (size_t)m * 1024) + lane;
#pragma unroll
        for (int j = 0; j < 4; ++j) xr[64 * j] = v[j] * rstd * g4[j];
    }
}

template <int PH> DI void run_phase(const Params& p, LAS unsigned char* lds) {
    unsigned char* ws = p.ws;
    const int G = gridDim.x;
    bf16_t* h0 = (bf16_t*)((unsigned char*)p.out + 64 * MiB);
    if constexpr (PH == 0) p0_prologue(p, lds);
    if constexpr (PH == 1) norm_rows<0>(p, lds);
    if constexpr (PH == 2 || PH == 4) {
        constexpr int half = (PH - 2) / 2;
        pg8::Gemm g{h0, h0 + (size_t)half * 16384 * 1024, 0, (const bf16_t*)(ws + WS_WA), 16384, 4096, 1024}; pg8::StaticOrder S; S.init(16384, 4096, G, (int)blockIdx.x);
        EpiA E{(bf16_t*)(ws + WS_RA), (bf16_t*)p.out, half * 16384};
        pg8::gemm_phase<EpiA, true>(lds, g, S, E);
    }
    if constexpr (PH == 3 || PH == 5) p3_prep(p, lds, (PH - 3) / 2);
    if constexpr (PH == 6) p4_scan<0>(p, lds);
    if constexpr (PH == 14) p4b_onorm(p);
    if constexpr (PH == 100) p4_scan<1>(p, lds);
    if constexpr (PH == 101) p4_scan<2>(p, lds);
    if constexpr (PH == 7) {
        const bf16_t* ya = (const bf16_t*)(ws + WS_RA);
        pg8::Gemm g{ya, ya, 0, (const bf16_t*)(ws + WS_WAO), M, 1024, 1024}; pg8::StaticOrder S; S.init(M, 1024, G, (int)blockIdx.x);
        EpiRes<false> E{p.in[0], p.out, (const float*)(ws + WS_MOD), nullptr};
        pg8::gemm_phase<EpiRes<false>, true>(lds, g, S, E);
    }
    if constexpr (PH == 8) norm_rows<1>(p, lds);
    if constexpr (PH == 9) {
        pg8::Gemm g{(const bf16_t*)(ws + WS_S), (const bf16_t*)(ws + WS_RA), 3, (const bf16_t*)(ws + WS_WCAT), M, 5120, 1024}; pg8::StaticOrder S; S.init(M, 5120, G, (int)blockIdx.x);
        EpiB E{(bf16_t*)(ws + WS_KV), (bf16_t*)(ws + WS_PROJB), (float*)(ws + WS_GATES), (bf16_t*)(ws + WS_VT)};
        pg8::gemm_phase<EpiB, true>(lds, g, S, E);
    }
    if constexpr (PH == 10) p8_compress(p, lds);
    if constexpr (PH == 11) p9_nsa<0>(p, lds);
    if constexpr (PH == 110) p9_nsa<1>(p, lds);
    if constexpr (PH == 111) p9_nsa<2>(p, lds);
    if constexpr (PH == 12) {
        const bf16_t* yb = (const bf16_t*)(ws + WS_RA);
        pg8::Gemm g{yb, yb, 0, (const bf16_t*)(ws + WS_WBO), M, 1024, 1024}; pg8::StaticOrder S; S.init(M, 1024, G, (int)blockIdx.x);
        EpiRes<true> E{p.out, p.out, (const float*)(ws + WS_MOD) + 8 * 3072, (float*)(ws + WS_SSQ)};
        pg8::gemm_phase<EpiRes<true>, true>(lds, g, S, E);
    }
    if constexpr (PH == 13) p11_final(p);
}
#if MK_ONE_LAUNCH
__global__ void __launch_bounds__(512, 2) fwd_kernel(Params p) {
    extern __shared__ __attribute__((aligned(16))) unsigned char lds_raw[];
    LAS unsigned char* lds = (LAS unsigned char*)lds_raw;
    volatile LAS unsigned* misc = (volatile LAS unsigned*)(lds + LDS_BYTES - 64);
    if (threadIdx.x < 16) misc[threadIdx.x] = 0u;
    __syncthreads();
    XcdBarrier bar = xcd_barrier_post((unsigned*)(p.ws + WS_CTL) + 1024, misc);
    run_phase<0>(p, lds); xcd_barrier(bar); if (DUP_MASK & (1 << 0)) { run_phase<0>(p, lds); xcd_barrier(bar); }
    run_phase<1>(p, lds); xcd_barrier(bar); if (DUP_MASK & (1 << 1)) { run_phase<1>(p, lds); xcd_barrier(bar); }
    run_phase<2>(p, lds); xcd_barrier(bar); if (DUP_MASK & (1 << 2)) { run_phase<2>(p, lds); xcd_barrier(bar); }
    run_phase<3>(p, lds); xcd_barrier(bar); if (DUP_MASK & (1 << 3)) { run_phase<3>(p, lds); xcd_barrier(bar); }
    run_phase<4>(p, lds); xcd_barrier(bar); if (DUP_MASK & (1 << 4)) { run_phase<4>(p, lds); xcd_barrier(bar); }
    run_phase<5>(p, lds); xcd_barrier(bar); if (DUP_MASK & (1 << 5)) { run_phase<5>(p, lds); xcd_barrier(bar); }
    run_phase<6>(p, lds); xcd_barrier(bar); if (DUP_MASK & (1 << 6)) { run_phase<6>(p, lds); xcd_barrier(bar); }
#if defined(PROBE_SCAN)
    run_phase<PROBE_SCAN>(p, lds); xcd_barrier(bar);
#endif
    run_phase<14>(p, lds); xcd_barrier(bar);
    run_phase<7>(p, lds); xcd_barrier(bar); if (DUP_MASK & (1 << 7)) { run_phase<7>(p, lds); xcd_barrier(bar); }
    run_phase<8>(p, lds); xcd_barrier(bar); if (DUP_MASK & (1 << 8)) { run_phase<8>(p, lds); xcd_barrier(bar); }
    run_phase<9>(p, lds); xcd_barrier(bar); if (DUP_MASK & (1 << 9)) { run_phase<9>(p, lds); xcd_barrier(bar); }
    run_phase<10>(p, lds); xcd_barrier(bar); if (DUP_MASK & (1 << 10)) { run_phase<10>(p, lds); xcd_barrier(bar); }
    run_phase<11>(p, lds); xcd_barrier(bar); if (DUP_MASK & (1 << 11)) { run_phase<11>(p, lds); xcd_barrier(bar); }
#if defined(PROBE_NSA)
    run_phase<PROBE_NSA>(p, lds); xcd_barrier(bar);
#endif
    run_phase<12>(p, lds); xcd_barrier(bar); if (DUP_MASK & (1 << 12)) { run_phase<12>(p, lds); xcd_barrier(bar); }
    run_phase<13>(p, lds);
}
#else
template <int PH> __global__ void __launch_bounds__(512, 2) phase_kernel(Params p) {
    extern __shared__ __attribute__((aligned(16))) unsigned char lds_raw[];
    run_phase<PH>(p, (LAS unsigned char*)lds_raw);
}
template <int PH> static void launch_phase(const Params& a, int grid, hipStream_t stream) {
    static bool attr = false;
    if (!attr) { (void)hipFuncSetAttribute((const void*)phase_kernel<PH>, hipFuncAttributeMaxDynamicSharedMemorySize, LDS_BYTES); attr = true; }
    hipLaunchKernelGGL(phase_kernel<PH>, dim3(grid), dim3(512), LDS_BYTES, stream, a);
}
#endif

extern "C" void kernel_launch(void* const* d_in, const int* in_sizes, int n_in, void* d_out, int out_size, void* d_ws, size_t ws_size, hipStream_t stream) {
    static int grid = 0;
    if (grid == 0) {
        if (n_in != 23 || out_size != M * D || ws_size < WS_END) { fprintf(stderr, "kernel_launch: unexpected shapes (n_in %d out %d ws %zu)\n", n_in, out_size, ws_size); grid = -1; return; }
        int dev = 0, cus = 0;
        if (hipGetDevice(&dev) != hipSuccess || hipDeviceGetAttribute(&cus, hipDeviceAttributeMultiprocessorCount, dev) != hipSuccess) { grid = -1; return; }
#if MK_ONE_LAUNCH
        if (hipFuncSetAttribute((const void*)fwd_kernel, hipFuncAttributeMaxDynamicSharedMemorySize, LDS_BYTES) != hipSuccess) { fprintf(stderr, "kernel_launch: hipFuncSetAttribute failed\n"); grid = -1; return; }
        int per_cu = 0;
        if (hipOccupancyMaxActiveBlocksPerMultiprocessor(&per_cu, (const void*)fwd_kernel, 512, LDS_BYTES) != hipSuccess || per_cu < 1) fprintf(stderr, "kernel_launch: occupancy query says %d\n", per_cu);
        (void)hipGetLastError();
#endif
        grid = cus;
    }
    if (grid < 0) return;
    Params a{};
    for (int i = 0; i < 23; ++i) a.in[i] = (const float*)d_in[i];
    a.out = (float*)d_out; a.ws = (unsigned char*)d_ws;
    a.ph_lo = 0; a.ph_hi = NPH;
#if MK_ONE_LAUNCH
    hipMemsetAsync((char*)d_ws + WS_CTL, 0, 65536, stream);
    hipLaunchKernelGGL(fwd_kernel, dim3(grid), dim3(512), LDS_BYTES, stream, a);
#else
    launch_phase<0>(a, grid, stream); launch_phase<1>(a, grid, stream); launch_phase<2>(a, grid, stream); launch_phase<3>(a, grid, stream);
    launch_phase<4>(a, grid, stream); launch_phase<5>(a, grid, stream); launch_phase<6>(a, grid, stream); launch_phase<14>(a, grid, stream); launch_phase<7>(a, grid, stream);
    launch_phase<8>(a, grid, stream); launch_phase<9>(a, grid, stream); launch_phase<10>(a, grid, stream); launch_phase<11>(a, grid, stream);
    launch_phase<12>(a, grid, stream); launch_phase<13>(a, grid, stream);
#endif
}
```

```cpp
#include <hip/hip_runtime.h>
#include <cstdio>
#include <cstdint>
#include <type_traits>

#define DI __device__ __forceinline__
#define LAS __attribute__((address_space(3)))
typedef unsigned short bf16_t;
typedef short bf16x8 __attribute__((ext_vector_type(8)));
typedef short s16x4 __attribute__((ext_vector_type(4)));
typedef float f32x4 __attribute__((ext_vector_type(4)));
typedef float f32x2 __attribute__((ext_vector_type(2)));
typedef float f32x16 __attribute__((ext_vector_type(16)));
typedef unsigned u32x4 __attribute__((ext_vector_type(4)));
typedef unsigned u32x2 __attribute__((ext_vector_type(2)));
typedef __bf16 bf16x2_t __attribute__((ext_vector_type(2)));

#ifndef DUP_MASK
#define DUP_MASK 0
#endif
#ifndef MK_ONE_LAUNCH
#define MK_ONE_LAUNCH 1
#endif

constexpr int NB = 8, T = 4096, D = 1024, M = NB * T;
constexpr int A_LD = 4112, B_LD = 4144;
constexpr float EPS = 1e-6f;
constexpr int NPH = 14;

constexpr size_t MiB = 1u << 20;
constexpr size_t WS_CTL = 0;
constexpr size_t WS_MODP = 1 * MiB;
constexpr size_t WS_WA = 4 * MiB;
constexpr size_t WS_WAO = 12 * MiB;
constexpr size_t WS_WCAT = 14 * MiB;
constexpr size_t WS_WBO = 24 * MiB;
constexpr size_t WS_W1T = 26 * MiB;
constexpr size_t WS_W2T = 28 * MiB;
constexpr size_t WS_C1P = 28 * MiB + 65536;
constexpr size_t WS_MOD = 28 * MiB + 131072;
constexpr size_t WS_SSQ = 28 * MiB + 524288;
constexpr size_t WS_BG = 31 * MiB;
constexpr size_t WS_GL = 33 * MiB;
constexpr size_t WS_RA = 34 * MiB;
constexpr size_t WS_RP = 130 * MiB;
constexpr size_t WS_PW = WS_RP;
constexpr size_t WS_PQD = WS_RP + 64 * MiB;
constexpr size_t WS_PKDT = WS_RP + 128 * MiB;
constexpr size_t WS_PU = WS_RP + 192 * MiB;
constexpr size_t WS_PAT = WS_RP + 256 * MiB;
constexpr size_t WS_PROJB = WS_RP;
constexpr size_t WS_S = WS_RP + 256 * MiB;
constexpr size_t WS_KV = WS_RP + 320 * MiB;
constexpr size_t WS_GATES = WS_RP + 368 * MiB;
constexpr size_t WS_CMP = WS_RP + 374 * MiB;
constexpr size_t WS_END = WS_RP + 375 * MiB;
constexpr size_t WS_VT = WS_RA + 64 * MiB;

constexpr int LDS_BYTES = 155648;

DI unsigned cvtpk(float lo, float hi) { f32x2 v = {lo, hi}; bf16x2_t b = __builtin_convertvector(v, bf16x2_t); return __builtin_bit_cast(unsigned, b); }
DI bf16_t f2bf(float f) { return (bf16_t)(cvtpk(f, 0.f) & 0xffffu); }
DI float bf2f(bf16_t v) { return __uint_as_float((unsigned)v << 16); }
DI float bflo(unsigned u) { return __uint_as_float(u << 16); }
DI float bfhi(unsigned u) { return __uint_as_float(u & 0xffff0000u); }
DI float sigm(float x) { return __builtin_amdgcn_rcpf(1.f + __builtin_amdgcn_exp2f(-1.4426950408889634f * x)); }
DI float siluf(float x) { return x * sigm(x); }
DI float wave_sum(float v) {
#pragma unroll
    for (int o = 1; o < 64; o <<= 1) v += __shfl_xor(v, o);
    return v;
}
DI int crow(int reg, int h) { return (reg & 3) + 8 * (reg >> 2) + 4 * h; }
#define MFMA32(a, b, c) __builtin_amdgcn_mfma_f32_32x32x16_bf16((a), (b), (c), 0, 0, 0)
DI bf16x8 pack8(const f32x16& x, const int s) {
    u32x4 p;
    p[0] = cvtpk(x[8 * s + 0], x[8 * s + 1]); p[1] = cvtpk(x[8 * s + 2], x[8 * s + 3]);
    p[2] = cvtpk(x[8 * s + 4], x[8 * s + 5]); p[3] = cvtpk(x[8 * s + 6], x[8 * s + 7]);
    return __builtin_bit_cast(bf16x8, p);
}
DI bf16x8 lds128(const LAS unsigned char* p) { return *(const LAS bf16x8*)p; }
DI bf16x8 lds2x64(const LAS unsigned char* lo, const LAS unsigned char* hi) {
    const s16x4 a = *(const LAS s16x4*)lo, b = *(const LAS s16x4*)hi;
    return __builtin_shufflevector(a, b, 0, 1, 2, 3, 4, 5, 6, 7);
}
DI int otid() { int t = threadIdx.x; asm volatile("" : "+v"(t)); return t; }
DI f32x16 zero16() { f32x16 z; for (int i = 0; i < 16; ++i) z[i] = 0.f; return z; }

struct Params { const float* in[23]; float* out; unsigned char* ws; int ph_lo, ph_hi, pad0, pad1; };

#define XB_TMO      128
#define XB_XCNT(j)  (256  + 64 * (j))
#define XB_XSUB(j)  (1280 + 64 * (j))
#define XB_XGEN(j)  (2304 + 64 * (j))
#define XB_TOP      3328
#define XB_TOPGEN   3392
#define XCD_BAR_WORDS 3456
#define XB_SPIN_CAP (1u << 22)
DI unsigned xb_ld(unsigned* p)              { return __hip_atomic_load(p, __ATOMIC_RELAXED, __HIP_MEMORY_SCOPE_AGENT); }
DI unsigned xb_add(unsigned* p, unsigned v) { return __hip_atomic_fetch_add(p, v, __ATOMIC_RELAXED, __HIP_MEMORY_SCOPE_AGENT); }
DI unsigned xb_xcc_id() { return (unsigned)__builtin_amdgcn_s_getreg((3 << 11) | 20) & 0xFu; }
#define XB_SPIN(cond, bar) do { unsigned _sp = 0; while (cond) { __builtin_amdgcn_s_sleep(1); \
    if ((++_sp & 255u) == 0u) { if (xb_ld(&(bar)[XB_TMO])) break; if (_sp > XB_SPIN_CAP) { atomicAdd(&(bar)[XB_TMO], 1u); break; } } } } while (0)
struct XcdBarrier { unsigned* bar; unsigned x; volatile LAS unsigned* st; };
DI XcdBarrier xcd_barrier_post(unsigned* bar, volatile LAS unsigned* st) {
    XcdBarrier b; b.bar = bar; b.x = xb_xcc_id(); b.st = st;
    if (threadIdx.x == 0) (void)xb_add(&bar[XB_XCNT(b.x)], 1u);
    return b;
}
DI void xcd_barrier_complete(unsigned* bar, unsigned x, unsigned& nloc, unsigned& nx) {
    const unsigned G = gridDim.x * gridDim.y * gridDim.z;
    unsigned sum, cnt, mine, sp = 0u;
    for (;;) {
        sum = 0u; cnt = 0u; mine = 0u;
#pragma unroll
        for (unsigned j = 0; j < 16; ++j) { const unsigned c = xb_ld(&bar[XB_XCNT(j)]); sum += c; cnt += (c > 0u) ? 1u : 0u; mine = (j == x) ? c : mine; }
        if (sum == G) break;
        __builtin_amdgcn_s_sleep(1);
        if ((++sp & 255u) == 0u) { if (xb_ld(&bar[XB_TMO])) break; if (sp > XB_SPIN_CAP) { atomicAdd(&bar[XB_TMO], 1u); break; } }
    }
    nloc = mine > 0u ? mine : 1u; nx = cnt > 0u ? cnt : 1u;
}
DI void xcd_barrier(const XcdBarrier& b) {
    asm volatile("s_waitcnt vmcnt(0)" ::: "memory");
    __syncthreads();
    if (threadIdx.x == 0) {
        unsigned* bar = b.bar;
        __builtin_amdgcn_s_waitcnt(0);
        unsigned nloc = b.st[0], nx = b.st[1];
        if (nloc == 0u) { xcd_barrier_complete(bar, b.x, nloc, nx); b.st[0] = nloc; b.st[1] = nx; }
        const unsigned old = xb_add(&bar[XB_XSUB(b.x)], 1u);
        const unsigned gen = old / nloc;
        if (old + 1u == (gen + 1u) * nloc) {
            __builtin_amdgcn_fence(__ATOMIC_RELEASE, "agent");
            asm volatile("s_waitcnt vmcnt(0)" ::: "memory");
            const unsigned og = xb_add(&bar[XB_TOP], 1u);
            const unsigned tg = og / nx;
            if (og + 1u == (tg + 1u) * nx) xb_add(&bar[XB_TOPGEN], 1u);
            else XB_SPIN(xb_ld(&bar[XB_TOPGEN]) == tg, bar);
            __builtin_amdgcn_fence(__ATOMIC_ACQUIRE, "agent");
            xb_add(&bar[XB_XGEN(b.x)], 1u);
            asm volatile("s_waitcnt vmcnt(0)" ::: "memory");
        } else {
            XB_SPIN(xb_ld(&bar[XB_XGEN(b.x)]) == gen, bar);
            __builtin_amdgcn_fence(__ATOMIC_ACQUIRE, "agent");
            asm volatile("s_waitcnt vmcnt(0)" ::: "memory");
        }
    }
    __syncthreads();
}

namespace pg8 {
constexpr int BM = 256, BK = 64, HALF = 128, HTB = HALF * BK * 2, STAGE_BYTES = 8 * HTB, NXCD = 8, WGM = 8;
DI int lds_byte(int r, int c) { const int st = (r >> 4) * 2 + (c >> 5), rr = r & 15, cc = c & 31, ob = rr * 64 + cc * 2; return st * 1024 + (ob ^ (((ob >> 9) & 1) << 5)); }
DI void stage_rc(int b, int& R, int& C) { const int st = b / 1024, sb = b % 1024, swz = sb ^ (((sb >> 9) & 1) << 5); R = (st >> 1) * 16 + swz / 64; C = (st & 1) * 32 + (swz % 64) / 2; }
DI int perm32(int rho) { const int n = rho >> 4, i = rho & 15; return 8 * (i >> 2) + 4 * n + (i & 3); }
struct Unit { int pm, pn; };
struct Gemm { const bf16_t* A0; const bf16_t* A1; int split; const bf16_t* Bt; int M, N, K; };
struct StaticOrder {
    int nM, nN, nwg, G, c;
    DI void init(int M_, int N_, int G_, int c_) { nM = M_ / BM; nN = N_ / BM; nwg = nM * nN; G = G_; c = c_; }
    DI bool next(int i, Unit& u) const {
        const long L = (long)i * G + c; if (L >= nwg) return false;
        int wgid = (int)L; { const int q = nwg / NXCD, r = nwg % NXCD, xcd = wgid % NXCD, off = wgid / NXCD; wgid = (xcd < r ? xcd * (q + 1) : r * (q + 1) + (xcd - r) * q) + off; }
        const int nig = WGM * nN, gid = wgid / nig, fm = gid * WGM, gsz = (nM - fm) < WGM ? (nM - fm) : WGM;
        u.pm = fm + ((wgid % nig) % gsz); u.pn = (wgid % nig) / gsz; return true;
    }
};
template <class Epi, bool ALIGN_EPI>
DI void gemm_phase(LAS unsigned char* lds, const Gemm g, const StaticOrder& S, const Epi& E) {
    const int tid = otid(), wid = __builtin_amdgcn_readfirstlane(tid >> 6), lane = tid & 63, wr = wid >> 2, wc = wid & 3, fr = lane & 15, fq = lane >> 4;
    const int K = g.K, nt = K / BK;
    unsigned voffA[2], voffB[2];
#pragma unroll
    for (int i = 0; i < 2; ++i) { int R, C; stage_rc(tid * 16 + i * 8192, R, C); const int Rb = Epi::PERM ? ((R & ~31) + perm32(R & 31)) : R;
        voffA[i] = (unsigned)(R * K + C) * 2u; voffB[i] = (unsigned)(Rb * K + C) * 2u; }
    const size_t kstep = (size_t)(BK * 2);
    const size_t hstep = (size_t)HALF * K * 2;
    const size_t tstep = 2 * hstep;
    const unsigned ldsw = (unsigned)wid * 1024u;
    const int aoff = lds_byte(wr * 64 + fr, fq * 8), boff = lds_byte(wc * 32 + fr, fq * 8);
#define PG8_SA(b, h) (((b) * 2 + (h)) * HTB)
#define PG8_SB(b, h) ((4 + (b) * 2 + (h)) * HTB)
#define PG8_STAGE(bufoff, gbase, voff) do { _Pragma("unroll") for (int _i = 0; _i < 2; ++_i) \
        __builtin_amdgcn_global_load_lds((const unsigned*)((const char*)(gbase) + (voff)[_i]), (LAS unsigned*)(lds + (bufoff) + ldsw + _i * 8192), 16, 0, 0); } while (0)
#define PG8_LDA(dst, b, h) do { _Pragma("unroll") for (int m = 0; m < 4; ++m) _Pragma("unroll") for (int k = 0; k < 2; ++k) dst[m][k] = *(const LAS bf16x8*)(lds + PG8_SA(b, h) + aoff + m * 2048 + k * 1024); } while (0)
#define PG8_LDB(dst, b, h) do { _Pragma("unroll") for (int n = 0; n < 2; ++n) _Pragma("unroll") for (int k = 0; k < 2; ++k) dst[n][k] = *(const LAS bf16x8*)(lds + PG8_SB(b, h) + boff + n * 2048 + k * 1024); } while (0)
#define PG8_MMA(ai, bj, At, Bt) do { __builtin_amdgcn_s_setprio(1); _Pragma("unroll") for (int m = 0; m < 4; ++m) _Pragma("unroll") for (int n = 0; n < 2; ++n) _Pragma("unroll") for (int k = 0; k < 2; ++k) \
        acc[ai][bj][m][n] = __builtin_amdgcn_mfma_f32_16x16x32_bf16(Bt[n][k], At[m][k], acc[ai][bj][m][n], 0, 0, 0); __builtin_amdgcn_s_setprio(0); } while (0)
#define PG8_WAIT_V(n) asm volatile("s_waitcnt vmcnt(" #n ")" ::: "memory")
#define PG8_WAIT_L(n) asm volatile("s_waitcnt lgkmcnt(" #n ")" ::: "memory")
#define PG8_BAR __builtin_amdgcn_s_barrier()
#define PG8_SCHED __builtin_amdgcn_sched_barrier(0)
    Unit cur, nxt; int ui = 0;
    if (!S.next(0, cur)) return;
    f32x4 acc[2][2][4][2];
#pragma unroll
    for (int a = 0; a < 2; ++a)
#pragma unroll
        for (int b = 0; b < 2; ++b)
#pragma unroll
            for (int m = 0; m < 4; ++m)
#pragma unroll
                for (int n = 0; n < 2; ++n) acc[a][b][m][n] = (f32x4){0.f, 0.f, 0.f, 0.f};
    bf16x8 At[4][2], B0[2][2], B1[2][2];
    const char* cA = (const char*)(cur.pn < g.split ? g.A0 : g.A1) + (size_t)cur.pm * tstep; const char* cB = (const char*)g.Bt + (size_t)cur.pn * tstep;
    PG8_STAGE(PG8_SB(0, 0), cB, voffB); PG8_STAGE(PG8_SB(0, 1), cB + hstep, voffB); PG8_STAGE(PG8_SA(0, 0), cA, voffA); PG8_STAGE(PG8_SA(0, 1), cA + hstep, voffA);
    if (wr == 1) PG8_BAR;
    PG8_WAIT_V(2); PG8_BAR;
    PG8_STAGE(PG8_SB(1, 0), cB + kstep, voffB); PG8_STAGE(PG8_SA(1, 0), cA + kstep, voffA); PG8_STAGE(PG8_SB(1, 1), cB + hstep + kstep, voffB);
    PG8_WAIT_V(6); PG8_BAR;
    for (;;) {
        const bool has_next = S.next(ui + 1, nxt);
        const char* nA = has_next ? (const char*)(nxt.pn < g.split ? g.A0 : g.A1) + (size_t)nxt.pm * tstep : cA; const char* nB = has_next ? (const char*)g.Bt + (size_t)nxt.pn * tstep : cB;
        for (int t = 0; t < nt; t += 2) {
            const bool last = (t == nt - 2);
            const char* a1 = cA + (size_t)(t + 1) * kstep;
            const char* a2 = last ? nA : cA + (size_t)(t + 2) * kstep; const char* b2 = last ? nB : cB + (size_t)(t + 2) * kstep;
            const char* a3 = a2 + kstep; const char* b3 = b2 + kstep;
            PG8_LDB(B0, 0, 0); PG8_LDB(B1, 0, 1); PG8_SCHED; PG8_LDA(At, 0, 0); PG8_STAGE(PG8_SA(1, 1), a1 + hstep, voffA);
            PG8_WAIT_V(8); PG8_WAIT_L(0); PG8_BAR; PG8_MMA(0, 0, At, B0); PG8_MMA(0, 1, At, B1); PG8_BAR; PG8_SCHED;
            PG8_LDA(At, 0, 1); PG8_STAGE(PG8_SB(0, 0), b2, voffB); PG8_STAGE(PG8_SB(0, 1), b2 + hstep, voffB); PG8_STAGE(PG8_SA(0, 0), a2, voffA);
            PG8_WAIT_V(8); PG8_WAIT_L(0); PG8_BAR; PG8_MMA(1, 0, At, B0); PG8_MMA(1, 1, At, B1); PG8_BAR; PG8_SCHED;
            PG8_LDB(B0, 1, 0); PG8_LDB(B1, 1, 1); PG8_SCHED; PG8_LDA(At, 1, 0); PG8_STAGE(PG8_SA(0, 1), a2 + hstep, voffA);
            PG8_WAIT_V(8); PG8_WAIT_L(0); PG8_BAR; PG8_MMA(0, 0, At, B0); PG8_MMA(0, 1, At, B1); PG8_BAR; PG8_SCHED;
            PG8_LDA(At, 1, 1); PG8_STAGE(PG8_SB(1, 0), b3, voffB); PG8_STAGE(PG8_SB(1, 1), b3 + hstep, voffB); PG8_STAGE(PG8_SA(1, 0), a3, voffA);
            PG8_WAIT_V(8); PG8_WAIT_L(0); PG8_BAR; PG8_MMA(1, 0, At, B0); PG8_MMA(1, 1, At, B1); PG8_BAR; PG8_SCHED;
        }
        if constexpr (ALIGN_EPI) { if (wr == 0) PG8_BAR; }
        E(acc, cur, wr, wc, fr, fq);
        if (!has_next) break;
#pragma unroll
        for (int a = 0; a < 2; ++a)
#pragma unroll
            for (int b = 0; b < 2; ++b)
#pragma unroll
                for (int m = 0; m < 4; ++m)
#pragma unroll
                    for (int n = 0; n < 2; ++n) acc[a][b][m][n] = (f32x4){0.f, 0.f, 0.f, 0.f};
        cur = nxt; cA = nA; cB = nB; ++ui;
        if constexpr (ALIGN_EPI) { if (wr == 1) PG8_BAR; }
    }
    PG8_WAIT_V(0);
    if constexpr (!ALIGN_EPI) { if (wr == 0) PG8_BAR; }
    PG8_BAR;
#undef PG8_SA
#undef PG8_SB
#undef PG8_STAGE
#undef PG8_LDA
#undef PG8_LDB
#undef PG8_MMA
#undef PG8_WAIT_V
#undef PG8_WAIT_L
#undef PG8_BAR
#undef PG8_SCHED
}
}

struct EpiA {
    static constexpr bool PERM = true;
    bf16_t* qkv; bf16_t* z; int row_off;
    DI void operator()(const f32x4 (&acc)[2][2][4][2], const pg8::Unit& u, int wr, int wc, int fr, int fq) const {
        const int row0 = u.pm * 256 + wr * 64 + fr; const int ct = u.pn * 256 + wc * 32 + 8 * fq;
        bf16_t* base; int ldc, col0;
        if (u.pn < 12) { base = qkv + (size_t)row0 * 3072; ldc = 3072; col0 = ct; } else { base = z + (size_t)(row_off + row0) * 1024; ldc = 1024; col0 = ct - 3072; }
#pragma unroll
        for (int ai = 0; ai < 2; ++ai)
#pragma unroll
            for (int m = 0; m < 4; ++m) { bf16_t* rowp = base + (size_t)(ai * 128 + m * 16) * ldc + col0;
#pragma unroll
                for (int bj = 0; bj < 2; ++bj) { const f32x4 v0 = acc[ai][bj][m][0], v1 = acc[ai][bj][m][1];
                    u32x4 w; w.x = cvtpk(v0[0], v0[1]); w.y = cvtpk(v0[2], v0[3]); w.z = cvtpk(v1[0], v1[1]); w.w = cvtpk(v1[2], v1[3]);
                    *(u32x4*)(rowp + bj * 128) = w; } }
    }
};
template <bool SSQ> struct EpiRes {
    static constexpr bool PERM = false;
    const float* base; float* out; const float* gate  ; float* ssq;
    DI void operator()(const f32x4 (&acc)[2][2][4][2], const pg8::Unit& u, int wr, int wc, int fr, int fq) const {
        const int col0 = u.pn * 256 + wc * 32 + 4 * fq; const int b = (u.pm * 256) >> 12;
        f32x4 gv[2][2];
#pragma unroll
        for (int bj = 0; bj < 2; ++bj)
#pragma unroll
            for (int n = 0; n < 2; ++n) gv[bj][n] = *(const f32x4*)(gate + (size_t)b * 3072 + 2048 + col0 + bj * 128 + n * 16);
#pragma unroll
        for (int ai = 0; ai < 2; ++ai)
#pragma unroll
            for (int m = 0; m < 4; ++m) { const int r = u.pm * 256 + ai * 128 + wr * 64 + m * 16 + fr; const size_t off = (size_t)r * 1024 + col0; float ss = 0.f;
#pragma unroll
                for (int bj = 0; bj < 2; ++bj)
#pragma unroll
                    for (int n = 0; n < 2; ++n) { const f32x4 bs = *(const f32x4*)(base + off + bj * 128 + n * 16); const f32x4 o = bs + gv[bj][n] * acc[ai][bj][m][n];
                        *(f32x4*)(out + off + bj * 128 + n * 16) = o; if (SSQ) ss += (o[0] * o[0] + o[1] * o[1]) + (o[2] * o[2] + o[3] * o[3]); }
                if (SSQ) { ss += __shfl_xor(ss, 16); ss += __shfl_xor(ss, 32); if (fq == 0) ssq[(size_t)(u.pn * 4 + wc) * M + r] = ss; } }
    }
};
struct EpiB {
    static constexpr bool PERM = true;
    bf16_t* kv; bf16_t* projb; float* gates; bf16_t* vt;
    DI void operator()(const f32x4 (&acc)[2][2][4][2], const pg8::Unit& u, int wr, int wc, int fr, int fq) const {
        const int row0 = u.pm * 256 + wr * 64 + fr; const int cw = wc * 32 + 8 * fq;
        if (u.pn == 19) {
#pragma unroll
            for (int ai = 0; ai < 2; ++ai)
#pragma unroll
                for (int m = 0; m < 4; ++m) { float* rowp = gates + (size_t)(row0 + ai * 128 + m * 16) * 48;
                    if (cw < 48) {
#pragma unroll
                        for (int n = 0; n < 2; ++n) { const f32x4 v = acc[ai][0][m][n]; f32x4 o; o[0] = sigm(v[0]); o[1] = sigm(v[1]); o[2] = sigm(v[2]); o[3] = sigm(v[3]); *(f32x4*)(rowp + cw + 4 * n) = o; } } }
            return;
        }
        if (u.pn == 1 || u.pn == 2) {
            const int gq = wc >> 1, d0 = (wc & 1) * 32 + 8 * fq;
#pragma unroll
            for (int ai = 0; ai < 2; ++ai)
#pragma unroll
                for (int m = 0; m < 4; ++m) { const int row = row0 + ai * 128 + m * 16; const int bb = row >> 12, t = row & 4095;
                    bf16_t* vp = vt + ((size_t)(((u.pn - 1) * 8 + bb) * 2 + gq) * 64 + d0) * 4096 + t;
                    const f32x4 v0 = acc[ai][1][m][0], v1 = acc[ai][1][m][1];
                    vp[0 * 4096] = f2bf(v0[0]); vp[1 * 4096] = f2bf(v0[1]); vp[2 * 4096] = f2bf(v0[2]); vp[3 * 4096] = f2bf(v0[3]);
                    vp[4 * 4096] = f2bf(v1[0]); vp[5 * 4096] = f2bf(v1[1]); vp[6 * 4096] = f2bf(v1[2]); vp[7 * 4096] = f2bf(v1[3]); }
        }
        bf16_t* base; int ldc, col0; float sc = 1.f;
        if (u.pn < 3) { base = kv + (size_t)row0 * 768; ldc = 768; col0 = u.pn * 256 + cw; } else { base = projb + (size_t)row0 * 4096; ldc = 4096; col0 = (u.pn - 3) * 256 + cw; if (u.pn < 7) sc = 0.125f * 1.4426950408889634f; }
#pragma unroll
        for (int ai = 0; ai < 2; ++ai)
#pragma unroll
            for (int m = 0; m < 4; ++m) { bf16_t* rowp = base + (size_t)(ai * 128 + m * 16) * ldc + col0;
#pragma unroll
                for (int bj = 0; bj < 2; ++bj) { const f32x4 v0 = acc[ai][bj][m][0] * sc, v1 = acc[ai][bj][m][1] * sc;
                    u32x4 w; w.x = cvtpk(v0[0], v0[1]); w.y = cvtpk(v0[2], v0[3]); w.z = cvtpk(v1[0], v1[1]); w.w = cvtpk(v1[2], v1[3]);
                    *(u32x4*)(rowp + bj * 128) = w; } }
    }
};

DI void p0_transpose_item(const float* W, int ld, int col0, int nvalid, int K, bf16_t* WT, int row_off, LAS float* scr, int item, int nblk, int lane) {
    const int kb = item / nblk, nb = item % nblk, k0 = 64 * kb, n0 = 32 * nb;
    const int nn = n0 + (lane & 31);
#pragma unroll 8
    for (int i = 0; i < 32; ++i) { const int kk = 2 * i + (lane >> 5); scr[kk * 33 + (lane & 31)] = (nn < nvalid) ? W[(size_t)(k0 + kk) * ld + col0 + nn] : 0.f; }
    asm volatile("s_waitcnt lgkmcnt(0)" ::: "memory");
    const int c = lane & 7;
#pragma unroll
    for (int j = 0; j < 4; ++j) { const int n = (lane >> 3) + 8 * j; const LAS float* s = scr + (8 * c) * 33 + n;
        u32x4 o; o.x = cvtpk(s[0 * 33], s[1 * 33]); o.y = cvtpk(s[2 * 33], s[3 * 33]); o.z = cvtpk(s[4 * 33], s[5 * 33]); o.w = cvtpk(s[6 * 33], s[7 * 33]);
        *(u32x4*)(WT + (size_t)(row_off + n0 + n) * K + k0 + 8 * c) = o; }
    asm volatile("s_waitcnt lgkmcnt(0)" ::: "memory");
}
template <int PART> DI void p0_prologue(const Params& p, LAS unsigned char* lds, const int b0, const int nb) {
    const int tid = otid(), lane = tid & 63, wave = __builtin_amdgcn_readfirstlane(tid >> 6);
    LAS float* scr = (LAS float*)(lds + wave * 8704);
    const int gw = ((int)blockIdx.x - b0) * 8 + wave, NGW = nb * 8;
    if ((int)blockIdx.x < b0 || (int)blockIdx.x >= b0 + nb) return;
    unsigned char* ws = p.ws;
    constexpr int I_ADA = 1536, I_WA = 16 * 128, I_WAO = 16 * 32, I_KV = 16 * 24, I_WB = 16 * 128, I_WG = 16 * 8, I_WBO = 16 * 32, I_W1 = 32 * 8, I_W2 = 4 * 2, I_C1 = 128;
    constexpr int NITEMS = I_ADA + I_WA + I_WAO + I_KV + I_WB + I_WG + I_WBO + 2 * I_W1 + 2 * I_W2 + I_C1;
    constexpr int N_P0 = I_ADA + I_WA + I_WAO;
    constexpr int N_P1 = I_KV + I_WB + I_WG + I_WBO + 2 * I_W1 + 2 * I_W2;
    constexpr int NLOOP = PART == 0 ? N_P0 + I_C1 : N_P1;
    static_assert(N_P0 + N_P1 + I_C1 == NITEMS, "p0 items");
    for (int it0 = gw; it0 < NLOOP; it0 += NGW) {
        int r = __builtin_amdgcn_readfirstlane(it0);
        if (PART == 0) { if (r >= N_P0) r += N_P1; } else r += N_P0;
        if (r < I_ADA) {
            const int l = r / 768, rem = r % 768, jc = rem / 16, kc = rem % 16;
            const float* c = p.in[1]; const float* w = p.in[3] + (size_t)l * 1024 * 3072;
            float a[8]; for (int b = 0; b < 8; ++b) a[b] = 0.f;
            const int j = jc * 64 + lane;
            for (int kk = 0; kk < 64; ++kk) { const int k = kc * 64 + kk; const float wv = w[(size_t)k * 3072 + j];
#pragma unroll
                for (int b = 0; b < 8; ++b) { const float cv = c[b * 1024 + k]; a[b] += siluf(cv) * wv; } }
            float* modp = (float*)(ws + WS_MODP);
#pragma unroll
            for (int b = 0; b < 8; ++b) modp[(size_t)((kc * 2 + l) * 8 + b) * 3072 + j] = a[b];
            continue;
        }
        r -= I_ADA;
        if (r < I_WA) { p0_transpose_item(p.in[6], A_LD, 0, 4096, 1024, (bf16_t*)(ws + WS_WA), 0, scr, r, 128, lane); continue; } r -= I_WA;
        if (r < I_WAO) { p0_transpose_item(p.in[11], 1024, 0, 1024, 1024, (bf16_t*)(ws + WS_WAO), 0, scr, r, 32, lane); continue; } r -= I_WAO;
        if (r < I_KV) { p0_transpose_item(p.in[13], 768, 0, 768, 1024, (bf16_t*)(ws + WS_WCAT), 0, scr, r, 24, lane); continue; } r -= I_KV;
        if (r < I_WB) { p0_transpose_item(p.in[20], B_LD, 0, 4096, 1024, (bf16_t*)(ws + WS_WCAT), 768, scr, r, 128, lane); continue; } r -= I_WB;
        if (r < I_WG) { p0_transpose_item(p.in[20], B_LD, 4096, 48, 1024, (bf16_t*)(ws + WS_WCAT), 4864, scr, r, 8, lane); continue; } r -= I_WG;
        if (r < I_WBO) { p0_transpose_item(p.in[21], 1024, 0, 1024, 1024, (bf16_t*)(ws + WS_WBO), 0, scr, r, 32, lane); continue; } r -= I_WBO;
        if (r < I_W1) { p0_transpose_item(p.in[16], 256, 0, 256, 2048, (bf16_t*)(ws + WS_W1T), 0, scr, r, 8, lane); continue; } r -= I_W1;
        if (r < I_W1) { p0_transpose_item(p.in[18], 256, 0, 256, 2048, (bf16_t*)(ws + WS_W1T), 256, scr, r, 8, lane); continue; } r -= I_W1;
        if (r < I_W2) { p0_transpose_item(p.in[17], 64, 0, 64, 256, (bf16_t*)(ws + WS_W2T), 0, scr, r, 2, lane); continue; } r -= I_W2;
        if (r < I_W2) { p0_transpose_item(p.in[19], 64, 0, 64, 256, (bf16_t*)(ws + WS_W2T), 64, scr, r, 2, lane); continue; } r -= I_W2;
        {
            const int which = r / 64, rem = r % 64, jc = rem / 16, kc = rem % 16;
            const float* pos = p.in[14 + which]; const float* w1 = p.in[16 + 2 * which];
            const int j = jc * 64 + lane; float a = 0.f;
            for (int kk = 0; kk < 128; ++kk) { const int k = kc * 128 + kk; a += pos[k] * w1[(size_t)k * 256 + j]; }
            ((float*)(ws + WS_C1P))[(kc * 2 + which) * 256 + j] = a;
        }
    }
}

template <int LAYER> DI void norm_rows(const Params& p, LAS unsigned char* lds) {
    const int tid = otid(), lane = tid & 63, wave = __builtin_amdgcn_readfirstlane(tid >> 6);
    unsigned char* ws = p.ws;
    LAS float* gs = (LAS float*)lds;
    LAS float* sh = gs + 1024;
    LAS float* g2 = sh + 1024;
    LAS float* wba = g2 + 1024;
    const float* xin = LAYER == 0 ? p.in[0] : p.out;
    bf16_t* hout = LAYER == 0 ? (bf16_t*)((unsigned char*)p.out + 64 * MiB) : (bf16_t*)(ws + WS_RA);
    bf16_t* sout = (bf16_t*)(ws + WS_S);
    const float* modp = (const float*)(ws + WS_MODP);
    float* mod = (float*)(ws + WS_MOD);
    for (int rb = blockIdx.x; rb < 256; rb += gridDim.x) {
        const int b = rb >> 5;
        __syncthreads();
        for (int k = tid; k < 1024; k += 512) {
            float v[3];
#pragma unroll
            for (int part = 0; part < 3; ++part) { float a = p.in[4][LAYER * 3072 + part * 1024 + k];
                for (int kc = 0; kc < 16; ++kc) a += modp[(size_t)((kc * 2 + LAYER) * 8 + b) * 3072 + part * 1024 + k];
                v[part] = a; if ((rb & 31) == 0) mod[(size_t)(LAYER * 8 + b) * 3072 + part * 1024 + k] = a; }
            gs[k] = p.in[5][LAYER * 1024 + k] * (1.f + v[1]); sh[k] = v[0];
            if (LAYER == 1) g2[k] = p.in[12][k];
        }
        if (LAYER == 0) for (int i = tid; i < 16 * 1024; i += 512) { const int c = i & 15, k = i >> 4; wba[c * 1024 + k] = p.in[6][(size_t)k * A_LD + 4096 + c]; }
        __syncthreads();
        f32x4 vn[4];
        { const f32x4* xr0 = (const f32x4*)(xin + (size_t)(rb * 128 + wave * 16) * 1024) + lane;
#pragma unroll
          for (int j = 0; j < 4; ++j) vn[j] = xr0[64 * j]; }
        for (int rr = 0; rr < 16; ++rr) {
            const int m = rb * 128 + wave * 16 + rr;
            f32x4 v[4]; float s = 0.f;
#pragma unroll
            for (int j = 0; j < 4; ++j) { v[j] = vn[j]; s += (v[j][0] * v[j][0] + v[j][1] * v[j][1]) + (v[j][2] * v[j][2] + v[j][3] * v[j][3]); }
            if (rr + 1 < 16) { const f32x4* xr1 = (const f32x4*)(xin + (size_t)(m + 1) * 1024) + lane;
#pragma unroll
                for (int j = 0; j < 4; ++j) vn[j] = xr1[64 * j]; }
            const float rstd = rsqrtf(wave_sum(s) * (1.f / 1024.f) + EPS);
            f32x4 hv[4];
#pragma unroll
            for (int j = 0; j < 4; ++j) { const f32x4 g4 = *(const LAS f32x4*)(gs + 4 * lane + 256 * j), s4 = *(const LAS f32x4*)(sh + 4 * lane + 256 * j);
                const f32x4 xn = v[j] * rstd; hv[j] = xn * g4 + s4;
                u32x2 o; o.x = cvtpk(hv[j][0], hv[j][1]); o.y = cvtpk(hv[j][2], hv[j][3]);
                *((u32x2*)(hout + (size_t)m * 1024) + lane + 64 * j) = o;
                if (LAYER == 1) { const f32x4 k4 = *(const LAS f32x4*)(g2 + 4 * lane + 256 * j); const f32x4 sv = xn * k4; u32x2 o2; o2.x = cvtpk(sv[0], sv[1]); o2.y = cvtpk(sv[2], sv[3]);
                    *((u32x2*)(sout + (size_t)m * 1024) + lane + 64 * j) = o2; } }
            if (LAYER == 0) {
                float pa[16];
#pragma unroll
                for (int c = 0; c < 16; ++c) { float a = 0.f;
#pragma unroll
                    for (int j = 0; j < 4; ++j) { const f32x4 w4 = *(const LAS f32x4*)(wba + c * 1024 + 4 * lane + 256 * j); a += (hv[j][0] * w4[0] + hv[j][1] * w4[1]) + (hv[j][2] * w4[2] + hv[j][3] * w4[3]); }
                    pa[c] = a; if (c & 1) __builtin_amdgcn_sched_barrier(0); }
                {
                    const bool up = (lane & 32) != 0; float q[8];
#pragma unroll
                    for (int c = 0; c < 8; ++c) { const float keep = up ? pa[8 + c] : pa[c], give = up ? pa[c] : pa[8 + c]; q[c] = keep + __shfl_xor(give, 32); }
                    const bool up2 = (lane & 16) != 0; float r4[4];
#pragma unroll
                    for (int c = 0; c < 4; ++c) { const float keep = up2 ? q[4 + c] : q[c], give = up2 ? q[c] : q[4 + c]; r4[c] = keep + __shfl_xor(give, 16); }
                    const bool up3 = (lane & 8) != 0; float r2[2];
#pragma unroll
                    for (int c = 0; c < 2; ++c) { const float keep = up3 ? r4[2 + c] : r4[c], give = up3 ? r4[c] : r4[2 + c]; r2[c] = keep + __shfl_xor(give, 8); }
                    const bool up4 = (lane & 4) != 0;
                    const float keep = up4 ? r2[1] : r2[0], give = up4 ? r2[0] : r2[1];
                    float r1 = keep + __shfl_xor(give, 4);
                    r1 += __shfl_xor(r1, 2); r1 += __shfl_xor(r1, 1);
                    pa[0] = r1;
                }
                const int mycol = ((lane >> 5) & 1) * 8 + ((lane >> 4) & 1) * 4 + ((lane >> 3) & 1) * 2 + ((lane >> 2) & 1);
                const float mine = pa[0];
                if ((lane & 3) == 0) { float o; const int cc = mycol;
                    if (cc < 8) o = sigm(mine);
                    else { const float xx = mine + p.in[9][cc - 8]; const float sp = xx > 20.f ? xx : log1pf(__expf(xx)); o = -__expf(p.in[8][cc - 8]) * sp; }
                    ((float*)(ws + WS_BG))[(size_t)m * 16 + cc] = o; }
            }
        }
    }
}

DI void mm16_acc(float (&acc)[4], const LAS float* X, int px, const LAS float* Y, int py, int c, int q) {
    float y[16];
#pragma unroll
    for (int kk = 0; kk < 16; ++kk) y[kk] = Y[kk * py + c];
#pragma unroll
    for (int h2 = 0; h2 < 2; ++h2) {
        f32x4 xv[2][4];
#pragma unroll
        for (int rr = 0; rr < 2; ++rr)
#pragma unroll
            for (int k4 = 0; k4 < 4; ++k4) xv[rr][k4] = *(const LAS f32x4*)(X + (4 * q + 2 * h2 + rr) * px + 4 * k4);
#pragma unroll
        for (int k4 = 0; k4 < 4; ++k4)
#pragma unroll
            for (int rr = 0; rr < 2; ++rr)
                acc[2 * h2 + rr] += (xv[rr][k4][0] * y[4 * k4] + xv[rr][k4][1] * y[4 * k4 + 1]) + (xv[rr][k4][2] * y[4 * k4 + 2] + xv[rr][k4][3] * y[4 * k4 + 3]);
    }
}
template <int K> DI float row_bcast16(float v) {
    return __builtin_bit_cast(float, __builtin_amdgcn_update_dpp(0, __builtin_bit_cast(int, v), 0x150 + K, 0xf, 0xf, false));
}
template <int I, int K> struct InvRow {
    static DI void run(const float (&mcol)[16], const float (&tt)[16], float& s) { InvRow<I, K - 1>::run(mcol, tt, s); s += row_bcast16<K>(mcol[I]) * tt[K]; }
};
template <int I> struct InvRow<I, -1> { static DI void run(const float (&)[16], const float (&)[16], float&) {} };
template <int I> struct InvAll {
    static DI void run(const float (&mcol)[16], float (&tt)[16], int c) { InvAll<I - 1>::run(mcol, tt, c); float s = 0.f; InvRow<I, I - 1>::run(mcol, tt, s); tt[I] = (I == c ? 1.f : 0.f) - s;
        __builtin_amdgcn_sched_barrier(0); }
};
template <> struct InvAll<-1> { static DI void run(const float (&)[16], float (&)[16], int) {} };
DI void p3_prep(const Params& p, LAS unsigned char* lds, const int half) {
    const int tid = otid(), lane_k = tid & 63, wave = __builtin_amdgcn_readfirstlane(tid >> 6);
    unsigned char* ws = p.ws;
    constexpr int L_CW = 0, L_QS = 6144, L_KS = L_QS + 17408, L_VBT = L_KS + 17408, L_KBGT = L_VBT + 18432, L_KDT = L_KBGT + 18432,
                  L_LM = L_KDT + 18432, L_TM = L_LM + 17408, L_TB = L_TM + 17408  , L_PM = L_TB + 9216, L_GC = L_PM + 2560, L_BETA = L_GC + 256, L_SS = L_BETA + 256;
    static_assert(L_SS + 4096 <= LDS_BYTES, "p3 lds");
    LAS float* Lm = (LAS float*)(lds + L_LM);
    LAS float* Tm = (LAS float*)(lds + L_TM);
    LAS float* Pm = (LAS float*)(lds + L_PM);
    LAS float* gcs = (LAS float*)(lds + L_GC);
    LAS float* betas = (LAS float*)(lds + L_BETA);
    const bf16_t* qkv = (const bf16_t*)(ws + WS_RA);
    const float* bg = (const float*)(ws + WS_BG);
    for (int g8 = blockIdx.x; g8 < 256; g8 += gridDim.x) {
        const int bl = g8 >> 6, h = (g8 >> 3) & 7, nbase = (g8 & 7) * 8;
        __syncthreads();
        float cwr[3][4][2];
#pragma unroll
        for (int X = 0; X < 3; ++X)
#pragma unroll
            for (int k = 0; k < 4; ++k) { const f32x2 w2 = *(const f32x2*)(p.in[7] + (size_t)k * 3072 + X * 1024 + h * 128 + 2 * lane_k); cwr[X][k][0] = w2[0]; cwr[X][k][1] = w2[1]; }
        unsigned xr[3][11];
        float gpre = 0.f, bpre = 0.f;
        auto xload = [&](int n_) {
            int ln = lane_k; asm volatile("" : "+v"(ln));
#pragma unroll
            for (int X = 0; X < 3; ++X)
#pragma unroll
                for (int j = 0; j < 11; ++j) { const int tt = n_ * 64 + 8 * wave + j - 3;
                    xr[X][j] = (tt >= 0) ? *(const unsigned*)(qkv + ((size_t)bl * 4096 + tt) * 3072 + X * 1024 + h * 128 + 2 * ln) : 0u; }
        };
        auto gload = [&](int n_) { if (wave == 0) { const size_t row = (size_t)(half * 4 + bl) * 4096 + n_ * 64 + lane_k; gpre = bg[row * 16 + 8 + h]; bpre = bg[row * 16 + h]; } };
        xload(nbase); gload(nbase);
        for (int nn = 0; nn < 8; ++nn) {
            int lane = lane_k, r32, hh; asm volatile("" : "+v"(lane));
            r32 = lane & 31; hh = lane >> 5;
            const int tid = wave * 64 + lane;
            const int n = nbase + nn;
            const int bglob = half * 4 + bl;
            const int ug = (bglob * 8 + h) * 64 + n;
            if (wave == 0) {
                float gv = gpre;
#pragma unroll
                for (int o = 1; o < 64; o <<= 1) { const float t = __shfl_up(gv, o); if (lane >= o) gv += t; }
                gcs[lane] = gv; betas[lane] = bpre;
            }
            if (nn + 1 < 8) gload(n + 1);
            __syncthreads();
            {
                const int tb = 8 * wave;
                const float gc_last = gcs[63];
#pragma unroll
                for (int X = 0; X < 3; ++X) {
                    float x0[11], x1[11];
#pragma unroll
                    for (int j = 0; j < 11; ++j) { x0[j] = bflo(xr[X][j]); x1[j] = bfhi(xr[X][j]); }
                    float y0[8], y1[8];
#pragma unroll
                    for (int tk = 0; tk < 8; ++tk) {
                        float a0 = 0.f, a1 = 0.f;
#pragma unroll
                        for (int k = 0; k < 4; ++k) { a0 += cwr[X][k][0] * x0[tk + k]; a1 += cwr[X][k][1] * x1[tk + k]; }
                        y0[tk] = siluf(a0); y1[tk] = siluf(a1);
                    }
                    if (X == 0) {
#pragma unroll
                        for (int tk = 0; tk < 8; ++tk) {
                            const int i = tb + tk;
                            const float rq = rsqrtf(wave_sum(y0[tk] * y0[tk] + y1[tk] * y1[tk]) + EPS) * 0.08838834764831845f;
                            const float q0 = y0[tk] * rq, q1 = y1[tk] * rq, eg = __expf(gcs[i]);
                            *(LAS unsigned*)(lds + L_QS + i * 272 + lane * 4) = cvtpk(q0, q1);
                            *(unsigned*)((bf16_t*)(ws + WS_PQD) + ((size_t)ug * 64 + i) * 128 + 2 * lane) = cvtpk(q0 * eg, q1 * eg);
                        }
                    } else if (X == 1) {
                        float b0[8], b1[8], d0[8], d1[8];
#pragma unroll
                        for (int tk = 0; tk < 8; ++tk) {
                            const int i = tb + tk;
                            const float rk = rsqrtf(wave_sum(y0[tk] * y0[tk] + y1[tk] * y1[tk]) + EPS);
                            const float k0 = y0[tk] * rk, k1 = y1[tk] * rk, gci = gcs[i];
                            const float fb = betas[i] * __expf(gci), fd = __expf(gc_last - gci);
                            *(LAS unsigned*)(lds + L_KS + i * 272 + lane * 4) = cvtpk(k0, k1);
                            b0[tk] = k0 * fb; b1[tk] = k1 * fb; d0[tk] = k0 * fd; d1[tk] = k1 * fd;
                        }
                        u32x4 w;
                        w.x = cvtpk(b0[0], b0[1]); w.y = cvtpk(b0[2], b0[3]); w.z = cvtpk(b0[4], b0[5]); w.w = cvtpk(b0[6], b0[7]); *(LAS u32x4*)(lds + L_KBGT + (2 * lane) * 144 + tb * 2) = w;
                        w.x = cvtpk(b1[0], b1[1]); w.y = cvtpk(b1[2], b1[3]); w.z = cvtpk(b1[4], b1[5]); w.w = cvtpk(b1[6], b1[7]); *(LAS u32x4*)(lds + L_KBGT + (2 * lane + 1) * 144 + tb * 2) = w;
                        w.x = cvtpk(d0[0], d0[1]); w.y = cvtpk(d0[2], d0[3]); w.z = cvtpk(d0[4], d0[5]); w.w = cvtpk(d0[6], d0[7]); *(LAS u32x4*)(lds + L_KDT + (2 * lane) * 144 + tb * 2) = w;
                        w.x = cvtpk(d1[0], d1[1]); w.y = cvtpk(d1[2], d1[3]); w.z = cvtpk(d1[4], d1[5]); w.w = cvtpk(d1[6], d1[7]); *(LAS u32x4*)(lds + L_KDT + (2 * lane + 1) * 144 + tb * 2) = w;
                    } else {
#pragma unroll
                        for (int tk = 0; tk < 8; ++tk) { const float bt = betas[tb + tk]; y0[tk] *= bt; y1[tk] *= bt; }
                        u32x4 w;
                        w.x = cvtpk(y0[0], y0[1]); w.y = cvtpk(y0[2], y0[3]); w.z = cvtpk(y0[4], y0[5]); w.w = cvtpk(y0[6], y0[7]); *(LAS u32x4*)(lds + L_VBT + (2 * lane) * 144 + tb * 2) = w;
                        w.x = cvtpk(y1[0], y1[1]); w.y = cvtpk(y1[2], y1[3]); w.z = cvtpk(y1[4], y1[5]); w.w = cvtpk(y1[6], y1[7]); *(LAS u32x4*)(lds + L_VBT + (2 * lane + 1) * 144 + tb * 2) = w;
                    }
                }
            }
            if (nn + 1 < 8) xload(n + 1);
            __syncthreads();
            {
                int lane_c = lane; asm volatile("" : "+v"(lane_c)); const int r32 = lane_c & 31, hh = lane_c >> 5;
                const int which = wave >> 2, mi = (wave >> 1) & 1, ni = wave & 1;
                f32x16 acc = zero16();
                if (!(mi == 0 && ni == 1)) {
                    const LAS unsigned char* ab = lds + (which ? L_QS : L_KS) + (32 * mi + r32) * 272 + hh * 16;
                    const LAS unsigned char* bb = lds + L_KS + (32 * ni + r32) * 272 + hh * 16;
#pragma unroll
                    for (int ks = 0; ks < 8; ++ks) acc = MFMA32(lds128(ab + ks * 32), lds128(bb + ks * 32), acc);
                }
                const int j = 32 * ni + r32; const float gcj = gcs[j];
                bf16_t* at = (bf16_t*)(ws + WS_PAT) + (size_t)ug * 4096;
#pragma unroll
                for (int reg = 0; reg < 16; ++reg) {
                    const int ii = 32 * mi + crow(reg, hh);
                    const float dec = (ii >= j) ? __expf(gcs[ii] - gcj) : 0.f;
                    if (which == 0) Lm[ii * 68 + j] = (ii > j) ? betas[ii] * acc[reg] * dec : 0.f;
                    else at[ii * 64 + j] = f2bf(acc[reg] * dec);
                }
            }
            __syncthreads();
            if (wave == 0) {
                const int a = lane >> 4, c = lane & 15;
                float mcol[16], tt[16];
#pragma unroll
                for (int ii = 0; ii < 16; ++ii) mcol[ii] = Lm[(16 * a + ii) * 68 + 16 * a + c];
                InvAll<15>::run(mcol, tt, c);
#pragma unroll
                for (int ii = 0; ii < 16; ++ii) Tm[(16 * a + ii) * 68 + 16 * a + c] = tt[ii];
            } else {
                int tid_d = tid; asm volatile("" : "+v"(tid_d));
                bf16_t* dst = (bf16_t*)(ws + WS_PKDT) + (size_t)ug * 8192;
                for (int ci = tid_d - 64; ci < 1024; ci += 448) { const int row = ci >> 3, ch = ci & 7;
                    *(u32x4*)(dst + row * 64 + ch * 8) = *(const LAS u32x4*)(lds + L_KDT + row * 144 + ch * 16); }
                if (tid_d == 64) ((float*)(ws + WS_GL))[ug] = __expf(gcs[63]);
            }
            __syncthreads();
            if (wave < 2) {
                const int aa = 2 * wave + 1, bb = 2 * wave, c = lane & 15, q = lane >> 4;
                LAS float* Pw = Pm + wave * 320;
                float acc[4] = {0.f, 0.f, 0.f, 0.f};
                mm16_acc(acc, Lm + (16 * aa) * 68 + 16 * bb, 68, Tm + (16 * bb) * 68 + 16 * bb, 68, c, q);
#pragma unroll
                for (int rr = 0; rr < 4; ++rr) Pw[(4 * q + rr) * 20 + c] = acc[rr];
                float acc2[4] = {0.f, 0.f, 0.f, 0.f};
                mm16_acc(acc2, Tm + (16 * aa) * 68 + 16 * aa, 68, Pw, 20, c, q);
#pragma unroll
                for (int rr = 0; rr < 4; ++rr) Tm[(16 * aa + 4 * q + rr) * 68 + 16 * bb + c] = -acc2[rr];
            }
            __syncthreads();
            for (int e = tid; e < 3072; e += 512) { const int which = e >> 10, ii = (e >> 5) & 31, j = e & 31;
                float v;
                if (which == 2) v = -Lm[(32 + ii) * 68 + j];
                else { const int o = 32 * which; v = ((j >> 4) > (ii >> 4)) ? 0.f : Tm[(o + ii) * 68 + o + j]; }
                *(LAS bf16_t*)(lds + L_TB + which * 2560 + ii * 80 + j * 2) = f2bf(v); }
            __syncthreads();
            {
                int lane_e = lane; asm volatile("" : "+v"(lane_e)); const int r32 = lane_e & 31, hh = lane_e >> 5;
                const int mat = wave >> 2, nb = wave & 3;
                const LAS unsigned char* xt = lds + (mat ? L_KBGT : L_VBT) + (32 * nb + r32) * 144;
                const LAS unsigned char* td0 = lds + L_TB + r32 * 80, *td1 = td0 + 2560, *nm = td0 + 5120;
                f32x16 acc0 = zero16();
#pragma unroll
                for (int ks = 0; ks < 2; ++ks) acc0 = MFMA32(lds128(td0 + hh * 16 + ks * 32), lds128(xt + hh * 16 + ks * 32), acc0);
                f32x16 acc1;
#pragma unroll
                for (int gq = 0; gq < 4; ++gq) { const u32x2 v = *(const LAS u32x2*)(xt + (32 + 8 * gq + 4 * hh) * 2);
                    acc1[4 * gq] = bflo(v[0]); acc1[4 * gq + 1] = bfhi(v[0]); acc1[4 * gq + 2] = bflo(v[1]); acc1[4 * gq + 3] = bfhi(v[1]); }
#pragma unroll
                for (int s2 = 0; s2 < 2; ++s2) acc1 = MFMA32(lds2x64(nm + hh * 8 + s2 * 32, nm + hh * 8 + s2 * 32 + 16), pack8(acc0, s2), acc1);
                f32x16 acc2 = zero16();
#pragma unroll
                for (int s2 = 0; s2 < 2; ++s2) acc2 = MFMA32(lds2x64(td1 + hh * 8 + s2 * 32, td1 + hh * 8 + s2 * 32 + 16), pack8(acc1, s2), acc2);
#pragma unroll
                for (int mi = 0; mi < 2; ++mi) {
                    const f32x16 acc = mi ? acc2 : acc0;
                    if (mat == 0) {
                        bf16_t* up = (bf16_t*)(ws + WS_PU) + ((((size_t)ug * 4 + nb) * 2 + mi) * 64 + lane_e) * 16;
                        u32x4 o0, o1;
#pragma unroll
                        for (int e = 0; e < 4; ++e) { o0[e] = cvtpk(acc[2 * e], acc[2 * e + 1]); o1[e] = cvtpk(acc[8 + 2 * e], acc[8 + 2 * e + 1]); }
                        *(u32x4*)up = o0; *(u32x4*)(up + 8) = o1;
                    } else {
                        bf16_t* wp = (bf16_t*)(ws + WS_PW) + (size_t)ug * 8192;
#pragma unroll
                        for (int reg = 0; reg < 16; ++reg) wp[(32 * mi + crow(reg, hh)) * 128 + 32 * nb + r32] = f2bf(acc[reg]);
                    }
                }
            }
            __syncthreads();
        }
    }
}

template <int PMODE> DI void p4_scan(const Params& p, LAS unsigned char* lds) {
    const int tid = otid(), lane = tid & 63, wave = __builtin_amdgcn_readfirstlane(tid >> 6);
    const int r32 = lane & 31, hh = lane >> 5;
    unsigned char* ws = p.ws;
    constexpr int ST = 59904, S_W = 0, S_QD = 16896, S_KDT = 33792, S_AT = 51200, L_OS = 2 * ST, OSB = 16896;
    static_assert(L_OS + 2 * OSB <= LDS_BYTES, "p4 lds");
    for (int bh = blockIdx.x; bh < 64; bh += gridDim.x) {
        const int b = bh >> 3, h = bh & 7;
        __syncthreads();
        if (wave >= 4) {
            const int lt_k = tid - 256;
            u32x4 rgA[14], rgB[14];
            auto issue = [&](u32x4 (&rg)[14], int n) {
                int lt = lt_k; asm volatile("" : "+v"(lt));
                const size_t ug = (size_t)bh * 64 + n;
                const bf16_t* pw = (const bf16_t*)(ws + WS_PW) + ug * 8192; const bf16_t* pq = (const bf16_t*)(ws + WS_PQD) + ug * 8192;
                const bf16_t* pk = (const bf16_t*)(ws + WS_PKDT) + ug * 8192; const bf16_t* pa = (const bf16_t*)(ws + WS_PAT) + ug * 4096;
#pragma unroll
                for (int k = 0; k < 4; ++k) { const int ci = lt + 256 * k; rg[k] = *(const u32x4*)(pw + ci * 8); rg[4 + k] = *(const u32x4*)(pq + ci * 8); rg[8 + k] = *(const u32x4*)(pk + ci * 8); }
#pragma unroll
                for (int k = 0; k < 2; ++k) { const int ci = lt + 256 * k; rg[12 + k] = *(const u32x4*)(pa + ci * 8); }
            };
            auto commit = [&](const u32x4 (&rg)[14], int st) {
                int lt = lt_k; asm volatile("" : "+v"(lt));
                LAS unsigned char* sb = lds + st * ST;
#pragma unroll
                for (int k = 0; k < 4; ++k) { const int ci = lt + 256 * k; const int row = ci >> 4, ch = ci & 15;
                    LAS u32x2* d0 = (LAS u32x2*)(sb + S_W + row * 264 + ch * 16); d0[0] = (u32x2){rg[k][0], rg[k][1]}; d0[1] = (u32x2){rg[k][2], rg[k][3]};
                    LAS u32x2* d1 = (LAS u32x2*)(sb + S_QD + row * 264 + ch * 16); d1[0] = (u32x2){rg[4 + k][0], rg[4 + k][1]}; d1[1] = (u32x2){rg[4 + k][2], rg[4 + k][3]};
                    const int row2 = ci >> 3, ch2 = ci & 7;
                    LAS u32x2* d2 = (LAS u32x2*)(sb + S_KDT + row2 * 136 + ch2 * 16); d2[0] = (u32x2){rg[8 + k][0], rg[8 + k][1]}; d2[1] = (u32x2){rg[8 + k][2], rg[8 + k][3]}; }
#pragma unroll
                for (int k = 0; k < 2; ++k) { const int ci = lt + 256 * k; const int row2 = ci >> 3, ch2 = ci & 7;
                    LAS u32x2* d3 = (LAS u32x2*)(sb + S_AT + row2 * 136 + ch2 * 16); d3[0] = (u32x2){rg[12 + k][0], rg[12 + k][1]}; d3[1] = (u32x2){rg[12 + k][2], rg[12 + k][3]}; }
            };
            auto ocopy = [&](int mstep) {
                int lt = lt_k; asm volatile("" : "+v"(lt));
                const int row = lt >> 2, part = lt & 3;
                const LAS unsigned char* ob = lds + L_OS + (mstep & 1) * OSB + row * 264 + part * 64;
                const size_t tok = (size_t)b * 4096 + mstep * 64 + row;
                bf16_t* yp = (bf16_t*)(ws + WS_RA) + tok * 1024 + h * 128 + part * 32;
#pragma unroll
                for (int e = 0; e < 4; ++e) { const u32x2 v0 = *(const LAS u32x2*)(ob + e * 16), v1 = *(const LAS u32x2*)(ob + e * 16 + 8); *(u32x4*)(yp + 8 * e) = (u32x4){v0[0], v0[1], v1[0], v1[1]}; }
            };
            issue(rgA, 0); commit(rgA, 0); issue(rgB, 1);
            __syncthreads();
            for (int n = 0; n <= 64; n += 2) {
                if (n + 2 < 64) issue(rgA, n + 2);
                if (PMODE == 0) { if (n >= 1) ocopy(n - 1); }
                if (n + 1 < 64) commit(rgB, (n + 1) & 1);
                __syncthreads();
                if (n + 1 <= 64) {
                    if (n + 3 < 64) issue(rgB, n + 3);
                    if (PMODE == 0) ocopy(n);
                    if (n + 2 < 64) commit(rgA, (n + 2) & 1);
                    __syncthreads();
                }
            }
        } else {
            const int sl = wave;
            f32x16 Sacc[4]; for (int kb = 0; kb < 4; ++kb) Sacc[kb] = zero16();
            u32x4 un[2][2]; float gln;
            auto uload = [&](int n) { const size_t ug = (size_t)bh * 64 + n;
                const bf16_t* up = (const bf16_t*)(ws + WS_PU) + (((ug * 4 + sl) * 2) * 64 + lane) * 16;
                un[0][0] = *(const u32x4*)up; un[0][1] = *(const u32x4*)(up + 8); un[1][0] = *(const u32x4*)(up + 1024); un[1][1] = *(const u32x4*)(up + 1032);
                gln = ((const float*)(ws + WS_GL))[ug]; };
            uload(0);
            __syncthreads();
            for (int n = 0; n <= 64; ++n) {
                if (n < 64 && PMODE != 1) {
                    const LAS unsigned char* sb = lds + (n & 1) * ST;
                    u32x4 uc[2][2]; uc[0][0] = un[0][0]; uc[0][1] = un[0][1]; uc[1][0] = un[1][0]; uc[1][1] = un[1][1]; const float gl = gln;
                    if (n + 1 < 64) uload(n + 1);
                    f32x16 vacc[2], qacc[2];
                    vacc[0] = zero16(); vacc[1] = zero16(); qacc[0] = zero16(); qacc[1] = zero16();
                    {
                        const LAS unsigned char* wrow = sb + S_W + r32 * 264 + hh * 8;
                        const LAS unsigned char* qrow = sb + S_QD + r32 * 264 + hh * 8;
#pragma unroll
                        for (int kb = 0; kb < 4; ++kb) {
                            bf16x8 fw[2][2], fq[2][2];
#pragma unroll
                            for (int s2 = 0; s2 < 2; ++s2)
#pragma unroll
                                for (int mi = 0; mi < 2; ++mi) { const int off = mi * 32 * 264 + (2 * kb + s2) * 32;
                                    fw[s2][mi] = lds2x64(wrow + off, wrow + off + 16); fq[s2][mi] = lds2x64(qrow + off, qrow + off + 16); }
                            const bf16x8 Sb0 = pack8(Sacc[kb], 0), Sb1 = pack8(Sacc[kb], 1);
                            __builtin_amdgcn_sched_barrier(0);
#pragma unroll
                            for (int mi = 0; mi < 2; ++mi) { vacc[mi] = MFMA32(fw[0][mi], Sb0, vacc[mi]); qacc[mi] = MFMA32(fq[0][mi], Sb0, qacc[mi]); }
#pragma unroll
                            for (int mi = 0; mi < 2; ++mi) { vacc[mi] = MFMA32(fw[1][mi], Sb1, vacc[mi]); qacc[mi] = MFMA32(fq[1][mi], Sb1, qacc[mi]); }
                        }
                    }
                    __builtin_amdgcn_sched_barrier(0);
                    bf16x8 Vb[4];
#pragma unroll
                    for (int mi = 0; mi < 2; ++mi) { f32x16 vn;
#pragma unroll
                        for (int e = 0; e < 4; ++e) { vn[2 * e] = bflo(uc[mi][0][e]) - vacc[mi][2 * e]; vn[2 * e + 1] = bfhi(uc[mi][0][e]) - vacc[mi][2 * e + 1];
                                                      vn[8 + 2 * e] = bflo(uc[mi][1][e]) - vacc[mi][8 + 2 * e]; vn[8 + 2 * e + 1] = bfhi(uc[mi][1][e]) - vacc[mi][8 + 2 * e + 1]; }
                        Vb[2 * mi] = pack8(vn, 0); Vb[2 * mi + 1] = pack8(vn, 1); }
                    {
                        bf16x8 fa[6];
                        const LAS unsigned char* arow = sb + S_AT + r32 * 136 + hh * 8;
                        fa[0] = lds2x64(arow, arow + 16); fa[1] = lds2x64(arow + 32, arow + 48);
#pragma unroll
                        for (int ks = 0; ks < 4; ++ks) fa[2 + ks] = lds2x64(arow + 32 * 136 + ks * 32, arow + 32 * 136 + ks * 32 + 16);
                        __builtin_amdgcn_sched_barrier(0);
                        qacc[0] = MFMA32(fa[0], Vb[0], qacc[0]); qacc[1] = MFMA32(fa[2], Vb[0], qacc[1]);
                        qacc[0] = MFMA32(fa[1], Vb[1], qacc[0]); qacc[1] = MFMA32(fa[3], Vb[1], qacc[1]);
                        qacc[1] = MFMA32(fa[4], Vb[2], qacc[1]); qacc[1] = MFMA32(fa[5], Vb[3], qacc[1]);
                    }
#pragma unroll
                    for (int kp = 0; kp < 2; ++kp) {
                        bf16x8 fk[2][4];
#pragma unroll
                        for (int k2 = 0; k2 < 2; ++k2)
#pragma unroll
                            for (int ks = 0; ks < 4; ++ks) { const LAS unsigned char* krow = sb + S_KDT + (32 * (2 * kp + k2) + r32) * 136 + hh * 8 + ks * 32; fk[k2][ks] = lds2x64(krow, krow + 16); }
                        f32x16 sn0 = Sacc[2 * kp] * gl, sn1 = Sacc[2 * kp + 1] * gl;
                        __builtin_amdgcn_sched_barrier(0);
#pragma unroll
                        for (int ks = 0; ks < 4; ++ks) { sn0 = MFMA32(fk[0][ks], Vb[ks], sn0); sn1 = MFMA32(fk[1][ks], Vb[ks], sn1); }
                        Sacc[2 * kp] = sn0; Sacc[2 * kp + 1] = sn1;
                    }
                    {
                        LAS bf16_t* ob = (LAS bf16_t*)(lds + L_OS + (n & 1) * OSB);
#pragma unroll
                        for (int mo = 0; mo < 2; ++mo)
#pragma unroll
                            for (int reg = 0; reg < 16; ++reg) ob[(32 * mo + crow(reg, hh)) * 132 + 32 * sl + r32] = f2bf(qacc[mo][reg]);
                    }
                }
                __syncthreads();
            }
        }
    }
}

DI void p4b_onorm(const Params& p) {
    const int tid = otid(), lane = tid & 63, wave = tid >> 6;
    bf16_t* ob = (bf16_t*)(p.ws + WS_RA);
    const bf16_t* zb = (const bf16_t*)p.out;
    const float* og = p.in[10] + (lane & 7) * 16;
    float g[16];
#pragma unroll
    for (int e = 0; e < 16; ++e) g[e] = og[e];
    const int stride = gridDim.x * 8;
    int m = blockIdx.x * 8 + wave;
    u32x4 no0, no1, nz0, nz1;
    auto ld = [&](int mm) { const bf16_t* op = ob + (size_t)mm * 1024 + lane * 16; const bf16_t* zp = zb + (size_t)mm * 1024 + lane * 16;
        no0 = *(const u32x4*)op; no1 = *(const u32x4*)(op + 8); nz0 = *(const u32x4*)zp; nz1 = *(const u32x4*)(zp + 8); };
    if (m < M) ld(m);
    for (; m < M; m += stride) {
        bf16_t* op = ob + (size_t)m * 1024 + lane * 16;
        const u32x4 o0 = no0, o1 = no1, z0 = nz0, z1 = nz1;
        if (m + stride < M) ld(m + stride);
        float ss = 0.f;
#pragma unroll
        for (int e = 0; e < 4; ++e) { const float a = bflo(o0[e]), b2 = bfhi(o0[e]), c = bflo(o1[e]), d = bfhi(o1[e]); ss += (a * a + b2 * b2) + (c * c + d * d); }
        ss += __shfl_xor(ss, 1); ss += __shfl_xor(ss, 2); ss += __shfl_xor(ss, 4);
        const float rstd = rsqrtf(ss * (1.f / 128.f) + EPS);
        u32x4 y0, y1;
#pragma unroll
        for (int e = 0; e < 4; ++e) {
            y0[e] = cvtpk(bflo(o0[e]) * rstd * g[2 * e] * siluf(bflo(z0[e])), bfhi(o0[e]) * rstd * g[2 * e + 1] * siluf(bfhi(z0[e])));
            y1[e] = cvtpk(bflo(o1[e]) * rstd * g[8 + 2 * e] * siluf(bflo(z1[e])), bfhi(o1[e]) * rstd * g[8 + 2 * e + 1] * siluf(bfhi(z1[e])));
        }
        *(u32x4*)op = y0; *(u32x4*)(op + 8) = y1;
    }
}

DI void p8_compress(const Params& p, LAS unsigned char* lds) {
    const int tid = otid(), lane = tid & 63, wave = __builtin_amdgcn_readfirstlane(tid >> 6);
    const int r32 = lane & 31, hh = lane >> 5;
    unsigned char* ws = p.ws;
    constexpr int L_AS = 0  , L_BS = 4608  , L_HS = L_BS + 36864  , L_C1 = L_HS + 16896  ;
    const bf16_t* kv = (const bf16_t*)(ws + WS_KV);
    for (int u = blockIdx.x; u < 256; u += gridDim.x) {
        const int which = u >> 7, bg = (u >> 3) & 15, nb = u & 7, b = bg >> 1, g = bg & 1;
        __syncthreads();
        if (tid < 256) { float a = 0.f; for (int kc = 0; kc < 16; ++kc) a += ((const float*)(ws + WS_C1P))[(kc * 2 + which) * 256 + tid]; ((LAS float*)(lds + L_C1))[tid] = a; }
        const bf16_t* w1t = (const bf16_t*)(ws + WS_W1T) + (size_t)which * 256 * 2048;
        f32x16 acc = zero16();
        for (int l = 0; l < 32; ++l) {
            __syncthreads();
            if (tid < 256) { const int row = tid >> 3, ch = tid & 7; int tk = 16 * (32 * nb + row) + l; tk = tk > 4095 ? 4095 : tk;
                *(LAS u32x4*)(lds + L_AS + row * 144 + ch * 16) = *(const u32x4*)(kv + ((size_t)b * 4096 + tk) * 768 + which * 128 + g * 64 + ch * 8); }
#pragma unroll
            for (int k = 0; k < 4; ++k) { const int ci = tid + 512 * k; const int row = ci >> 3, ch = ci & 7;
                *(LAS u32x4*)(lds + L_BS + row * 144 + ch * 16) = *(const u32x4*)(w1t + (size_t)row * 2048 + l * 64 + ch * 8); }
            __syncthreads();
            const LAS unsigned char* ab = lds + L_AS + r32 * 144 + hh * 16;
            const LAS unsigned char* bb = lds + L_BS + (32 * wave + r32) * 144 + hh * 16;
#pragma unroll
            for (int ks = 0; ks < 4; ++ks) acc = MFMA32(lds128(ab + ks * 32), lds128(bb + ks * 32), acc);
        }
        {
            const float c1 = ((LAS float*)(lds + L_C1))[32 * wave + r32];
#pragma unroll
            for (int reg = 0; reg < 16; ++reg) *(LAS bf16_t*)(lds + L_HS + crow(reg, hh) * 528 + (32 * wave + r32) * 2) = f2bf(siluf(acc[reg] + c1));
        }
        __syncthreads();
        if (wave < 2) {
            const bf16_t* w2t = (const bf16_t*)(ws + WS_W2T) + (size_t)(which * 64 + 32 * wave + r32) * 256 + hh * 8;
            const LAS unsigned char* ab = lds + L_HS + r32 * 528 + hh * 16;
            f32x16 o = zero16();
#pragma unroll
            for (int ks = 0; ks < 16; ++ks) o = MFMA32(lds128(ab + ks * 32), *(const bf16x8*)(w2t + ks * 16), o);
            bf16_t* dst = (bf16_t*)(ws + WS_CMP) + (size_t)(which * 16 + bg) * 256 * 64;
#pragma unroll
            for (int reg = 0; reg < 16; ++reg) { const int n = 32 * nb + crow(reg, hh); const bf16_t val = (n < 255) ? f2bf(o[reg]) : (bf16_t)0;
                if (which == 0) dst[n * 64 + 32 * wave + r32] = val; else dst[(32 * wave + r32) * 256 + n] = val; }
        }
    }
}

__device__ const unsigned char T5_BUCKET[128] = {0, 1, 2, 3, 4, 5, 6, 7, 8, 9, 10, 11, 12, 13, 14, 15, 16, 16, 16, 17, 17, 18, 18, 18, 19, 19, 19, 20, 20, 20, 20, 21, 21, 21, 21, 22, 22, 22, 22, 22, 23, 23, 23, 23, 23, 23, 24, 24, 24, 24, 24, 24, 25, 25, 25, 25, 25, 25, 25, 26, 26, 26, 26, 26, 26, 26, 26, 27, 27, 27, 27, 27, 27, 27, 27, 27, 27, 28, 28, 28, 28, 28, 28, 28, 28, 28, 28, 29, 29, 29, 29, 29, 29, 29, 29, 29, 29, 29, 29, 30, 30, 30, 30, 30, 30, 30, 30, 30, 30, 30, 30, 30, 30, 31, 31, 31, 31, 31, 31, 31, 31, 31, 31, 31, 31, 31, 31, 31};
constexpr float NEGBIG = -1e30f;

template <int PMODE> DI void p9_nsa(const Params& p, LAS unsigned char* lds) {
    const int tid0 = otid(); const int lane_k = tid0 & 63, wave = __builtin_amdgcn_readfirstlane(tid0 >> 6);
    unsigned char* ws = p.ws;
    constexpr int STG = 17920, L_K = 0, L_V = 9216, L_BT = 2 * STG, L_IA = L_BT + 4224, L_IB = L_IA + 8192, L_Y = L_IB + 8704;
    static_assert(L_Y + 65536 <= LDS_BYTES, "p9 lds");
    constexpr float LOG2E = 1.4426950408889634f;
    LAS float* YL = (LAS float*)(lds + L_Y) + wave * 2048;
    LAS float* BT = (LAS float*)(lds + L_BT);
    LAS float* IA = (LAS float*)(lds + L_IA) + wave * 256;
    LAS float* IB = (LAS float*)(lds + L_IB) + wave * 272;
    const bf16_t* kvb = (const bf16_t*)(ws + WS_KV);
    const bf16_t* cmpb = (const bf16_t*)(ws + WS_CMP);
    const bf16_t* vtb = (const bf16_t*)(ws + WS_VT);
    const bf16_t* projb = (const bf16_t*)(ws + WS_PROJB);
    const float* gates = (const float*)(ws + WS_GATES);
    const float* relb = p.in[2];
    for (int vc0 = blockIdx.x; vc0 < 256; vc0 += gridDim.x) {
        const int vc = (gridDim.x == 256) ? ((vc0 & 7) * 32 + (vc0 >> 3)) : vc0;
        const int bg = vc >> 4, kk16 = vc & 15, b = bg >> 1, g = bg & 1;
        __syncthreads();
        for (int idx = otid(); idx < 1040; idx += 512) { const int hd_ = idx / 130, e = idx - hd_ * 130;
            BT[idx] = (e == 0) ? NEGBIG : relb[(e == 129 ? 31 : (int)T5_BUCKET[e - 1]) * 16 + g * 8 + hd_] * LOG2E; }
        for (int ju = 0; ju < 8; ++ju) {
            int lane = lane_k; asm volatile("" : "+v"(lane));
            const int tid = wave * 64 + lane, r32 = lane & 31, hh = lane >> 5, tok = r32 >> 3, hd = r32 & 7;
            const int srow = tid >> 3, sch = tid & 7;
            const int ub = (ju & 1) ? (32 * (ju >> 1) + 31 - kk16) : (32 * (ju >> 1) + kk16);
            const int t0 = 32 * ub, cur = ub >> 1;
            const int tq = t0 + 4 * wave + tok, head = g * 8 + hd;
            const int tqw = t0 + 4 * wave;
            const size_t trow = (size_t)b * 4096 + tq;
            __syncthreads();
            for (int idx = lane; idx < 256; idx += 64) IA[idx] = 0.f;
            for (int idx = lane; idx < 272; idx += 64) IB[idx] = 0.f;
            const float bfar = relb[31 * 16 + head] * LOG2E;
            bf16x8 Qf[4];
#pragma unroll
            for (int ks = 0; ks < 4; ++ks) Qf[ks] = *(const bf16x8*)(projb + trow * 4096 + head * 64 + 16 * ks + 8 * hh);
            const int nct = (ub >> 5) + 1;
            const int wlo = (t0 - 511) > 0 ? ((t0 - 511) >> 6) : 0;
            const int nwin = cur - wlo + 1;
            const int NT = 2 * nct + (cur + 1) + nwin;
            u32x4 kregA, vregA, kregB, vregB;
            auto tload = [&](u32x4& kreg, u32x4& vreg, int i) {
                const bf16_t *kp, *vp; int kstride, vstride;
                if (i < 2 * nct) { const int ti = i < nct ? i : i - nct; kp = cmpb + ((size_t)(0 * 16 + bg) * 256 + 64 * ti) * 64; kstride = 64; vp = cmpb + (size_t)(1 * 16 + bg) * 256 * 64 + 64 * ti; vstride = 256; }
                else if (i < 2 * nct + cur + 1) { const int s_ = i - 2 * nct; kp = kvb + ((size_t)b * 4096 + 64 * s_) * 768 + 256 + g * 64; kstride = 768; vp = vtb + (size_t)((0 * 8 + b) * 2 + g) * 64 * 4096 + 64 * s_; vstride = 4096; }
                else { const int blk = cur - (i - 2 * nct - cur - 1); kp = kvb + ((size_t)b * 4096 + 64 * blk) * 768 + 512 + g * 64; kstride = 768; vp = vtb + (size_t)((1 * 8 + b) * 2 + g) * 64 * 4096 + 64 * blk; vstride = 4096; }
                kreg = *(const u32x4*)(kp + (size_t)srow * kstride + sch * 8); vreg = *(const u32x4*)(vp + (size_t)srow * vstride + sch * 8);
            };
            auto twrite = [&](const u32x4& kreg, const u32x4& vreg, int st) {
                *(LAS u32x4*)(lds + st * STG + L_K + srow * 144 + sch * 16) = kreg;
                LAS u32x2* vd = (LAS u32x2*)(lds + st * STG + L_V + srow * 136 + sch * 16);
                vd[0] = (u32x2){vreg[0], vreg[1]}; vd[1] = (u32x2){vreg[2], vreg[3]};
            };
            tload(kregA, vregA, 0); twrite(kregA, vregA, 0);
            if (NT > 1) tload(kregB, vregB, 1);
            __syncthreads();
            float m_run = NEGBIG, l_run = 0.f, m_c = NEGBIG, linv_c = 0.f;
            f32x16 O[2]; O[0] = zero16(); O[1] = zero16();
            unsigned long long mymask = 0ull, wmask = 0ull;
            u32x2 zpre[8]; float gpre;
            auto zfetch = [&](int br) {
                int l2 = lane; asm volatile("" : "+v"(l2)); const int hh2 = l2 >> 5;
                gpre = gates[trow * 48 + br * 16 + head];
                const bf16_t* zp = projb + trow * 4096 + 1024 + br * 1024 + head * 64;
#pragma unroll
                for (int db = 0; db < 2; ++db)
#pragma unroll
                    for (int gi = 0; gi < 4; ++gi) zpre[db * 4 + gi] = *(const u32x2*)(zp + 32 * db + 8 * gi + 4 * hh2);
            };
            zfetch(0);
            auto finalize = [&](int br, bool normalized) {
                float inv = 1.f;
                if (!normalized) { const float L = l_run + __shfl_xor(l_run, 32); inv = 1.f / fmaxf(L, 1e-30f); }
                const float gt = gpre * inv;
#pragma unroll
                for (int db = 0; db < 2; ++db)
#pragma unroll
                    for (int gi = 0; gi < 4; ++gi) { const u32x2 zv = zpre[db * 4 + gi];
                        LAS float* yl = YL + (db * 16 + 4 * gi) * 64 + lane;
                        const float c0 = gt * O[db][4 * gi + 0] * siluf(bflo(zv[0])), c1 = gt * O[db][4 * gi + 1] * siluf(bfhi(zv[0]));
                        const float c2 = gt * O[db][4 * gi + 2] * siluf(bflo(zv[1])), c3 = gt * O[db][4 * gi + 3] * siluf(bfhi(zv[1]));
                        if (br == 0) { yl[0] = c0; yl[64] = c1; yl[128] = c2; yl[192] = c3; }
                        else { yl[0] += c0; yl[64] += c1; yl[128] += c2; yl[192] += c3; } }
                O[0] = zero16(); O[1] = zero16(); m_run = NEGBIG; l_run = 0.f;
                if (br < 2) zfetch(br + 1);
            };
            auto tile_body_p = [&](auto KT, auto MD, auto PAR, const int i, const int tix) {
                constexpr int kind = decltype(KT)::value; constexpr int mode = decltype(MD)::value; constexpr int par = decltype(PAR)::value;
                if (i + 2 < NT) { if constexpr (par) tload(kregB, vregB, i + 2); else tload(kregA, vregA, i + 2); }
                const LAS unsigned char* sb = lds + (i & 1) * STG;
                const bool skip = ((kind == 2) && (((wmask >> tix) & 1ull) == 0ull)) || PMODE == 1;
                if (!skip) {
                    bf16x8 kf[8];
#pragma unroll
                    for (int kb = 0; kb < 2; ++kb)
#pragma unroll
                        for (int ks = 0; ks < 4; ++ks) kf[kb * 4 + ks] = lds128(sb + L_K + (32 * kb + r32) * 144 + hh * 16 + ks * 32);
                    __builtin_amdgcn_sched_barrier(0);
                    f32x16 st[2];
#pragma unroll
                    for (int kb = 0; kb < 2; ++kb) { st[kb] = zero16();
#pragma unroll
                        for (int ks = 0; ks < 4; ++ks) st[kb] = MFMA32(kf[kb * 4 + ks], Qf[ks], st[kb]); }
                    bf16x8 vf[8];
                    if constexpr (kind != 0) {
#pragma unroll
                        for (int db = 0; db < 2; ++db)
#pragma unroll
                            for (int ks = 0; ks < 4; ++ks) { const LAS unsigned char* vr = sb + L_V + (32 * db + r32) * 136 + hh * 8 + ks * 32; vf[db * 4 + ks] = lds2x64(vr, vr + 16); }
                    }
                    __builtin_amdgcn_sched_barrier(0);
                    const bool selected = (kind != 2) || (((mymask >> tix) & 1ull) != 0ull);
                    float mx = NEGBIG;
                    if constexpr (mode == 1) {
                        int dbase = (kind <= 1) ? (tq - 30 - 1024 * tix - 64 * hh) : (tq + 1 - 64 * tix - 4 * hh);
                        asm volatile("" : "+v"(dbase));
                        constexpr int dmul = (kind <= 1) ? 16 : 1;
                        const LAS float* btl = BT + hd * 130;
                        float man[4] = {NEGBIG, NEGBIG, NEGBIG, NEGBIG};
#pragma unroll
                        for (int kb = 0; kb < 2; ++kb)
#pragma unroll
                            for (int reg = 0; reg < 16; ++reg) {
                                const int dr_ = dbase - dmul * (32 * kb + (reg & 3) + 8 * (reg >> 2)); const int di = dr_ < 0 ? 0 : (dr_ > 129 ? 129 : dr_);
                                const float sv = st[kb][reg] + btl[di];
                                st[kb][reg] = sv; man[reg & 3] = fmaxf(man[reg & 3], sv);
                            }
                        mx = fmaxf(fmaxf(man[0], man[1]), fmaxf(man[2], man[3]));
                        if (!selected) mx = NEGBIG;
                    } else if constexpr (mode == 2) {
                        int dbase = tq - 64 * tix - 4 * hh; asm volatile("" : "+v"(dbase));
#pragma unroll
                        for (int kb = 0; kb < 2; ++kb)
#pragma unroll
                            for (int reg = 0; reg < 16; ++reg) {
                                const int dist = dbase - (32 * kb + (reg & 3) + 8 * (reg >> 2));
                                const float sv = dist < 512 ? st[kb][reg] + bfar : NEGBIG;
                                st[kb][reg] = sv; mx = fmaxf(mx, sv);
                            }
                    } else {
                        float ma[4] = {NEGBIG, NEGBIG, NEGBIG, NEGBIG};
#pragma unroll
                        for (int kb = 0; kb < 2; ++kb)
#pragma unroll
                            for (int reg = 0; reg < 16; ++reg) ma[reg & 3] = fmaxf(ma[reg & 3], st[kb][reg]);
                        mx = fmaxf(fmaxf(ma[0], ma[1]), fmaxf(ma[2], ma[3]));
                        mx = selected ? mx + bfar : NEGBIG;
                    }
                    if constexpr (kind != 1) {
                        mx = fmaxf(mx, __shfl_xor(mx, 32));
                        const float mnew = fmaxf(m_run, mx);
                        const float alpha = __builtin_amdgcn_exp2f(m_run - mnew);
                        const float msub = selected ? (mode == 0 ? mnew - bfar : mnew) : 1e30f;
                        float ls;
                        {
                            const f32x2 ms2 = {msub, msub}; f32x2 acc2[4] = {{0.f, 0.f}, {0.f, 0.f}, {0.f, 0.f}, {0.f, 0.f}};
#pragma unroll
                            for (int kb = 0; kb < 2; ++kb)
#pragma unroll
                                for (int r2 = 0; r2 < 8; ++r2) { f32x2 v = {st[kb][2 * r2], st[kb][2 * r2 + 1]}; v = v - ms2;
                                    v[0] = __builtin_amdgcn_exp2f(v[0]); v[1] = __builtin_amdgcn_exp2f(v[1]); acc2[r2 & 3] = acc2[r2 & 3] + v; st[kb][2 * r2] = v[0]; st[kb][2 * r2 + 1] = v[1]; }
                            const f32x2 t2 = (acc2[0] + acc2[1]) + (acc2[2] + acc2[3]);
                            ls = t2[0] + t2[1];
                        }
                        l_run = l_run * alpha + ls; m_run = mnew;
                        if constexpr (kind != 0) { if (__ballot(alpha != 1.f) != 0ull) { O[0] = O[0] * alpha; O[1] = O[1] * alpha; } }
                    } else {
#pragma unroll
                        for (int kb = 0; kb < 2; ++kb) {
#pragma unroll
                            for (int reg = 0; reg < 16; ++reg) st[kb][reg] = __builtin_amdgcn_exp2f(st[kb][reg] - m_c) * linv_c;
#pragma unroll
                            for (int gi = 0; gi < 4; ++gi) {
                                float a = 2.f * (st[kb][4 * gi] + st[kb][4 * gi + 1] + st[kb][4 * gi + 2]) + st[kb][4 * gi + 3], bq = st[kb][4 * gi + 3];
                                a += __shfl_xor(a, 1); a += __shfl_xor(a, 2); a += __shfl_xor(a, 4);
                                bq += __shfl_xor(bq, 1); bq += __shfl_xor(bq, 2); bq += __shfl_xor(bq, 4);
                                const int sidx = 16 * tix + 8 * kb + 2 * gi + hh;
                                if (hd == 0) { IA[tok * 64 + sidx] = a; IB[tok * 68 + sidx + 1] = bq; }
                            }
                        }
                    }
                    if constexpr (kind != 0 && PMODE != 2) {
                        bf16x8 Pf[4];
#pragma unroll
                        for (int kb = 0; kb < 2; ++kb) { Pf[2 * kb] = pack8(st[kb], 0); Pf[2 * kb + 1] = pack8(st[kb], 1); }
                        __builtin_amdgcn_sched_barrier(0);
#pragma unroll
                        for (int ks = 0; ks < 4; ++ks)
#pragma unroll
                            for (int db = 0; db < 2; ++db) O[db] = MFMA32(vf[db * 4 + ks], Pf[ks], O[db]);
                    }
                }
                __builtin_amdgcn_sched_barrier(0);
                if (i + 1 < NT) { if constexpr (par) twrite(kregA, vregA, (i + 1) & 1); else twrite(kregB, vregB, (i + 1) & 1); }
                __syncthreads();
            };
            auto tile_body = [&](auto KT, auto MD, const int i, const int tix) {
                if (i & 1) tile_body_p(KT, MD, std::integral_constant<int, 1>{}, i, tix); else tile_body_p(KT, MD, std::integral_constant<int, 0>{}, i, tix);
            };
            using IC0 = std::integral_constant<int, 0>; using IC1 = std::integral_constant<int, 1>; using IC2 = std::integral_constant<int, 2>; using IC3 = std::integral_constant<int, 3>;
            int ti = 0;
#pragma unroll 1
            for (int t = 0; t < nct; ++t, ++ti) tile_body(IC0{}, IC1{}, ti, t);
            { const float L = l_run + __shfl_xor(l_run, 32); m_c = m_run; linv_c = (tq >= 31) ? 1.f / fmaxf(L, 1e-30f) : 0.f; m_run = NEGBIG; l_run = 0.f; }
#pragma unroll 1
            for (int t = 0; t < nct; ++t, ++ti) tile_body(IC1{}, IC1{}, ti, t);
            finalize(0, true);
            {
                wmask = 0ull; mymask = 0ull;
#pragma unroll 1
                for (int tk = 0; tk < 4; ++tk) {
                    float v = IA[tk * 64 + lane] + IB[tk * 68 + lane];
                    if (lane == 0 || lane == cur || lane == cur - 1) v = 1e9f; else if (lane > cur) v = -1e9f;
                    int rank = 0;
#pragma unroll
                    for (int j = 0; j < 64; ++j) { const float vj = __builtin_bit_cast(float, __builtin_amdgcn_readlane(__builtin_bit_cast(int, v), j)); rank += ((vj > v) || (vj == v && j < lane)) ? 1 : 0; }
                    const unsigned long long mk = __ballot(rank < 16);
                    wmask |= mk; if (tok == tk) mymask = mk;
                }
            }
            const int nfar_s = (tqw - 176 >= 0) ? ((tqw - 176) >> 6) + 1 : 0;
#pragma unroll 1
            for (int t = 0; t <= cur; ++t, ++ti) { if (t < nfar_s) tile_body(IC2{}, IC0{}, ti, t); else tile_body(IC2{}, IC1{}, ti, t); }
            finalize(1, false);
#pragma unroll 1
            for (int t = 0; t < nwin; ++t, ++ti) { const int blk = cur - t;
                const bool oldw = (tqw + 3 - 64 * blk > 511), nearw = (tqw - 64 * blk - 63 < 113);
                if (oldw) tile_body(IC3{}, IC2{}, ti, blk); else if (nearw) tile_body(IC3{}, IC1{}, ti, blk); else tile_body(IC3{}, IC0{}, ti, blk); }
            finalize(2, false);
            if (PMODE != 0) continue;
            bf16_t* yp = (bf16_t*)(ws + WS_RA) + trow * 1024 + head * 64;
#pragma unroll
            for (int db = 0; db < 2; ++db)
#pragma unroll
                for (int gi = 0; gi < 4; ++gi) { const LAS float* yl = YL + (db * 16 + 4 * gi) * 64 + lane; u32x2 o; o.x = cvtpk(yl[0], yl[64]); o.y = cvtpk(yl[128], yl[192]);
                    *(u32x2*)(yp + 32 * db + 8 * gi + 4 * hh) = o; }
        }
    }
}

DI void p11_final(const Params& p) {
    const int tid = otid(), lane = tid & 63, wave = tid >> 6;
    const float* ssq = (const float*)(p.ws + WS_SSQ);
    f32x4 g4[4];
#pragma unroll
    for (int j = 0; j < 4; ++j) g4[j] = *((const f32x4*)p.in[22] + lane + 64 * j);
    const int stride = gridDim.x * 8;
    int m = blockIdx.x * 8 + wave;
    f32x4 vn[4]; float sn = 0.f;
    auto ld = [&](int mm) { f32x4* xr = (f32x4*)(p.out + (size_t)mm * 1024) + lane;
#pragma unroll
        for (int j = 0; j < 4; ++j) vn[j] = xr[64 * j];
        sn = (lane < 16) ? ssq[(size_t)lane * M + mm] : 0.f; };
    if (m < M) ld(m);
    for (; m < M; m += stride) {
        f32x4 v[4]; for (int j = 0; j < 4; ++j) v[j] = vn[j]; float s = sn;
        if (m + stride < M) ld(m + stride);
        s += __shfl_xor(s, 1); s += __shfl_xor(s, 2); s += __shfl_xor(s, 4); s += __shfl_xor(s, 8);
        s = __shfl(s, 0);
        const float rstd = rsqrtf(s * (1.f / 1024.f) + EPS);
        f32x4* xr = (f32x4*)(p.out + (size_t)m * 1024) + lane;
#pragma unroll
        for (int j = 0; j < 4; ++j) xr[64 * j] = v[j] * rstd * g4[j];
    }
}

template <int PH> DI void run_phase(const Params& p, LAS unsigned char* lds) {
    unsigned char* ws = p.ws;
    const int G = gridDim.x;
    bf16_t* h0 = (bf16_t*)((unsigned char*)p.out + 64 * MiB);
    if constexpr (PH == 0) p0_prologue<0>(p, lds, 0, (int)gridDim.x);
    if constexpr (PH == 1) norm_rows<0>(p, lds);
    if constexpr (PH == 2 || PH == 4) {
        constexpr int half = (PH - 2) / 2;
        pg8::Gemm g{h0, h0 + (size_t)half * 16384 * 1024, 0, (const bf16_t*)(ws + WS_WA), 16384, 4096, 1024}; pg8::StaticOrder S; S.init(16384, 4096, G, (int)blockIdx.x);
        EpiA E{(bf16_t*)(ws + WS_RA), (bf16_t*)p.out, half * 16384};
        pg8::gemm_phase<EpiA, true>(lds, g, S, E);
    }
    if constexpr (PH == 3 || PH == 5) p3_prep(p, lds, (PH - 3) / 2);
    if constexpr (PH == 6) { if (gridDim.x > 64) p0_prologue<1>(p, lds, 64, (int)gridDim.x - 64); else p0_prologue<1>(p, lds, 0, (int)gridDim.x); p4_scan<0>(p, lds); }
    if constexpr (PH == 14) p4b_onorm(p);
    if constexpr (PH == 100) p4_scan<1>(p, lds);
    if constexpr (PH == 101) p4_scan<2>(p, lds);
    if constexpr (PH == 7) {
        const bf16_t* ya = (const bf16_t*)(ws + WS_RA);
        pg8::Gemm g{ya, ya, 0, (const bf16_t*)(ws + WS_WAO), M, 1024, 1024}; pg8::StaticOrder S; S.init(M, 1024, G, (int)blockIdx.x);
        EpiRes<false> E{p.in[0], p.out, (const float*)(ws + WS_MOD), nullptr};
        pg8::gemm_phase<EpiRes<false>, true>(lds, g, S, E);
    }
    if constexpr (PH == 8) norm_rows<1>(p, lds);
    if constexpr (PH == 9) {
        pg8::Gemm g{(const bf16_t*)(ws + WS_S), (const bf16_t*)(ws + WS_RA), 3, (const bf16_t*)(ws + WS_WCAT), M, 5120, 1024}; pg8::StaticOrder S; S.init(M, 5120, G, (int)blockIdx.x);
        EpiB E{(bf16_t*)(ws + WS_KV), (bf16_t*)(ws + WS_PROJB), (float*)(ws + WS_GATES), (bf16_t*)(ws + WS_VT)};
        pg8::gemm_phase<EpiB, true>(lds, g, S, E);
    }
    if constexpr (PH == 10) p8_compress(p, lds);
    if constexpr (PH == 11) p9_nsa<0>(p, lds);
    if constexpr (PH == 110) p9_nsa<1>(p, lds);
    if constexpr (PH == 111) p9_nsa<2>(p, lds);
    if constexpr (PH == 12) {
        const bf16_t* yb = (const bf16_t*)(ws + WS_RA);
        pg8::Gemm g{yb, yb, 0, (const bf16_t*)(ws + WS_WBO), M, 1024, 1024}; pg8::StaticOrder S; S.init(M, 1024, G, (int)blockIdx.x);
        EpiRes<true> E{p.out, p.out, (const float*)(ws + WS_MOD) + 8 * 3072, (float*)(ws + WS_SSQ)};
        pg8::gemm_phase<EpiRes<true>, true>(lds, g, S, E);
    }
    if constexpr (PH == 13) p11_final(p);
}
#if MK_ONE_LAUNCH
__global__ void __launch_bounds__(512, 2) fwd_kernel(Params p) {
    extern __shared__ __attribute__((aligned(16))) unsigned char lds_raw[];
    LAS unsigned char* lds = (LAS unsigned char*)lds_raw;
    volatile LAS unsigned* misc = (volatile LAS unsigned*)(lds + LDS_BYTES - 64);
    if (threadIdx.x < 16) misc[threadIdx.x] = 0u;
    __syncthreads();
    XcdBarrier bar = xcd_barrier_post((unsigned*)(p.ws + WS_CTL) + 1024, misc);
    run_phase<0>(p, lds); xcd_barrier(bar); if (DUP_MASK & (1 << 0)) { run_phase<0>(p, lds); xcd_barrier(bar); }
    run_phase<1>(p, lds); xcd_barrier(bar); if (DUP_MASK & (1 << 1)) { run_phase<1>(p, lds); xcd_barrier(bar); }
    run_phase<2>(p, lds); xcd_barrier(bar); if (DUP_MASK & (1 << 2)) { run_phase<2>(p, lds); xcd_barrier(bar); }
    run_phase<3>(p, lds); xcd_barrier(bar); if (DUP_MASK & (1 << 3)) { run_phase<3>(p, lds); xcd_barrier(bar); }
    run_phase<4>(p, lds); xcd_barrier(bar); if (DUP_MASK & (1 << 4)) { run_phase<4>(p, lds); xcd_barrier(bar); }
    run_phase<5>(p, lds); xcd_barrier(bar); if (DUP_MASK & (1 << 5)) { run_phase<5>(p, lds); xcd_barrier(bar); }
    run_phase<6>(p, lds); xcd_barrier(bar); if (DUP_MASK & (1 << 6)) { run_phase<6>(p, lds); xcd_barrier(bar); }
#if defined(PROBE_SCAN)
    run_phase<PROBE_SCAN>(p, lds); xcd_barrier(bar);
#endif
    run_phase<14>(p, lds); xcd_barrier(bar);
    run_phase<7>(p, lds); xcd_barrier(bar); if (DUP_MASK & (1 << 7)) { run_phase<7>(p, lds); xcd_barrier(bar); }
    run_phase<8>(p, lds); xcd_barrier(bar); if (DUP_MASK & (1 << 8)) { run_phase<8>(p, lds); xcd_barrier(bar); }
    run_phase<9>(p, lds); xcd_barrier(bar); if (DUP_MASK & (1 << 9)) { run_phase<9>(p, lds); xcd_barrier(bar); }
    run_phase<10>(p, lds); xcd_barrier(bar); if (DUP_MASK & (1 << 10)) { run_phase<10>(p, lds); xcd_barrier(bar); }
    run_phase<11>(p, lds); xcd_barrier(bar); if (DUP_MASK & (1 << 11)) { run_phase<11>(p, lds); xcd_barrier(bar); }
#if defined(PROBE_NSA)
    run_phase<PROBE_NSA>(p, lds); xcd_barrier(bar);
#endif
    run_phase<12>(p, lds); xcd_barrier(bar); if (DUP_MASK & (1 << 12)) { run_phase<12>(p, lds); xcd_barrier(bar); }
    run_phase<13>(p, lds);
}
#else
template <int PH> __global__ void __launch_bounds__(512, 2) phase_kernel(Params p) {
    extern __shared__ __attribute__((aligned(16))) unsigned char lds_raw[];
    run_phase<PH>(p, (LAS unsigned char*)lds_raw);
}
template <int PH> static void launch_phase(const Params& a, int grid, hipStream_t stream) {
    static bool attr = false;
    if (!attr) { (void)hipFuncSetAttribute((const void*)phase_kernel<PH>, hipFuncAttributeMaxDynamicSharedMemorySize, LDS_BYTES); attr = true; }
    hipLaunchKernelGGL(phase_kernel<PH>, dim3(grid), dim3(512), LDS_BYTES, stream, a);
}
#endif

extern "C" void kernel_launch(void* const* d_in, const int* in_sizes, int n_in, void* d_out, int out_size, void* d_ws, size_t ws_size, hipStream_t stream) {
    static int grid = 0;
    if (grid == 0) {
        if (n_in != 23 || out_size != M * D || ws_size < WS_END) { fprintf(stderr, "kernel_launch: unexpected shapes (n_in %d out %d ws %zu)\n", n_in, out_size, ws_size); grid = -1; return; }
        int dev = 0, cus = 0;
        if (hipGetDevice(&dev) != hipSuccess || hipDeviceGetAttribute(&cus, hipDeviceAttributeMultiprocessorCount, dev) != hipSuccess) { grid = -1; return; }
#if MK_ONE_LAUNCH
        if (hipFuncSetAttribute((const void*)fwd_kernel, hipFuncAttributeMaxDynamicSharedMemorySize, LDS_BYTES) != hipSuccess) { fprintf(stderr, "kernel_launch: hipFuncSetAttribute failed\n"); grid = -1; return; }
        int per_cu = 0;
        if (hipOccupancyMaxActiveBlocksPerMultiprocessor(&per_cu, (const void*)fwd_kernel, 512, LDS_BYTES) != hipSuccess || per_cu < 1) fprintf(stderr, "kernel_launch: occupancy query says %d\n", per_cu);
        (void)hipGetLastError();
#endif
        grid = cus;
    }
    if (grid < 0) return;
    Params a{};
    for (int i = 0; i < 23; ++i) a.in[i] = (const float*)d_in[i];
    a.out = (float*)d_out; a.ws = (unsigned char*)d_ws;
    a.ph_lo = 0; a.ph_hi = NPH;
#if MK_ONE_LAUNCH
    hipMemsetAsync((char*)d_ws + WS_CTL, 0, 65536, stream);
    hipLaunchKernelGGL(fwd_kernel, dim3(grid), dim3(512), LDS_BYTES, stream, a);
#else
    launch_phase<0>(a, grid, stream); launch_phase<1>(a, grid, stream); launch_phase<2>(a, grid, stream); launch_phase<3>(a, grid, stream);
    launch_phase<4>(a, grid, stream); launch_phase<5>(a, grid, stream); launch_phase<6>(a, grid, stream); launch_phase<14>(a, grid, stream); launch_phase<7>(a, grid, stream);
    launch_phase<8>(a, grid, stream); launch_phase<9>(a, grid, stream); launch_phase<10>(a, grid, stream); launch_phase<11>(a, grid, stream);
    launch_phase<12>(a, grid, stream); launch_phase<13>(a, grid, stream);
#endif
}
```

```cpp
#include <hip/hip_runtime.h>
#include <cstdio>
#include <cstdint>
#include <type_traits>

#define DI __device__ __forceinline__
#define LAS __attribute__((address_space(3)))
typedef unsigned short bf16_t;
typedef short bf16x8 __attribute__((ext_vector_type(8)));
typedef short s16x4 __attribute__((ext_vector_type(4)));
typedef float f32x4 __attribute__((ext_vector_type(4)));
typedef float f32x2 __attribute__((ext_vector_type(2)));
typedef float f32x16 __attribute__((ext_vector_type(16)));
typedef unsigned u32x4 __attribute__((ext_vector_type(4)));
typedef unsigned u32x2 __attribute__((ext_vector_type(2)));
typedef __bf16 bf16x2_t __attribute__((ext_vector_type(2)));

#ifndef DUP_MASK
#define DUP_MASK 0
#endif
#ifndef MK_ONE_LAUNCH
#define MK_ONE_LAUNCH 1
#endif

constexpr int NB = 8, T = 4096, D = 1024, M = NB * T;
constexpr int A_LD = 4112, B_LD = 4144;
constexpr float EPS = 1e-6f;
constexpr int NPH = 14;

constexpr size_t MiB = 1u << 20;
constexpr size_t WS_CTL = 0;
constexpr size_t WS_MODP = 1 * MiB;
constexpr size_t WS_WA = 4 * MiB;
constexpr size_t WS_WAO = 12 * MiB;
constexpr size_t WS_C1P = 14 * MiB;
constexpr size_t WS_MOD = 14 * MiB + 65536;
constexpr size_t WS_SSQ = 15 * MiB;
constexpr size_t WS_BG = 17 * MiB;
constexpr size_t WS_GL = 19 * MiB;
constexpr size_t WS_RA = 20 * MiB;
constexpr size_t WS_RP = 212 * MiB;
constexpr size_t WS_PW = WS_RP;
constexpr size_t WS_PQD = WS_RP + 64 * MiB;
constexpr size_t WS_PKDT = WS_RP + 128 * MiB;
constexpr size_t WS_PU = WS_RP + 192 * MiB;
constexpr size_t WS_PAT = WS_RP + 256 * MiB;
constexpr size_t WS_VT = 84 * MiB;
constexpr size_t WS_KV = 100 * MiB;
constexpr size_t WS_WCAT = 148 * MiB;
constexpr size_t WS_WBO = 158 * MiB;
constexpr size_t WS_W1T = 160 * MiB;
constexpr size_t WS_W2T = 162 * MiB;
constexpr size_t WS_GATES = 163 * MiB;
constexpr size_t WS_S = 169 * MiB;
constexpr size_t WS_CMP = 233 * MiB;
constexpr size_t WS_PROJB = 256 * MiB;
constexpr size_t WS_END = 512 * MiB;

constexpr int LDS_BYTES = 155648;

DI unsigned cvtpk(float lo, float hi) { f32x2 v = {lo, hi}; bf16x2_t b = __builtin_convertvector(v, bf16x2_t); return __builtin_bit_cast(unsigned, b); }
DI bf16_t f2bf(float f) { return (bf16_t)(cvtpk(f, 0.f) & 0xffffu); }
DI float bf2f(bf16_t v) { return __uint_as_float((unsigned)v << 16); }
DI float bflo(unsigned u) { return __uint_as_float(u << 16); }
DI float bfhi(unsigned u) { return __uint_as_float(u & 0xffff0000u); }
DI float sigm(float x) { return __builtin_amdgcn_rcpf(1.f + __builtin_amdgcn_exp2f(-1.4426950408889634f * x)); }
DI float siluf(float x) { return x * sigm(x); }
DI float wave_sum(float v) {
#pragma unroll
    for (int o = 1; o < 64; o <<= 1) v += __shfl_xor(v, o);
    return v;
}
DI int crow(int reg, int h) { return (reg & 3) + 8 * (reg >> 2) + 4 * h; }
#define MFMA32(a, b, c) __builtin_amdgcn_mfma_f32_32x32x16_bf16((a), (b), (c), 0, 0, 0)
DI bf16x8 pack8(const f32x16& x, const int s) {
    u32x4 p;
    p[0] = cvtpk(x[8 * s + 0], x[8 * s + 1]); p[1] = cvtpk(x[8 * s + 2], x[8 * s + 3]);
    p[2] = cvtpk(x[8 * s + 4], x[8 * s + 5]); p[3] = cvtpk(x[8 * s + 6], x[8 * s + 7]);
    return __builtin_bit_cast(bf16x8, p);
}
DI bf16x8 lds128(const LAS unsigned char* p) { return *(const LAS bf16x8*)p; }
DI bf16x8 lds2x64(const LAS unsigned char* lo, const LAS unsigned char* hi) {
    const s16x4 a = *(const LAS s16x4*)lo, b = *(const LAS s16x4*)hi;
    return __builtin_shufflevector(a, b, 0, 1, 2, 3, 4, 5, 6, 7);
}
DI int otid() { int t = threadIdx.x; asm volatile("" : "+v"(t)); return t; }
DI f32x16 zero16() { f32x16 z; for (int i = 0; i < 16; ++i) z[i] = 0.f; return z; }

struct Params { const float* in[23]; float* out; unsigned char* ws; int ph_lo, ph_hi, pad0, pad1; };

#define XB_TMO      128
#define XB_XCNT(j)  (256  + 64 * (j))
#define XB_XSUB(j)  (1280 + 64 * (j))
#define XB_XGEN(j)  (2304 + 64 * (j))
#define XB_TOP      3328
#define XB_TOPGEN   3392
#define XCD_BAR_WORDS 3456
#define XB_SPIN_CAP (1u << 22)
DI unsigned xb_ld(unsigned* p)              { return __hip_atomic_load(p, __ATOMIC_RELAXED, __HIP_MEMORY_SCOPE_AGENT); }
DI unsigned xb_add(unsigned* p, unsigned v) { return __hip_atomic_fetch_add(p, v, __ATOMIC_RELAXED, __HIP_MEMORY_SCOPE_AGENT); }
DI unsigned xb_xcc_id() { return (unsigned)__builtin_amdgcn_s_getreg((3 << 11) | 20) & 0xFu; }
#define XB_SPIN(cond, bar) do { unsigned _sp = 0; while (cond) { __builtin_amdgcn_s_sleep(1); \
    if ((++_sp & 255u) == 0u) { if (xb_ld(&(bar)[XB_TMO])) break; if (_sp > XB_SPIN_CAP) { atomicAdd(&(bar)[XB_TMO], 1u); break; } } } } while (0)
struct XcdBarrier { unsigned* bar; unsigned x; volatile LAS unsigned* st; };
DI XcdBarrier xcd_barrier_post(unsigned* bar, volatile LAS unsigned* st) {
    XcdBarrier b; b.bar = bar; b.x = xb_xcc_id(); b.st = st;
    if (threadIdx.x == 0) (void)xb_add(&bar[XB_XCNT(b.x)], 1u);
    return b;
}
DI void xcd_barrier_complete(unsigned* bar, unsigned x, unsigned& nloc, unsigned& nx) {
    const unsigned G = gridDim.x * gridDim.y * gridDim.z;
    unsigned sum, cnt, mine, sp = 0u;
    for (;;) {
        sum = 0u; cnt = 0u; mine = 0u;
#pragma unroll
        for (unsigned j = 0; j < 16; ++j) { const unsigned c = xb_ld(&bar[XB_XCNT(j)]); sum += c; cnt += (c > 0u) ? 1u : 0u; mine = (j == x) ? c : mine; }
        if (sum == G) break;
        __builtin_amdgcn_s_sleep(1);
        if ((++sp & 255u) == 0u) { if (xb_ld(&bar[XB_TMO])) break; if (sp > XB_SPIN_CAP) { atomicAdd(&bar[XB_TMO], 1u); break; } }
    }
    nloc = mine > 0u ? mine : 1u; nx = cnt > 0u ? cnt : 1u;
}
DI void xcd_barrier(const XcdBarrier& b) {
    asm volatile("s_waitcnt vmcnt(0)" ::: "memory");
    __syncthreads();
    if (threadIdx.x == 0) {
        unsigned* bar = b.bar;
        __builtin_amdgcn_s_waitcnt(0);
        unsigned nloc = b.st[0], nx = b.st[1];
        if (nloc == 0u) { xcd_barrier_complete(bar, b.x, nloc, nx); b.st[0] = nloc; b.st[1] = nx; }
        const unsigned old = xb_add(&bar[XB_XSUB(b.x)], 1u);
        const unsigned gen = old / nloc;
        if (old + 1u == (gen + 1u) * nloc) {
            __builtin_amdgcn_fence(__ATOMIC_RELEASE, "agent");
            asm volatile("s_waitcnt vmcnt(0)" ::: "memory");
            const unsigned og = xb_add(&bar[XB_TOP], 1u);
            const unsigned tg = og / nx;
            if (og + 1u == (tg + 1u) * nx) xb_add(&bar[XB_TOPGEN], 1u);
            else XB_SPIN(xb_ld(&bar[XB_TOPGEN]) == tg, bar);
            __builtin_amdgcn_fence(__ATOMIC_ACQUIRE, "agent");
            xb_add(&bar[XB_XGEN(b.x)], 1u);
            asm volatile("s_waitcnt vmcnt(0)" ::: "memory");
        } else {
            XB_SPIN(xb_ld(&bar[XB_XGEN(b.x)]) == gen, bar);
            __builtin_amdgcn_fence(__ATOMIC_ACQUIRE, "agent");
            asm volatile("s_waitcnt vmcnt(0)" ::: "memory");
        }
    }
    __syncthreads();
}

namespace pg8 {
constexpr int BM = 256, BK = 64, HALF = 128, HTB = HALF * BK * 2, STAGE_BYTES = 8 * HTB, NXCD = 8, WGM = 8;
DI int lds_byte(int r, int c) { const int st = (r >> 4) * 2 + (c >> 5), rr = r & 15, cc = c & 31, ob = rr * 64 + cc * 2; return st * 1024 + (ob ^ (((ob >> 9) & 1) << 5)); }
DI void stage_rc(int b, int& R, int& C) { const int st = b / 1024, sb = b % 1024, swz = sb ^ (((sb >> 9) & 1) << 5); R = (st >> 1) * 16 + swz / 64; C = (st & 1) * 32 + (swz % 64) / 2; }
DI int perm32(int rho) { const int n = rho >> 4, i = rho & 15; return 8 * (i >> 2) + 4 * n + (i & 3); }
struct Unit { int pm, pn; };
struct Gemm { const bf16_t* A0; const bf16_t* A1; int split; const bf16_t* Bt; int M, N, K; };
struct StaticOrder {
    int nM, nN, nwg, G, c;
    DI void init(int M_, int N_, int G_, int c_) { nM = M_ / BM; nN = N_ / BM; nwg = nM * nN; G = G_; c = c_; }
    DI bool next(int i, Unit& u) const {
        const long L = (long)i * G + c; if (L >= nwg) return false;
        int wgid = (int)L; { const int q = nwg / NXCD, r = nwg % NXCD, xcd = wgid % NXCD, off = wgid / NXCD; wgid = (xcd < r ? xcd * (q + 1) : r * (q + 1) + (xcd - r) * q) + off; }
        const int nig = WGM * nN, gid = wgid / nig, fm = gid * WGM, gsz = (nM - fm) < WGM ? (nM - fm) : WGM;
        u.pm = fm + ((wgid % nig) % gsz); u.pn = (wgid % nig) / gsz; return true;
    }
};
template <class Epi, bool ALIGN_EPI>
DI void gemm_phase(LAS unsigned char* lds, const Gemm g, const StaticOrder& S, const Epi& E) {
    const int tid = otid(), wid = __builtin_amdgcn_readfirstlane(tid >> 6), lane = tid & 63, wr = wid >> 2, wc = wid & 3, fr = lane & 15, fq = lane >> 4;
    const int K = g.K, nt = K / BK;
    unsigned voffA[2], voffB[2];
#pragma unroll
    for (int i = 0; i < 2; ++i) { int R, C; stage_rc(tid * 16 + i * 8192, R, C); const int Rb = Epi::PERM ? ((R & ~31) + perm32(R & 31)) : R;
        voffA[i] = (unsigned)(R * K + C) * 2u; voffB[i] = (unsigned)(Rb * K + C) * 2u; }
    const size_t kstep = (size_t)(BK * 2);
    const size_t hstep = (size_t)HALF * K * 2;
    const size_t tstep = 2 * hstep;
    const unsigned ldsw = (unsigned)wid * 1024u;
    const int aoff = lds_byte(wr * 64 + fr, fq * 8), boff = lds_byte(wc * 32 + fr, fq * 8);
#define PG8_SA(b, h) (((b) * 2 + (h)) * HTB)
#define PG8_SB(b, h) ((4 + (b) * 2 + (h)) * HTB)
#define PG8_STAGE(bufoff, gbase, voff) do { _Pragma("unroll") for (int _i = 0; _i < 2; ++_i) \
        __builtin_amdgcn_global_load_lds((const unsigned*)((const char*)(gbase) + (voff)[_i]), (LAS unsigned*)(lds + (bufoff) + ldsw + _i * 8192), 16, 0, 0); } while (0)
#define PG8_LDA(dst, b, h) do { _Pragma("unroll") for (int m = 0; m < 4; ++m) _Pragma("unroll") for (int k = 0; k < 2; ++k) dst[m][k] = *(const LAS bf16x8*)(lds + PG8_SA(b, h) + aoff + m * 2048 + k * 1024); } while (0)
#define PG8_LDB(dst, b, h) do { _Pragma("unroll") for (int n = 0; n < 2; ++n) _Pragma("unroll") for (int k = 0; k < 2; ++k) dst[n][k] = *(const LAS bf16x8*)(lds + PG8_SB(b, h) + boff + n * 2048 + k * 1024); } while (0)
#define PG8_MMA(ai, bj, At, Bt) do { __builtin_amdgcn_s_setprio(1); _Pragma("unroll") for (int m = 0; m < 4; ++m) _Pragma("unroll") for (int n = 0; n < 2; ++n) _Pragma("unroll") for (int k = 0; k < 2; ++k) \
        acc[ai][bj][m][n] = __builtin_amdgcn_mfma_f32_16x16x32_bf16(Bt[n][k], At[m][k], acc[ai][bj][m][n], 0, 0, 0); __builtin_amdgcn_s_setprio(0); } while (0)
#define PG8_WAIT_V(n) asm volatile("s_waitcnt vmcnt(" #n ")" ::: "memory")
#define PG8_WAIT_L(n) asm volatile("s_waitcnt lgkmcnt(" #n ")" ::: "memory")
#define PG8_BAR __builtin_amdgcn_s_barrier()
#define PG8_SCHED __builtin_amdgcn_sched_barrier(0)
    Unit cur, nxt; int ui = 0;
    if (!S.next(0, cur)) return;
    f32x4 acc[2][2][4][2];
#pragma unroll
    for (int a = 0; a < 2; ++a)
#pragma unroll
        for (int b = 0; b < 2; ++b)
#pragma unroll
            for (int m = 0; m < 4; ++m)
#pragma unroll
                for (int n = 0; n < 2; ++n) acc[a][b][m][n] = (f32x4){0.f, 0.f, 0.f, 0.f};
    bf16x8 At[4][2], B0[2][2], B1[2][2];
    const char* cA = (const char*)(cur.pn < g.split ? g.A0 : g.A1) + (size_t)cur.pm * tstep; const char* cB = (const char*)g.Bt + (size_t)cur.pn * tstep;
    PG8_STAGE(PG8_SB(0, 0), cB, voffB); PG8_STAGE(PG8_SB(0, 1), cB + hstep, voffB); PG8_STAGE(PG8_SA(0, 0), cA, voffA); PG8_STAGE(PG8_SA(0, 1), cA + hstep, voffA);
    if (wr == 1) PG8_BAR;
    PG8_WAIT_V(2); PG8_BAR;
    PG8_STAGE(PG8_SB(1, 0), cB + kstep, voffB); PG8_STAGE(PG8_SA(1, 0), cA + kstep, voffA); PG8_STAGE(PG8_SB(1, 1), cB + hstep + kstep, voffB);
    PG8_WAIT_V(6); PG8_BAR;
    for (;;) {
        const bool has_next = S.next(ui + 1, nxt);
        const char* nA = has_next ? (const char*)(nxt.pn < g.split ? g.A0 : g.A1) + (size_t)nxt.pm * tstep : cA; const char* nB = has_next ? (const char*)g.Bt + (size_t)nxt.pn * tstep : cB;
        for (int t = 0; t < nt; t += 2) {
            const bool last = (t == nt - 2);
            const char* a1 = cA + (size_t)(t + 1) * kstep;
            const char* a2 = last ? nA : cA + (size_t)(t + 2) * kstep; const char* b2 = last ? nB : cB + (size_t)(t + 2) * kstep;
            const char* a3 = a2 + kstep; const char* b3 = b2 + kstep;
            PG8_LDB(B0, 0, 0); PG8_LDB(B1, 0, 1); PG8_SCHED; PG8_LDA(At, 0, 0); PG8_STAGE(PG8_SA(1, 1), a1 + hstep, voffA);
            PG8_WAIT_V(8); PG8_WAIT_L(0); PG8_BAR; PG8_MMA(0, 0, At, B0); PG8_MMA(0, 1, At, B1); PG8_BAR; PG8_SCHED;
            PG8_LDA(At, 0, 1); PG8_STAGE(PG8_SB(0, 0), b2, voffB); PG8_STAGE(PG8_SB(0, 1), b2 + hstep, voffB); PG8_STAGE(PG8_SA(0, 0), a2, voffA);
            PG8_WAIT_V(8); PG8_WAIT_L(0); PG8_BAR; PG8_MMA(1, 0, At, B0); PG8_MMA(1, 1, At, B1); PG8_BAR; PG8_SCHED;
            PG8_LDB(B0, 1, 0); PG8_LDB(B1, 1, 1); PG8_SCHED; PG8_LDA(At, 1, 0); PG8_STAGE(PG8_SA(0, 1), a2 + hstep, voffA);
            PG8_WAIT_V(8); PG8_WAIT_L(0); PG8_BAR; PG8_MMA(0, 0, At, B0); PG8_MMA(0, 1, At, B1); PG8_BAR; PG8_SCHED;
            PG8_LDA(At, 1, 1); PG8_STAGE(PG8_SB(1, 0), b3, voffB); PG8_STAGE(PG8_SB(1, 1), b3 + hstep, voffB); PG8_STAGE(PG8_SA(1, 0), a3, voffA);
            PG8_WAIT_V(8); PG8_WAIT_L(0); PG8_BAR; PG8_MMA(1, 0, At, B0); PG8_MMA(1, 1, At, B1); PG8_BAR; PG8_SCHED;
        }
        if constexpr (ALIGN_EPI) { if (wr == 0) PG8_BAR; }
        E(acc, cur, wr, wc, fr, fq);
        if (!has_next) break;
#pragma unroll
        for (int a = 0; a < 2; ++a)
#pragma unroll
            for (int b = 0; b < 2; ++b)
#pragma unroll
                for (int m = 0; m < 4; ++m)
#pragma unroll
                    for (int n = 0; n < 2; ++n) acc[a][b][m][n] = (f32x4){0.f, 0.f, 0.f, 0.f};
        cur = nxt; cA = nA; cB = nB; ++ui;
        if constexpr (ALIGN_EPI) { if (wr == 1) PG8_BAR; }
    }
    PG8_WAIT_V(0);
    if constexpr (!ALIGN_EPI) { if (wr == 0) PG8_BAR; }
    PG8_BAR;
#undef PG8_SA
#undef PG8_SB
#undef PG8_STAGE
#undef PG8_LDA
#undef PG8_LDB
#undef PG8_MMA
#undef PG8_WAIT_V
#undef PG8_WAIT_L
#undef PG8_BAR
#undef PG8_SCHED
}
}

struct EpiA {
    static constexpr bool PERM = true;
    bf16_t* qkv; bf16_t* z; int row_off;
    DI void operator()(const f32x4 (&acc)[2][2][4][2], const pg8::Unit& u, int wr, int wc, int fr, int fq) const {
        const int row0 = u.pm * 256 + wr * 64 + fr; const int ct = u.pn * 256 + wc * 32 + 8 * fq;
        bf16_t* base; int ldc, col0;
        if (u.pn < 12) { base = qkv + (size_t)row0 * 3072; ldc = 3072; col0 = ct; } else { base = z + (size_t)(row_off + row0) * 1024; ldc = 1024; col0 = ct - 3072; }
#pragma unroll
        for (int ai = 0; ai < 2; ++ai)
#pragma unroll
            for (int m = 0; m < 4; ++m) { bf16_t* rowp = base + (size_t)(ai * 128 + m * 16) * ldc + col0;
#pragma unroll
                for (int bj = 0; bj < 2; ++bj) { const f32x4 v0 = acc[ai][bj][m][0], v1 = acc[ai][bj][m][1];
                    u32x4 w; w.x = cvtpk(v0[0], v0[1]); w.y = cvtpk(v0[2], v0[3]); w.z = cvtpk(v1[0], v1[1]); w.w = cvtpk(v1[2], v1[3]);
                    *(u32x4*)(rowp + bj * 128) = w; } }
    }
};
template <bool SSQ> struct EpiRes {
    static constexpr bool PERM = false;
    const float* base; float* out; const float* gate  ; float* ssq;
    DI void operator()(const f32x4 (&acc)[2][2][4][2], const pg8::Unit& u, int wr, int wc, int fr, int fq) const {
        const int col0 = u.pn * 256 + wc * 32 + 4 * fq; const int b = (u.pm * 256) >> 12;
        f32x4 gv[2][2];
#pragma unroll
        for (int bj = 0; bj < 2; ++bj)
#pragma unroll
            for (int n = 0; n < 2; ++n) gv[bj][n] = *(const f32x4*)(gate + (size_t)b * 3072 + 2048 + col0 + bj * 128 + n * 16);
#pragma unroll
        for (int ai = 0; ai < 2; ++ai)
#pragma unroll
            for (int m = 0; m < 4; ++m) { const int r = u.pm * 256 + ai * 128 + wr * 64 + m * 16 + fr; const size_t off = (size_t)r * 1024 + col0; float ss = 0.f;
#pragma unroll
                for (int bj = 0; bj < 2; ++bj)
#pragma unroll
                    for (int n = 0; n < 2; ++n) { const f32x4 bs = *(const f32x4*)(base + off + bj * 128 + n * 16); const f32x4 o = bs + gv[bj][n] * acc[ai][bj][m][n];
                        *(f32x4*)(out + off + bj * 128 + n * 16) = o; if (SSQ) ss += (o[0] * o[0] + o[1] * o[1]) + (o[2] * o[2] + o[3] * o[3]); }
                if (SSQ) { ss += __shfl_xor(ss, 16); ss += __shfl_xor(ss, 32); if (fq == 0) ssq[(size_t)(u.pn * 4 + wc) * M + r] = ss; } }
    }
};
struct EpiB {
    static constexpr bool PERM = true;
    bf16_t* kv; bf16_t* projb; float* gates; bf16_t* vt;
    DI void operator()(const f32x4 (&acc)[2][2][4][2], const pg8::Unit& u, int wr, int wc, int fr, int fq) const {
        const int row0 = u.pm * 256 + wr * 64 + fr; const int cw = wc * 32 + 8 * fq;
        if (u.pn == 19) {
#pragma unroll
            for (int ai = 0; ai < 2; ++ai)
#pragma unroll
                for (int m = 0; m < 4; ++m) { float* rowp = gates + (size_t)(row0 + ai * 128 + m * 16) * 48;
                    if (cw < 48) {
#pragma unroll
                        for (int n = 0; n < 2; ++n) { const f32x4 v = acc[ai][0][m][n]; f32x4 o; o[0] = sigm(v[0]); o[1] = sigm(v[1]); o[2] = sigm(v[2]); o[3] = sigm(v[3]); *(f32x4*)(rowp + cw + 4 * n) = o; } } }
            return;
        }
        if (u.pn == 1 || u.pn == 2) {
            const int gq = wc >> 1, d0 = (wc & 1) * 32 + 8 * fq;
#pragma unroll
            for (int ai = 0; ai < 2; ++ai)
#pragma unroll
                for (int m = 0; m < 4; ++m) { const int row = row0 + ai * 128 + m * 16; const int bb = row >> 12, t = row & 4095;
                    bf16_t* vp = vt + ((size_t)(((u.pn - 1) * 8 + bb) * 2 + gq) * 64 + d0) * 4096 + t;
                    const f32x4 v0 = acc[ai][1][m][0], v1 = acc[ai][1][m][1];
                    vp[0 * 4096] = f2bf(v0[0]); vp[1 * 4096] = f2bf(v0[1]); vp[2 * 4096] = f2bf(v0[2]); vp[3 * 4096] = f2bf(v0[3]);
                    vp[4 * 4096] = f2bf(v1[0]); vp[5 * 4096] = f2bf(v1[1]); vp[6 * 4096] = f2bf(v1[2]); vp[7 * 4096] = f2bf(v1[3]); }
        }
        bf16_t* base; int ldc, col0; float sc = 1.f;
        if (u.pn < 3) { base = kv + (size_t)row0 * 768; ldc = 768; col0 = u.pn * 256 + cw; } else { base = projb + (size_t)row0 * 4096; ldc = 4096; col0 = (u.pn - 3) * 256 + cw; if (u.pn < 7) sc = 0.125f * 1.4426950408889634f; }
#pragma unroll
        for (int ai = 0; ai < 2; ++ai)
#pragma unroll
            for (int m = 0; m < 4; ++m) { bf16_t* rowp = base + (size_t)(ai * 128 + m * 16) * ldc + col0;
#pragma unroll
                for (int bj = 0; bj < 2; ++bj) { const f32x4 v0 = acc[ai][bj][m][0] * sc, v1 = acc[ai][bj][m][1] * sc;
                    u32x4 w; w.x = cvtpk(v0[0], v0[1]); w.y = cvtpk(v0[2], v0[3]); w.z = cvtpk(v1[0], v1[1]); w.w = cvtpk(v1[2], v1[3]);
                    *(u32x4*)(rowp + bj * 128) = w; } }
    }
};

DI void p0_transpose_item(const float* W, int ld, int col0, int nvalid, int K, bf16_t* WT, int row_off, LAS float* scr, int item, int nblk, int lane) {
    const int kb = item / nblk, nb = item % nblk, k0 = 64 * kb, n0 = 32 * nb;
    const int nn = n0 + (lane & 31);
#pragma unroll 8
    for (int i = 0; i < 32; ++i) { const int kk = 2 * i + (lane >> 5); scr[kk * 33 + (lane & 31)] = (nn < nvalid) ? W[(size_t)(k0 + kk) * ld + col0 + nn] : 0.f; }
    asm volatile("s_waitcnt lgkmcnt(0)" ::: "memory");
    const int c = lane & 7;
#pragma unroll
    for (int j = 0; j < 4; ++j) { const int n = (lane >> 3) + 8 * j; const LAS float* s = scr + (8 * c) * 33 + n;
        u32x4 o; o.x = cvtpk(s[0 * 33], s[1 * 33]); o.y = cvtpk(s[2 * 33], s[3 * 33]); o.z = cvtpk(s[4 * 33], s[5 * 33]); o.w = cvtpk(s[6 * 33], s[7 * 33]);
        *(u32x4*)(WT + (size_t)(row_off + n0 + n) * K + k0 + 8 * c) = o; }
    asm volatile("s_waitcnt lgkmcnt(0)" ::: "memory");
}
template <int PART> DI void p0_prologue(const Params& p, LAS unsigned char* lds, const int b0, const int nb) {
    const int tid = otid(), lane = tid & 63, wave = __builtin_amdgcn_readfirstlane(tid >> 6);
    LAS float* scr = (LAS float*)(lds + wave * 8704);
    const int gw = ((int)blockIdx.x - b0) * 8 + wave, NGW = nb * 8;
    if ((int)blockIdx.x < b0 || (int)blockIdx.x >= b0 + nb) return;
    unsigned char* ws = p.ws;
    constexpr int I_ADA = 1536, I_WA = 16 * 128, I_WAO = 16 * 32, I_KV = 16 * 24, I_WB = 16 * 128, I_WG = 16 * 8, I_WBO = 16 * 32, I_W1 = 32 * 8, I_W2 = 4 * 2, I_C1 = 128;
    constexpr int NITEMS = I_ADA + I_WA + I_WAO + I_KV + I_WB + I_WG + I_WBO + 2 * I_W1 + 2 * I_W2 + I_C1;
    constexpr int N_P0 = I_ADA + I_WA + I_WAO;
    constexpr int N_P1 = I_KV + I_WB + I_WG + I_WBO + 2 * I_W1 + 2 * I_W2;
    constexpr int NLOOP = PART == 0 ? N_P0 + I_C1 : N_P1;
    static_assert(N_P0 + N_P1 + I_C1 == NITEMS, "p0 items");
    for (int it0 = gw; it0 < NLOOP; it0 += NGW) {
        int r = __builtin_amdgcn_readfirstlane(it0);
        if (PART == 0) { if (r >= N_P0) r += N_P1; } else r += N_P0;
        if (r < I_ADA) {
            const int l = r / 768, rem = r % 768, jc = rem / 16, kc = rem % 16;
            const float* c = p.in[1]; const float* w = p.in[3] + (size_t)l * 1024 * 3072;
            float a[8]; for (int b = 0; b < 8; ++b) a[b] = 0.f;
            const int j = jc * 64 + lane;
            for (int kk = 0; kk < 64; ++kk) { const int k = kc * 64 + kk; const float wv = w[(size_t)k * 3072 + j];
#pragma unroll
                for (int b = 0; b < 8; ++b) { const float cv = c[b * 1024 + k]; a[b] += siluf(cv) * wv; } }
            float* modp = (float*)(ws + WS_MODP);
#pragma unroll
            for (int b = 0; b < 8; ++b) modp[(size_t)((kc * 2 + l) * 8 + b) * 3072 + j] = a[b];
            continue;
        }
        r -= I_ADA;
        if (r < I_WA) { p0_transpose_item(p.in[6], A_LD, 0, 4096, 1024, (bf16_t*)(ws + WS_WA), 0, scr, r, 128, lane); continue; } r -= I_WA;
        if (r < I_WAO) { p0_transpose_item(p.in[11], 1024, 0, 1024, 1024, (bf16_t*)(ws + WS_WAO), 0, scr, r, 32, lane); continue; } r -= I_WAO;
        if (r < I_KV) { p0_transpose_item(p.in[13], 768, 0, 768, 1024, (bf16_t*)(ws + WS_WCAT), 0, scr, r, 24, lane); continue; } r -= I_KV;
        if (r < I_WB) { p0_transpose_item(p.in[20], B_LD, 0, 4096, 1024, (bf16_t*)(ws + WS_WCAT), 768, scr, r, 128, lane); continue; } r -= I_WB;
        if (r < I_WG) { p0_transpose_item(p.in[20], B_LD, 4096, 48, 1024, (bf16_t*)(ws + WS_WCAT), 4864, scr, r, 8, lane); continue; } r -= I_WG;
        if (r < I_WBO) { p0_transpose_item(p.in[21], 1024, 0, 1024, 1024, (bf16_t*)(ws + WS_WBO), 0, scr, r, 32, lane); continue; } r -= I_WBO;
        if (r < I_W1) { p0_transpose_item(p.in[16], 256, 0, 256, 2048, (bf16_t*)(ws + WS_W1T), 0, scr, r, 8, lane); continue; } r -= I_W1;
        if (r < I_W1) { p0_transpose_item(p.in[18], 256, 0, 256, 2048, (bf16_t*)(ws + WS_W1T), 256, scr, r, 8, lane); continue; } r -= I_W1;
        if (r < I_W2) { p0_transpose_item(p.in[17], 64, 0, 64, 256, (bf16_t*)(ws + WS_W2T), 0, scr, r, 2, lane); continue; } r -= I_W2;
        if (r < I_W2) { p0_transpose_item(p.in[19], 64, 0, 64, 256, (bf16_t*)(ws + WS_W2T), 64, scr, r, 2, lane); continue; } r -= I_W2;
        {
            const int which = r / 64, rem = r % 64, jc = rem / 16, kc = rem % 16;
            const float* pos = p.in[14 + which]; const float* w1 = p.in[16 + 2 * which];
            const int j = jc * 64 + lane; float a = 0.f;
            for (int kk = 0; kk < 128; ++kk) { const int k = kc * 128 + kk; a += pos[k] * w1[(size_t)k * 256 + j]; }
            ((float*)(ws + WS_C1P))[(kc * 2 + which) * 256 + j] = a;
        }
    }
}

template <int LAYER> DI void norm_rows(const Params& p, LAS unsigned char* lds) {
    const int tid = otid(), lane = tid & 63, wave = __builtin_amdgcn_readfirstlane(tid >> 6);
    unsigned char* ws = p.ws;
    LAS float* gs = (LAS float*)lds;
    LAS float* sh = gs + 1024;
    LAS float* g2 = sh + 1024;
    LAS float* wba = g2 + 1024;
    const float* xin = LAYER == 0 ? p.in[0] : p.out;
    bf16_t* hout = LAYER == 0 ? (bf16_t*)((unsigned char*)p.out + 64 * MiB) : (bf16_t*)(ws + WS_RA);
    bf16_t* sout = (bf16_t*)(ws + WS_S);
    const float* modp = (const float*)(ws + WS_MODP);
    float* mod = (float*)(ws + WS_MOD);
    for (int rb = blockIdx.x; rb < 256; rb += gridDim.x) {
        const int b = rb >> 5;
        __syncthreads();
        for (int k = tid; k < 1024; k += 512) {
            float v[3];
#pragma unroll
            for (int part = 0; part < 3; ++part) { float a = p.in[4][LAYER * 3072 + part * 1024 + k];
                for (int kc = 0; kc < 16; ++kc) a += modp[(size_t)((kc * 2 + LAYER) * 8 + b) * 3072 + part * 1024 + k];
                v[part] = a; if ((rb & 31) == 0) mod[(size_t)(LAYER * 8 + b) * 3072 + part * 1024 + k] = a; }
            gs[k] = p.in[5][LAYER * 1024 + k] * (1.f + v[1]); sh[k] = v[0];
            if (LAYER == 1) g2[k] = p.in[12][k];
        }
        if (LAYER == 0) for (int i = tid; i < 16 * 1024; i += 512) { const int c = i & 15, k = i >> 4; wba[c * 1024 + k] = p.in[6][(size_t)k * A_LD + 4096 + c]; }
        __syncthreads();
        f32x4 vn[4];
        { const f32x4* xr0 = (const f32x4*)(xin + (size_t)(rb * 128 + wave * 16) * 1024) + lane;
#pragma unroll
          for (int j = 0; j < 4; ++j) vn[j] = xr0[64 * j]; }
        for (int rr = 0; rr < 16; ++rr) {
            const int m = rb * 128 + wave * 16 + rr;
            f32x4 v[4]; float s = 0.f;
#pragma unroll
            for (int j = 0; j < 4; ++j) { v[j] = vn[j]; s += (v[j][0] * v[j][0] + v[j][1] * v[j][1]) + (v[j][2] * v[j][2] + v[j][3] * v[j][3]); }
            if (rr + 1 < 16) { const f32x4* xr1 = (const f32x4*)(xin + (size_t)(m + 1) * 1024) + lane;
#pragma unroll
                for (int j = 0; j < 4; ++j) vn[j] = xr1[64 * j]; }
            const float rstd = rsqrtf(wave_sum(s) * (1.f / 1024.f) + EPS);
            f32x4 hv[4];
#pragma unroll
            for (int j = 0; j < 4; ++j) { const f32x4 g4 = *(const LAS f32x4*)(gs + 4 * lane + 256 * j), s4 = *(const LAS f32x4*)(sh + 4 * lane + 256 * j);
                const f32x4 xn = v[j] * rstd; hv[j] = xn * g4 + s4;
                u32x2 o; o.x = cvtpk(hv[j][0], hv[j][1]); o.y = cvtpk(hv[j][2], hv[j][3]);
                *((u32x2*)(hout + (size_t)m * 1024) + lane + 64 * j) = o;
                if (LAYER == 1) { const f32x4 k4 = *(const LAS f32x4*)(g2 + 4 * lane + 256 * j); const f32x4 sv = xn * k4; u32x2 o2; o2.x = cvtpk(sv[0], sv[1]); o2.y = cvtpk(sv[2], sv[3]);
                    *((u32x2*)(sout + (size_t)m * 1024) + lane + 64 * j) = o2; } }
            if (LAYER == 0) {
                float pa[16];
#pragma unroll
                for (int c = 0; c < 16; ++c) { float a = 0.f;
#pragma unroll
                    for (int j = 0; j < 4; ++j) { const f32x4 w4 = *(const LAS f32x4*)(wba + c * 1024 + 4 * lane + 256 * j); a += (hv[j][0] * w4[0] + hv[j][1] * w4[1]) + (hv[j][2] * w4[2] + hv[j][3] * w4[3]); }
                    pa[c] = a; if (c & 1) __builtin_amdgcn_sched_barrier(0); }
                {
                    const bool up = (lane & 32) != 0; float q[8];
#pragma unroll
                    for (int c = 0; c < 8; ++c) { const float keep = up ? pa[8 + c] : pa[c], give = up ? pa[c] : pa[8 + c]; q[c] = keep + __shfl_xor(give, 32); }
                    const bool up2 = (lane & 16) != 0; float r4[4];
#pragma unroll
                    for (int c = 0; c < 4; ++c) { const float keep = up2 ? q[4 + c] : q[c], give = up2 ? q[c] : q[4 + c]; r4[c] = keep + __shfl_xor(give, 16); }
                    const bool up3 = (lane & 8) != 0; float r2[2];
#pragma unroll
                    for (int c = 0; c < 2; ++c) { const float keep = up3 ? r4[2 + c] : r4[c], give = up3 ? r4[c] : r4[2 + c]; r2[c] = keep + __shfl_xor(give, 8); }
                    const bool up4 = (lane & 4) != 0;
                    const float keep = up4 ? r2[1] : r2[0], give = up4 ? r2[0] : r2[1];
                    float r1 = keep + __shfl_xor(give, 4);
                    r1 += __shfl_xor(r1, 2); r1 += __shfl_xor(r1, 1);
                    pa[0] = r1;
                }
                const int mycol = ((lane >> 5) & 1) * 8 + ((lane >> 4) & 1) * 4 + ((lane >> 3) & 1) * 2 + ((lane >> 2) & 1);
                const float mine = pa[0];
                if ((lane & 3) == 0) { float o; const int cc = mycol;
                    if (cc < 8) o = sigm(mine);
                    else { const float xx = mine + p.in[9][cc - 8]; const float sp = xx > 20.f ? xx : log1pf(__expf(xx)); o = -__expf(p.in[8][cc - 8]) * sp; }
                    ((float*)(ws + WS_BG))[(size_t)m * 16 + cc] = o; }
            }
        }
    }
}

DI void mm16_acc(float (&acc)[4], const LAS float* X, int px, const LAS float* Y, int py, int c, int q) {
    float y[16];
#pragma unroll
    for (int kk = 0; kk < 16; ++kk) y[kk] = Y[kk * py + c];
#pragma unroll
    for (int h2 = 0; h2 < 2; ++h2) {
        f32x4 xv[2][4];
#pragma unroll
        for (int rr = 0; rr < 2; ++rr)
#pragma unroll
            for (int k4 = 0; k4 < 4; ++k4) xv[rr][k4] = *(const LAS f32x4*)(X + (4 * q + 2 * h2 + rr) * px + 4 * k4);
#pragma unroll
        for (int k4 = 0; k4 < 4; ++k4)
#pragma unroll
            for (int rr = 0; rr < 2; ++rr)
                acc[2 * h2 + rr] += (xv[rr][k4][0] * y[4 * k4] + xv[rr][k4][1] * y[4 * k4 + 1]) + (xv[rr][k4][2] * y[4 * k4 + 2] + xv[rr][k4][3] * y[4 * k4 + 3]);
    }
}
template <int K> DI float row_bcast16(float v) {
    return __builtin_bit_cast(float, __builtin_amdgcn_update_dpp(0, __builtin_bit_cast(int, v), 0x150 + K, 0xf, 0xf, false));
}
template <int I, int K> struct InvRow {
    static DI void run(const float (&mcol)[16], const float (&tt)[16], float& s) { InvRow<I, K - 1>::run(mcol, tt, s); s += row_bcast16<K>(mcol[I]) * tt[K]; }
};
template <int I> struct InvRow<I, -1> { static DI void run(const float (&)[16], const float (&)[16], float&) {} };
template <int I> struct InvAll {
    static DI void run(const float (&mcol)[16], float (&tt)[16], int c) { InvAll<I - 1>::run(mcol, tt, c); float s = 0.f; InvRow<I, I - 1>::run(mcol, tt, s); tt[I] = (I == c ? 1.f : 0.f) - s;
        __builtin_amdgcn_sched_barrier(0); }
};
template <> struct InvAll<-1> { static DI void run(const float (&)[16], float (&)[16], int) {} };
DI void p3_prep(const Params& p, LAS unsigned char* lds) {
    const int tid = otid(), lane_k = tid & 63, wave = __builtin_amdgcn_readfirstlane(tid >> 6);
    unsigned char* ws = p.ws;
    constexpr int L_CW = 0, L_QS = 6144, L_KS = L_QS + 17408, L_VBT = L_KS + 17408, L_KBGT = L_VBT + 18432, L_KDT = L_KBGT + 18432,
                  L_LM = L_KDT + 18432, L_TM = L_LM + 17408, L_TB = L_TM + 17408  , L_PM = L_TB + 9216, L_GC = L_PM + 2560, L_BETA = L_GC + 256, L_SS = L_BETA + 256;
    static_assert(L_SS + 4096 <= LDS_BYTES, "p3 lds");
    LAS float* Lm = (LAS float*)(lds + L_LM);
    LAS float* Tm = (LAS float*)(lds + L_TM);
    LAS float* Pm = (LAS float*)(lds + L_PM);
    LAS float* gcs = (LAS float*)(lds + L_GC);
    LAS float* betas = (LAS float*)(lds + L_BETA);
    const bf16_t* qkv = (const bf16_t*)(ws + WS_RA);
    const float* bg = (const float*)(ws + WS_BG);
    for (int g8 = blockIdx.x; g8 < 512; g8 += gridDim.x) {
        const int bl = g8 >> 6, h = (g8 >> 3) & 7, nbase = (g8 & 7) * 8;
        __syncthreads();
        float cwr[3][4][2];
#pragma unroll
        for (int X = 0; X < 3; ++X)
#pragma unroll
            for (int k = 0; k < 4; ++k) { const f32x2 w2 = *(const f32x2*)(p.in[7] + (size_t)k * 3072 + X * 1024 + h * 128 + 2 * lane_k); cwr[X][k][0] = w2[0]; cwr[X][k][1] = w2[1]; }
        unsigned xr[3][11];
        float gpre = 0.f, bpre = 0.f;
        auto xload = [&](int n_) {
            int ln = lane_k; asm volatile("" : "+v"(ln));
#pragma unroll
            for (int X = 0; X < 3; ++X)
#pragma unroll
                for (int j = 0; j < 11; ++j) { const int tt = n_ * 64 + 8 * wave + j - 3;
                    xr[X][j] = (tt >= 0) ? *(const unsigned*)(qkv + ((size_t)bl * 4096 + tt) * 3072 + X * 1024 + h * 128 + 2 * ln) : 0u; }
        };
        auto gload = [&](int n_) { if (wave == 0) { const size_t row = (size_t)bl * 4096 + n_ * 64 + lane_k; gpre = bg[row * 16 + 8 + h]; bpre = bg[row * 16 + h]; } };
        xload(nbase); gload(nbase);
        for (int nn = 0; nn < 8; ++nn) {
            int lane = lane_k, r32, hh; asm volatile("" : "+v"(lane));
            r32 = lane & 31; hh = lane >> 5;
            const int tid = wave * 64 + lane;
            const int n = nbase + nn;
            const int bglob = bl;
            const int ug = (bglob * 8 + h) * 64 + n;
            if (wave == 0) {
                float gv = gpre;
#pragma unroll
                for (int o = 1; o < 64; o <<= 1) { const float t = __shfl_up(gv, o); if (lane >= o) gv += t; }
                gcs[lane] = gv; betas[lane] = bpre;
            }
            if (nn + 1 < 8) gload(n + 1);
            __syncthreads();
            {
                const int tb = 8 * wave;
                const float gc_last = gcs[63];
#pragma unroll
                for (int X = 0; X < 3; ++X) {
                    float x0[11], x1[11];
#pragma unroll
                    for (int j = 0; j < 11; ++j) { x0[j] = bflo(xr[X][j]); x1[j] = bfhi(xr[X][j]); }
                    float y0[8], y1[8];
#pragma unroll
                    for (int tk = 0; tk < 8; ++tk) {
                        float a0 = 0.f, a1 = 0.f;
#pragma unroll
                        for (int k = 0; k < 4; ++k) { a0 += cwr[X][k][0] * x0[tk + k]; a1 += cwr[X][k][1] * x1[tk + k]; }
                        y0[tk] = siluf(a0); y1[tk] = siluf(a1);
                    }
                    if (X == 0) {
#pragma unroll
                        for (int tk = 0; tk < 8; ++tk) {
                            const int i = tb + tk;
                            const float rq = rsqrtf(wave_sum(y0[tk] * y0[tk] + y1[tk] * y1[tk]) + EPS) * 0.08838834764831845f;
                            const float q0 = y0[tk] * rq, q1 = y1[tk] * rq, eg = __expf(gcs[i]);
                            *(LAS unsigned*)(lds + L_QS + i * 272 + lane * 4) = cvtpk(q0, q1);
                            *(unsigned*)((bf16_t*)(ws + WS_PQD) + ((size_t)ug * 64 + i) * 128 + 2 * lane) = cvtpk(q0 * eg, q1 * eg);
                        }
                    } else if (X == 1) {
                        float b0[8], b1[8], d0[8], d1[8];
#pragma unroll
                        for (int tk = 0; tk < 8; ++tk) {
                            const int i = tb + tk;
                            const float rk = rsqrtf(wave_sum(y0[tk] * y0[tk] + y1[tk] * y1[tk]) + EPS);
                            const float k0 = y0[tk] * rk, k1 = y1[tk] * rk, gci = gcs[i];
                            const float fb = betas[i] * __expf(gci), fd = __expf(gc_last - gci);
                            *(LAS unsigned*)(lds + L_KS + i * 272 + lane * 4) = cvtpk(k0, k1);
                            b0[tk] = k0 * fb; b1[tk] = k1 * fb; d0[tk] = k0 * fd; d1[tk] = k1 * fd;
                        }
                        u32x4 w;
                        w.x = cvtpk(b0[0], b0[1]); w.y = cvtpk(b0[2], b0[3]); w.z = cvtpk(b0[4], b0[5]); w.w = cvtpk(b0[6], b0[7]); *(LAS u32x4*)(lds + L_KBGT + (2 * lane) * 144 + tb * 2) = w;
                        w.x = cvtpk(b1[0], b1[1]); w.y = cvtpk(b1[2], b1[3]); w.z = cvtpk(b1[4], b1[5]); w.w = cvtpk(b1[6], b1[7]); *(LAS u32x4*)(lds + L_KBGT + (2 * lane + 1) * 144 + tb * 2) = w;
                        w.x = cvtpk(d0[0], d0[1]); w.y = cvtpk(d0[2], d0[3]); w.z = cvtpk(d0[4], d0[5]); w.w = cvtpk(d0[6], d0[7]); *(LAS u32x4*)(lds + L_KDT + (2 * lane) * 144 + tb * 2) = w;
                        w.x = cvtpk(d1[0], d1[1]); w.y = cvtpk(d1[2], d1[3]); w.z = cvtpk(d1[4], d1[5]); w.w = cvtpk(d1[6], d1[7]); *(LAS u32x4*)(lds + L_KDT + (2 * lane + 1) * 144 + tb * 2) = w;
                    } else {
#pragma unroll
                        for (int tk = 0; tk < 8; ++tk) { const float bt = betas[tb + tk]; y0[tk] *= bt; y1[tk] *= bt; }
                        u32x4 w;
                        w.x = cvtpk(y0[0], y0[1]); w.y = cvtpk(y0[2], y0[3]); w.z = cvtpk(y0[4], y0[5]); w.w = cvtpk(y0[6], y0[7]); *(LAS u32x4*)(lds + L_VBT + (2 * lane) * 144 + tb * 2) = w;
                        w.x = cvtpk(y1[0], y1[1]); w.y = cvtpk(y1[2], y1[3]); w.z = cvtpk(y1[4], y1[5]); w.w = cvtpk(y1[6], y1[7]); *(LAS u32x4*)(lds + L_VBT + (2 * lane + 1) * 144 + tb * 2) = w;
                    }
                }
            }
            if (nn + 1 < 8) xload(n + 1);
            __syncthreads();
            {
                int lane_c = lane; asm volatile("" : "+v"(lane_c)); const int r32 = lane_c & 31, hh = lane_c >> 5;
                const int which = wave >> 2, mi = (wave >> 1) & 1, ni = wave & 1;
                f32x16 acc = zero16();
                if (!(mi == 0 && ni == 1)) {
                    const LAS unsigned char* ab = lds + (which ? L_QS : L_KS) + (32 * mi + r32) * 272 + hh * 16;
                    const LAS unsigned char* bb = lds + L_KS + (32 * ni + r32) * 272 + hh * 16;
#pragma unroll
                    for (int ks = 0; ks < 8; ++ks) acc = MFMA32(lds128(ab + ks * 32), lds128(bb + ks * 32), acc);
                }
                const int j = 32 * ni + r32; const float gcj = gcs[j];
                bf16_t* at = (bf16_t*)(ws + WS_PAT) + (size_t)ug * 4096;
#pragma unroll
                for (int reg = 0; reg < 16; ++reg) {
                    const int ii = 32 * mi + crow(reg, hh);
                    const float dec = (ii >= j) ? __expf(gcs[ii] - gcj) : 0.f;
                    if (which == 0) Lm[ii * 68 + j] = (ii > j) ? betas[ii] * acc[reg] * dec : 0.f;
                    else at[ii * 64 + j] = f2bf(acc[reg] * dec);
                }
            }
            __syncthreads();
            if (wave == 0) {
                const int a = lane >> 4, c = lane & 15;
                float mcol[16], tt[16];
#pragma unroll
                for (int ii = 0; ii < 16; ++ii) mcol[ii] = Lm[(16 * a + ii) * 68 + 16 * a + c];
                InvAll<15>::run(mcol, tt, c);
#pragma unroll
                for (int ii = 0; ii < 16; ++ii) Tm[(16 * a + ii) * 68 + 16 * a + c] = tt[ii];
            } else {
                int tid_d = tid; asm volatile("" : "+v"(tid_d));
                bf16_t* dst = (bf16_t*)(ws + WS_PKDT) + (size_t)ug * 8192;
                for (int ci = tid_d - 64; ci < 1024; ci += 448) { const int row = ci >> 3, ch = ci & 7;
                    *(u32x4*)(dst + row * 64 + ch * 8) = *(const LAS u32x4*)(lds + L_KDT + row * 144 + ch * 16); }
                if (tid_d == 64) ((float*)(ws + WS_GL))[ug] = __expf(gcs[63]);
            }
            __syncthreads();
            if (wave < 2) {
                const int aa = 2 * wave + 1, bb = 2 * wave, c = lane & 15, q = lane >> 4;
                LAS float* Pw = Pm + wave * 320;
                float acc[4] = {0.f, 0.f, 0.f, 0.f};
                mm16_acc(acc, Lm + (16 * aa) * 68 + 16 * bb, 68, Tm + (16 * bb) * 68 + 16 * bb, 68, c, q);
#pragma unroll
                for (int rr = 0; rr < 4; ++rr) Pw[(4 * q + rr) * 20 + c] = acc[rr];
                float acc2[4] = {0.f, 0.f, 0.f, 0.f};
                mm16_acc(acc2, Tm + (16 * aa) * 68 + 16 * aa, 68, Pw, 20, c, q);
#pragma unroll
                for (int rr = 0; rr < 4; ++rr) Tm[(16 * aa + 4 * q + rr) * 68 + 16 * bb + c] = -acc2[rr];
            }
            __syncthreads();
            for (int e = tid; e < 3072; e += 512) { const int which = e >> 10, ii = (e >> 5) & 31, j = e & 31;
                float v;
                if (which == 2) v = -Lm[(32 + ii) * 68 + j];
                else { const int o = 32 * which; v = ((j >> 4) > (ii >> 4)) ? 0.f : Tm[(o + ii) * 68 + o + j]; }
                *(LAS bf16_t*)(lds + L_TB + which * 2560 + ii * 80 + j * 2) = f2bf(v); }
            __syncthreads();
            {
                int lane_e = lane; asm volatile("" : "+v"(lane_e)); const int r32 = lane_e & 31, hh = lane_e >> 5;
                const int mat = wave >> 2, nb = wave & 3;
                const LAS unsigned char* xt = lds + (mat ? L_KBGT : L_VBT) + (32 * nb + r32) * 144;
                const LAS unsigned char* td0 = lds + L_TB + r32 * 80, *td1 = td0 + 2560, *nm = td0 + 5120;
                f32x16 acc0 = zero16();
#pragma unroll
                for (int ks = 0; ks < 2; ++ks) acc0 = MFMA32(lds128(td0 + hh * 16 + ks * 32), lds128(xt + hh * 16 + ks * 32), acc0);
                f32x16 acc1;
#pragma unroll
                for (int gq = 0; gq < 4; ++gq) { const u32x2 v = *(const LAS u32x2*)(xt + (32 + 8 * gq + 4 * hh) * 2);
                    acc1[4 * gq] = bflo(v[0]); acc1[4 * gq + 1] = bfhi(v[0]); acc1[4 * gq + 2] = bflo(v[1]); acc1[4 * gq + 3] = bfhi(v[1]); }
#pragma unroll
                for (int s2 = 0; s2 < 2; ++s2) acc1 = MFMA32(lds2x64(nm + hh * 8 + s2 * 32, nm + hh * 8 + s2 * 32 + 16), pack8(acc0, s2), acc1);
                f32x16 acc2 = zero16();
#pragma unroll
                for (int s2 = 0; s2 < 2; ++s2) acc2 = MFMA32(lds2x64(td1 + hh * 8 + s2 * 32, td1 + hh * 8 + s2 * 32 + 16), pack8(acc1, s2), acc2);
#pragma unroll
                for (int mi = 0; mi < 2; ++mi) {
                    const f32x16 acc = mi ? acc2 : acc0;
                    if (mat == 0) {
                        bf16_t* up = (bf16_t*)(ws + WS_PU) + ((((size_t)ug * 4 + nb) * 2 + mi) * 64 + lane_e) * 16;
                        u32x4 o0, o1;
#pragma unroll
                        for (int e = 0; e < 4; ++e) { o0[e] = cvtpk(acc[2 * e], acc[2 * e + 1]); o1[e] = cvtpk(acc[8 + 2 * e], acc[8 + 2 * e + 1]); }
                        *(u32x4*)up = o0; *(u32x4*)(up + 8) = o1;
                    } else {
                        bf16_t* wp = (bf16_t*)(ws + WS_PW) + (size_t)ug * 8192;
#pragma unroll
                        for (int reg = 0; reg < 16; ++reg) wp[(32 * mi + crow(reg, hh)) * 128 + 32 * nb + r32] = f2bf(acc[reg]);
                    }
                }
            }
            __syncthreads();
        }
    }
}

template <int PMODE> DI void p4_scan(const Params& p, LAS unsigned char* lds) {
    const int tid = otid(), lane = tid & 63, wave = __builtin_amdgcn_readfirstlane(tid >> 6);
    const int r32 = lane & 31, hh = lane >> 5;
    unsigned char* ws = p.ws;
    constexpr int ST = 59904, S_W = 0, S_QD = 16896, S_KDT = 33792, S_AT = 51200, L_OS = 2 * ST, OSB = 16896;
    static_assert(L_OS + 2 * OSB <= LDS_BYTES, "p4 lds");
    for (int bh = blockIdx.x; bh < 64; bh += gridDim.x) {
        const int b = bh >> 3, h = bh & 7;
        __syncthreads();
        if (wave >= 4) {
            const int lt_k = tid - 256;
            u32x4 rgA[14], rgB[14];
            auto issue = [&](u32x4 (&rg)[14], int n) {
                int lt = lt_k; asm volatile("" : "+v"(lt));
                const size_t ug = (size_t)bh * 64 + n;
                const bf16_t* pw = (const bf16_t*)(ws + WS_PW) + ug * 8192; const bf16_t* pq = (const bf16_t*)(ws + WS_PQD) + ug * 8192;
                const bf16_t* pk = (const bf16_t*)(ws + WS_PKDT) + ug * 8192; const bf16_t* pa = (const bf16_t*)(ws + WS_PAT) + ug * 4096;
#pragma unroll
                for (int k = 0; k < 4; ++k) { const int ci = lt + 256 * k; rg[k] = *(const u32x4*)(pw + ci * 8); rg[4 + k] = *(const u32x4*)(pq + ci * 8); rg[8 + k] = *(const u32x4*)(pk + ci * 8); }
#pragma unroll
                for (int k = 0; k < 2; ++k) { const int ci = lt + 256 * k; rg[12 + k] = *(const u32x4*)(pa + ci * 8); }
            };
            auto commit = [&](const u32x4 (&rg)[14], int st) {
                int lt = lt_k; asm volatile("" : "+v"(lt));
                LAS unsigned char* sb = lds + st * ST;
#pragma unroll
                for (int k = 0; k < 4; ++k) { const int ci = lt + 256 * k; const int row = ci >> 4, ch = ci & 15;
                    LAS u32x2* d0 = (LAS u32x2*)(sb + S_W + row * 264 + ch * 16); d0[0] = (u32x2){rg[k][0], rg[k][1]}; d0[1] = (u32x2){rg[k][2], rg[k][3]};
                    LAS u32x2* d1 = (LAS u32x2*)(sb + S_QD + row * 264 + ch * 16); d1[0] = (u32x2){rg[4 + k][0], rg[4 + k][1]}; d1[1] = (u32x2){rg[4 + k][2], rg[4 + k][3]};
                    const int row2 = ci >> 3, ch2 = ci & 7;
                    LAS u32x2* d2 = (LAS u32x2*)(sb + S_KDT + row2 * 136 + ch2 * 16); d2[0] = (u32x2){rg[8 + k][0], rg[8 + k][1]}; d2[1] = (u32x2){rg[8 + k][2], rg[8 + k][3]}; }
#pragma unroll
                for (int k = 0; k < 2; ++k) { const int ci = lt + 256 * k; const int row2 = ci >> 3, ch2 = ci & 7;
                    LAS u32x2* d3 = (LAS u32x2*)(sb + S_AT + row2 * 136 + ch2 * 16); d3[0] = (u32x2){rg[12 + k][0], rg[12 + k][1]}; d3[1] = (u32x2){rg[12 + k][2], rg[12 + k][3]}; }
            };
            auto ocopy = [&](int mstep) {
                int lt = lt_k; asm volatile("" : "+v"(lt));
                const int row = lt >> 2, part = lt & 3;
                const LAS unsigned char* ob = lds + L_OS + (mstep & 1) * OSB + row * 264 + part * 64;
                const size_t tok = (size_t)b * 4096 + mstep * 64 + row;
                bf16_t* yp = (bf16_t*)(ws + WS_RA) + tok * 1024 + h * 128 + part * 32;
#pragma unroll
                for (int e = 0; e < 4; ++e) { const u32x2 v0 = *(const LAS u32x2*)(ob + e * 16), v1 = *(const LAS u32x2*)(ob + e * 16 + 8); *(u32x4*)(yp + 8 * e) = (u32x4){v0[0], v0[1], v1[0], v1[1]}; }
            };
            issue(rgA, 0); commit(rgA, 0); issue(rgB, 1);
            __syncthreads();
            for (int n = 0; n <= 64; n += 2) {
                if (n + 2 < 64) issue(rgA, n + 2);
                if (PMODE == 0) { if (n >= 1) ocopy(n - 1); }
                if (n + 1 < 64) commit(rgB, (n + 1) & 1);
                __syncthreads();
                if (n + 1 <= 64) {
                    if (n + 3 < 64) issue(rgB, n + 3);
                    if (PMODE == 0) ocopy(n);
                    if (n + 2 < 64) commit(rgA, (n + 2) & 1);
                    __syncthreads();
                }
            }
        } else {
            const int sl = wave;
            f32x16 Sacc[4]; for (int kb = 0; kb < 4; ++kb) Sacc[kb] = zero16();
            u32x4 un[2][2]; float gln;
            auto uload = [&](int n) { const size_t ug = (size_t)bh * 64 + n;
                const bf16_t* up = (const bf16_t*)(ws + WS_PU) + (((ug * 4 + sl) * 2) * 64 + lane) * 16;
                un[0][0] = *(const u32x4*)up; un[0][1] = *(const u32x4*)(up + 8); un[1][0] = *(const u32x4*)(up + 1024); un[1][1] = *(const u32x4*)(up + 1032);
                gln = ((const float*)(ws + WS_GL))[ug]; };
            uload(0);
            __syncthreads();
            for (int n = 0; n <= 64; ++n) {
                if (n < 64 && PMODE != 1) {
                    const LAS unsigned char* sb = lds + (n & 1) * ST;
                    u32x4 uc[2][2]; uc[0][0] = un[0][0]; uc[0][1] = un[0][1]; uc[1][0] = un[1][0]; uc[1][1] = un[1][1]; const float gl = gln;
                    if (n + 1 < 64) uload(n + 1);
                    f32x16 vacc[2], qacc[2];
                    vacc[0] = zero16(); vacc[1] = zero16(); qacc[0] = zero16(); qacc[1] = zero16();
                    {
                        const LAS unsigned char* wrow = sb + S_W + r32 * 264 + hh * 8;
                        const LAS unsigned char* qrow = sb + S_QD + r32 * 264 + hh * 8;
#pragma unroll
                        for (int kb = 0; kb < 4; ++kb) {
                            bf16x8 fw[2][2], fq[2][2];
#pragma unroll
                            for (int s2 = 0; s2 < 2; ++s2)
#pragma unroll
                                for (int mi = 0; mi < 2; ++mi) { const int off = mi * 32 * 264 + (2 * kb + s2) * 32;
                                    fw[s2][mi] = lds2x64(wrow + off, wrow + off + 16); fq[s2][mi] = lds2x64(qrow + off, qrow + off + 16); }
                            const bf16x8 Sb0 = pack8(Sacc[kb], 0), Sb1 = pack8(Sacc[kb], 1);
                            __builtin_amdgcn_sched_barrier(0);
#pragma unroll
                            for (int mi = 0; mi < 2; ++mi) { vacc[mi] = MFMA32(fw[0][mi], Sb0, vacc[mi]); qacc[mi] = MFMA32(fq[0][mi], Sb0, qacc[mi]); }
#pragma unroll
                            for (int mi = 0; mi < 2; ++mi) { vacc[mi] = MFMA32(fw[1][mi], Sb1, vacc[mi]); qacc[mi] = MFMA32(fq[1][mi], Sb1, qacc[mi]); }
                        }
                    }
                    __builtin_amdgcn_sched_barrier(0);
                    bf16x8 Vb[4];
#pragma unroll
                    for (int mi = 0; mi < 2; ++mi) { f32x16 vn;
#pragma unroll
                        for (int e = 0; e < 4; ++e) { vn[2 * e] = bflo(uc[mi][0][e]) - vacc[mi][2 * e]; vn[2 * e + 1] = bfhi(uc[mi][0][e]) - vacc[mi][2 * e + 1];
                                                      vn[8 + 2 * e] = bflo(uc[mi][1][e]) - vacc[mi][8 + 2 * e]; vn[8 + 2 * e + 1] = bfhi(uc[mi][1][e]) - vacc[mi][8 + 2 * e + 1]; }
                        Vb[2 * mi] = pack8(vn, 0); Vb[2 * mi + 1] = pack8(vn, 1); }
                    {
                        bf16x8 fa[6];
                        const LAS unsigned char* arow = sb + S_AT + r32 * 136 + hh * 8;
                        fa[0] = lds2x64(arow, arow + 16); fa[1] = lds2x64(arow + 32, arow + 48);
#pragma unroll
                        for (int ks = 0; ks < 4; ++ks) fa[2 + ks] = lds2x64(arow + 32 * 136 + ks * 32, arow + 32 * 136 + ks * 32 + 16);
                        __builtin_amdgcn_sched_barrier(0);
                        qacc[0] = MFMA32(fa[0], Vb[0], qacc[0]); qacc[1] = MFMA32(fa[2], Vb[0], qacc[1]);
                        qacc[0] = MFMA32(fa[1], Vb[1], qacc[0]); qacc[1] = MFMA32(fa[3], Vb[1], qacc[1]);
                        qacc[1] = MFMA32(fa[4], Vb[2], qacc[1]); qacc[1] = MFMA32(fa[5], Vb[3], qacc[1]);
                    }
#pragma unroll
                    for (int kp = 0; kp < 2; ++kp) {
                        bf16x8 fk[2][4];
#pragma unroll
                        for (int k2 = 0; k2 < 2; ++k2)
#pragma unroll
                            for (int ks = 0; ks < 4; ++ks) { const LAS unsigned char* krow = sb + S_KDT + (32 * (2 * kp + k2) + r32) * 136 + hh * 8 + ks * 32; fk[k2][ks] = lds2x64(krow, krow + 16); }
                        f32x16 sn0 = Sacc[2 * kp] * gl, sn1 = Sacc[2 * kp + 1] * gl;
                        __builtin_amdgcn_sched_barrier(0);
#pragma unroll
                        for (int ks = 0; ks < 4; ++ks) { sn0 = MFMA32(fk[0][ks], Vb[ks], sn0); sn1 = MFMA32(fk[1][ks], Vb[ks], sn1); }
                        Sacc[2 * kp] = sn0; Sacc[2 * kp + 1] = sn1;
                    }
                    {
                        LAS bf16_t* ob = (LAS bf16_t*)(lds + L_OS + (n & 1) * OSB);
#pragma unroll
                        for (int mo = 0; mo < 2; ++mo)
#pragma unroll
                            for (int reg = 0; reg < 16; ++reg) ob[(32 * mo + crow(reg, hh)) * 132 + 32 * sl + r32] = f2bf(qacc[mo][reg]);
                    }
                }
                __syncthreads();
            }
        }
    }
}

DI void p4b_onorm(const Params& p) {
    const int tid = otid(), lane = tid & 63, wave = tid >> 6;
    bf16_t* ob = (bf16_t*)(p.ws + WS_RA);
    const bf16_t* zb = (const bf16_t*)p.out;
    const float* og = p.in[10] + (lane & 7) * 16;
    float g[16];
#pragma unroll
    for (int e = 0; e < 16; ++e) g[e] = og[e];
    const int stride = gridDim.x * 8;
    int m = blockIdx.x * 8 + wave;
    u32x4 no0, no1, nz0, nz1;
    auto ld = [&](int mm) { const bf16_t* op = ob + (size_t)mm * 1024 + lane * 16; const bf16_t* zp = zb + (size_t)mm * 1024 + lane * 16;
        no0 = *(const u32x4*)op; no1 = *(const u32x4*)(op + 8); nz0 = *(const u32x4*)zp; nz1 = *(const u32x4*)(zp + 8); };
    if (m < M) ld(m);
    for (; m < M; m += stride) {
        bf16_t* op = ob + (size_t)m * 1024 + lane * 16;
        const u32x4 o0 = no0, o1 = no1, z0 = nz0, z1 = nz1;
        if (m + stride < M) ld(m + stride);
        float ss = 0.f;
#pragma unroll
        for (int e = 0; e < 4; ++e) { const float a = bflo(o0[e]), b2 = bfhi(o0[e]), c = bflo(o1[e]), d = bfhi(o1[e]); ss += (a * a + b2 * b2) + (c * c + d * d); }
        ss += __shfl_xor(ss, 1); ss += __shfl_xor(ss, 2); ss += __shfl_xor(ss, 4);
        const float rstd = rsqrtf(ss * (1.f / 128.f) + EPS);
        u32x4 y0, y1;
#pragma unroll
        for (int e = 0; e < 4; ++e) {
            y0[e] = cvtpk(bflo(o0[e]) * rstd * g[2 * e] * siluf(bflo(z0[e])), bfhi(o0[e]) * rstd * g[2 * e + 1] * siluf(bfhi(z0[e])));
            y1[e] = cvtpk(bflo(o1[e]) * rstd * g[8 + 2 * e] * siluf(bflo(z1[e])), bfhi(o1[e]) * rstd * g[8 + 2 * e + 1] * siluf(bfhi(z1[e])));
        }
        *(u32x4*)op = y0; *(u32x4*)(op + 8) = y1;
    }
}

DI void p8_compress(const Params& p, LAS unsigned char* lds) {
    const int tid = otid(), lane = tid & 63, wave = __builtin_amdgcn_readfirstlane(tid >> 6);
    const int r32 = lane & 31, hh = lane >> 5;
    unsigned char* ws = p.ws;
    constexpr int L_AS = 0  , L_BS = 4608  , L_HS = L_BS + 36864  , L_C1 = L_HS + 16896  ;
    const bf16_t* kv = (const bf16_t*)(ws + WS_KV);
    for (int u = blockIdx.x; u < 256; u += gridDim.x) {
        const int which = u >> 7, bg = (u >> 3) & 15, nb = u & 7, b = bg >> 1, g = bg & 1;
        __syncthreads();
        if (tid < 256) { float a = 0.f; for (int kc = 0; kc < 16; ++kc) a += ((const float*)(ws + WS_C1P))[(kc * 2 + which) * 256 + tid]; ((LAS float*)(lds + L_C1))[tid] = a; }
        const bf16_t* w1t = (const bf16_t*)(ws + WS_W1T) + (size_t)which * 256 * 2048;
        f32x16 acc = zero16();
        for (int l = 0; l < 32; ++l) {
            __syncthreads();
            if (tid < 256) { const int row = tid >> 3, ch = tid & 7; int tk = 16 * (32 * nb + row) + l; tk = tk > 4095 ? 4095 : tk;
                *(LAS u32x4*)(lds + L_AS + row * 144 + ch * 16) = *(const u32x4*)(kv + ((size_t)b * 4096 + tk) * 768 + which * 128 + g * 64 + ch * 8); }
#pragma unroll
            for (int k = 0; k < 4; ++k) { const int ci = tid + 512 * k; const int row = ci >> 3, ch = ci & 7;
                *(LAS u32x4*)(lds + L_BS + row * 144 + ch * 16) = *(const u32x4*)(w1t + (size_t)row * 2048 + l * 64 + ch * 8); }
            __syncthreads();
            const LAS unsigned char* ab = lds + L_AS + r32 * 144 + hh * 16;
            const LAS unsigned char* bb = lds + L_BS + (32 * wave + r32) * 144 + hh * 16;
#pragma unroll
            for (int ks = 0; ks < 4; ++ks) acc = MFMA32(lds128(ab + ks * 32), lds128(bb + ks * 32), acc);
        }
        {
            const float c1 = ((LAS float*)(lds + L_C1))[32 * wave + r32];
#pragma unroll
            for (int reg = 0; reg < 16; ++reg) *(LAS bf16_t*)(lds + L_HS + crow(reg, hh) * 528 + (32 * wave + r32) * 2) = f2bf(siluf(acc[reg] + c1));
        }
        __syncthreads();
        if (wave < 2) {
            const bf16_t* w2t = (const bf16_t*)(ws + WS_W2T) + (size_t)(which * 64 + 32 * wave + r32) * 256 + hh * 8;
            const LAS unsigned char* ab = lds + L_HS + r32 * 528 + hh * 16;
            f32x16 o = zero16();
#pragma unroll
            for (int ks = 0; ks < 16; ++ks) o = MFMA32(lds128(ab + ks * 32), *(const bf16x8*)(w2t + ks * 16), o);
            bf16_t* dst = (bf16_t*)(ws + WS_CMP) + (size_t)(which * 16 + bg) * 256 * 64;
#pragma unroll
            for (int reg = 0; reg < 16; ++reg) { const int n = 32 * nb + crow(reg, hh); const bf16_t val = (n < 255) ? f2bf(o[reg]) : (bf16_t)0;
                if (which == 0) dst[n * 64 + 32 * wave + r32] = val; else dst[(32 * wave + r32) * 256 + n] = val; }
        }
    }
}

__device__ const unsigned char T5_BUCKET[128] = {0, 1, 2, 3, 4, 5, 6, 7, 8, 9, 10, 11, 12, 13, 14, 15, 16, 16, 16, 17, 17, 18, 18, 18, 19, 19, 19, 20, 20, 20, 20, 21, 21, 21, 21, 22, 22, 22, 22, 22, 23, 23, 23, 23, 23, 23, 24, 24, 24, 24, 24, 24, 25, 25, 25, 25, 25, 25, 25, 26, 26, 26, 26, 26, 26, 26, 26, 27, 27, 27, 27, 27, 27, 27, 27, 27, 27, 28, 28, 28, 28, 28, 28, 28, 28, 28, 28, 29, 29, 29, 29, 29, 29, 29, 29, 29, 29, 29, 29, 30, 30, 30, 30, 30, 30, 30, 30, 30, 30, 30, 30, 30, 30, 31, 31, 31, 31, 31, 31, 31, 31, 31, 31, 31, 31, 31, 31, 31};
constexpr float NEGBIG = -1e30f;

template <int PMODE> DI void p9_nsa(const Params& p, LAS unsigned char* lds) {
    const int tid0 = otid(); const int lane_k = tid0 & 63, wave = __builtin_amdgcn_readfirstlane(tid0 >> 6);
    unsigned char* ws = p.ws;
    constexpr int STG = 17920, L_K = 0, L_V = 9216, L_BT = 2 * STG, L_IA = L_BT + 4224, L_IB = L_IA + 8192, L_Y = L_IB + 8704;
    static_assert(L_Y + 65536 <= LDS_BYTES, "p9 lds");
    constexpr float LOG2E = 1.4426950408889634f;
    LAS float* YL = (LAS float*)(lds + L_Y) + wave * 2048;
    LAS float* BT = (LAS float*)(lds + L_BT);
    LAS float* IA = (LAS float*)(lds + L_IA) + wave * 256;
    LAS float* IB = (LAS float*)(lds + L_IB) + wave * 272;
    const bf16_t* kvb = (const bf16_t*)(ws + WS_KV);
    const bf16_t* cmpb = (const bf16_t*)(ws + WS_CMP);
    const bf16_t* vtb = (const bf16_t*)(ws + WS_VT);
    const bf16_t* projb = (const bf16_t*)(ws + WS_PROJB);
    const float* gates = (const float*)(ws + WS_GATES);
    const float* relb = p.in[2];
    for (int vc0 = blockIdx.x; vc0 < 256; vc0 += gridDim.x) {
        const int vc = (gridDim.x == 256) ? ((vc0 & 7) * 32 + (vc0 >> 3)) : vc0;
        const int bg = vc >> 4, kk16 = vc & 15, b = bg >> 1, g = bg & 1;
        __syncthreads();
        for (int idx = otid(); idx < 1040; idx += 512) { const int hd_ = idx / 130, e = idx - hd_ * 130;
            BT[idx] = (e == 0) ? NEGBIG : relb[(e == 129 ? 31 : (int)T5_BUCKET[e - 1]) * 16 + g * 8 + hd_] * LOG2E; }
        for (int ju = 0; ju < 8; ++ju) {
            int lane = lane_k; asm volatile("" : "+v"(lane));
            const int tid = wave * 64 + lane, r32 = lane & 31, hh = lane >> 5, tok = r32 >> 3, hd = r32 & 7;
            const int srow = tid >> 3, sch = tid & 7;
            const int ub = (ju & 1) ? (32 * (ju >> 1) + 31 - kk16) : (32 * (ju >> 1) + kk16);
            const int t0 = 32 * ub, cur = ub >> 1;
            const int tq = t0 + 4 * wave + tok, head = g * 8 + hd;
            const int tqw = t0 + 4 * wave;
            const size_t trow = (size_t)b * 4096 + tq;
            __syncthreads();
            for (int idx = lane; idx < 256; idx += 64) IA[idx] = 0.f;
            for (int idx = lane; idx < 272; idx += 64) IB[idx] = 0.f;
            const float bfar = relb[31 * 16 + head] * LOG2E;
            bf16x8 Qf[4];
#pragma unroll
            for (int ks = 0; ks < 4; ++ks) Qf[ks] = *(const bf16x8*)(projb + trow * 4096 + head * 64 + 16 * ks + 8 * hh);
            const int nct = (ub >> 5) + 1;
            const int wlo = (t0 - 511) > 0 ? ((t0 - 511) >> 6) : 0;
            const int nwin = cur - wlo + 1;
            const int NT = 2 * nct + (cur + 1) + nwin;
            u32x4 kregA, vregA, kregB, vregB;
            auto tload = [&](u32x4& kreg, u32x4& vreg, int i) {
                const bf16_t *kp, *vp; int kstride, vstride;
                if (i < 2 * nct) { const int ti = i < nct ? i : i - nct; kp = cmpb + ((size_t)(0 * 16 + bg) * 256 + 64 * ti) * 64; kstride = 64; vp = cmpb + (size_t)(1 * 16 + bg) * 256 * 64 + 64 * ti; vstride = 256; }
                else if (i < 2 * nct + cur + 1) { const int s_ = i - 2 * nct; kp = kvb + ((size_t)b * 4096 + 64 * s_) * 768 + 256 + g * 64; kstride = 768; vp = vtb + (size_t)((0 * 8 + b) * 2 + g) * 64 * 4096 + 64 * s_; vstride = 4096; }
                else { const int blk = cur - (i - 2 * nct - cur - 1); kp = kvb + ((size_t)b * 4096 + 64 * blk) * 768 + 512 + g * 64; kstride = 768; vp = vtb + (size_t)((1 * 8 + b) * 2 + g) * 64 * 4096 + 64 * blk; vstride = 4096; }
                kreg = *(const u32x4*)(kp + (size_t)srow * kstride + sch * 8); vreg = *(const u32x4*)(vp + (size_t)srow * vstride + sch * 8);
            };
            auto twrite = [&](const u32x4& kreg, const u32x4& vreg, int st) {
                *(LAS u32x4*)(lds + st * STG + L_K + srow * 144 + sch * 16) = kreg;
                LAS u32x2* vd = (LAS u32x2*)(lds + st * STG + L_V + srow * 136 + sch * 16);
                vd[0] = (u32x2){vreg[0], vreg[1]}; vd[1] = (u32x2){vreg[2], vreg[3]};
            };
            tload(kregA, vregA, 0); twrite(kregA, vregA, 0);
            if (NT > 1) tload(kregB, vregB, 1);
            __syncthreads();
            float m_run = NEGBIG, l_run = 0.f, m_c = NEGBIG, linv_c = 0.f;
            f32x16 O[2]; O[0] = zero16(); O[1] = zero16();
            unsigned long long mymask = 0ull, wmask = 0ull;
            u32x2 zpre[8]; float gpre;
            auto zfetch = [&](int br) {
                int l2 = lane; asm volatile("" : "+v"(l2)); const int hh2 = l2 >> 5;
                gpre = gates[trow * 48 + br * 16 + head];
                const bf16_t* zp = projb + trow * 4096 + 1024 + br * 1024 + head * 64;
#pragma unroll
                for (int db = 0; db < 2; ++db)
#pragma unroll
                    for (int gi = 0; gi < 4; ++gi) zpre[db * 4 + gi] = *(const u32x2*)(zp + 32 * db + 8 * gi + 4 * hh2);
            };
            zfetch(0);
            auto finalize = [&](int br, bool normalized) {
                float inv = 1.f;
                if (!normalized) { const float L = l_run + __shfl_xor(l_run, 32); inv = 1.f / fmaxf(L, 1e-30f); }
                const float gt = gpre * inv;
#pragma unroll
                for (int db = 0; db < 2; ++db)
#pragma unroll
                    for (int gi = 0; gi < 4; ++gi) { const u32x2 zv = zpre[db * 4 + gi];
                        LAS float* yl = YL + (db * 16 + 4 * gi) * 64 + lane;
                        const float c0 = gt * O[db][4 * gi + 0] * siluf(bflo(zv[0])), c1 = gt * O[db][4 * gi + 1] * siluf(bfhi(zv[0]));
                        const float c2 = gt * O[db][4 * gi + 2] * siluf(bflo(zv[1])), c3 = gt * O[db][4 * gi + 3] * siluf(bfhi(zv[1]));
                        if (br == 0) { yl[0] = c0; yl[64] = c1; yl[128] = c2; yl[192] = c3; }
                        else { yl[0] += c0; yl[64] += c1; yl[128] += c2; yl[192] += c3; } }
                O[0] = zero16(); O[1] = zero16(); m_run = NEGBIG; l_run = 0.f;
                if (br < 2) zfetch(br + 1);
            };
            auto tile_body_p = [&](auto KT, auto MD, auto PAR, const int i, const int tix) {
                constexpr int kind = decltype(KT)::value; constexpr int mode = decltype(MD)::value; constexpr int par = decltype(PAR)::value;
                if (i + 2 < NT) { if constexpr (par) tload(kregB, vregB, i + 2); else tload(kregA, vregA, i + 2); }
                const LAS unsigned char* sb = lds + (i & 1) * STG;
                const bool skip = ((kind == 2) && (((wmask >> tix) & 1ull) == 0ull)) || PMODE == 1;
                if (!skip) {
                    bf16x8 kf[8];
#pragma unroll
                    for (int kb = 0; kb < 2; ++kb)
#pragma unroll
                        for (int ks = 0; ks < 4; ++ks) kf[kb * 4 + ks] = lds128(sb + L_K + (32 * kb + r32) * 144 + hh * 16 + ks * 32);
                    __builtin_amdgcn_sched_barrier(0);
                    f32x16 st[2];
#pragma unroll
                    for (int kb = 0; kb < 2; ++kb) { st[kb] = zero16();
#pragma unroll
                        for (int ks = 0; ks < 4; ++ks) st[kb] = MFMA32(kf[kb * 4 + ks], Qf[ks], st[kb]); }
                    bf16x8 vf[8];
                    if constexpr (kind != 0) {
#pragma unroll
                        for (int db = 0; db < 2; ++db)
#pragma unroll
                            for (int ks = 0; ks < 4; ++ks) { const LAS unsigned char* vr = sb + L_V + (32 * db + r32) * 136 + hh * 8 + ks * 32; vf[db * 4 + ks] = lds2x64(vr, vr + 16); }
                    }
                    __builtin_amdgcn_sched_barrier(0);
                    const bool selected = (kind != 2) || (((mymask >> tix) & 1ull) != 0ull);
                    float mx = NEGBIG;
                    if constexpr (mode == 1) {
                        int dbase = (kind <= 1) ? (tq - 30 - 1024 * tix - 64 * hh) : (tq + 1 - 64 * tix - 4 * hh);
                        asm volatile("" : "+v"(dbase));
                        constexpr int dmul = (kind <= 1) ? 16 : 1;
                        const LAS float* btl = BT + hd * 130;
                        float man[4] = {NEGBIG, NEGBIG, NEGBIG, NEGBIG};
#pragma unroll
                        for (int kb = 0; kb < 2; ++kb)
#pragma unroll
                            for (int reg = 0; reg < 16; ++reg) {
                                const int dr_ = dbase - dmul * (32 * kb + (reg & 3) + 8 * (reg >> 2)); const int di = dr_ < 0 ? 0 : (dr_ > 129 ? 129 : dr_);
                                const float sv = st[kb][reg] + btl[di];
                                st[kb][reg] = sv; man[reg & 3] = fmaxf(man[reg & 3], sv);
                            }
                        mx = fmaxf(fmaxf(man[0], man[1]), fmaxf(man[2], man[3]));
                        if (!selected) mx = NEGBIG;
                    } else if constexpr (mode == 2) {
                        int dbase = tq - 64 * tix - 4 * hh; asm volatile("" : "+v"(dbase));
#pragma unroll
                        for (int kb = 0; kb < 2; ++kb)
#pragma unroll
                            for (int reg = 0; reg < 16; ++reg) {
                                const int dist = dbase - (32 * kb + (reg & 3) + 8 * (reg >> 2));
                                const float sv = dist < 512 ? st[kb][reg] + bfar : NEGBIG;
                                st[kb][reg] = sv; mx = fmaxf(mx, sv);
                            }
                    } else {
                        float ma[4] = {NEGBIG, NEGBIG, NEGBIG, NEGBIG};
#pragma unroll
                        for (int kb = 0; kb < 2; ++kb)
#pragma unroll
                            for (int reg = 0; reg < 16; ++reg) ma[reg & 3] = fmaxf(ma[reg & 3], st[kb][reg]);
                        mx = fmaxf(fmaxf(ma[0], ma[1]), fmaxf(ma[2], ma[3]));
                        mx = selected ? mx + bfar : NEGBIG;
                    }
                    if constexpr (kind != 1) {
                        mx = fmaxf(mx, __shfl_xor(mx, 32));
                        const float mnew = fmaxf(m_run, mx);
                        const float alpha = __builtin_amdgcn_exp2f(m_run - mnew);
                        const float msub = selected ? (mode == 0 ? mnew - bfar : mnew) : 1e30f;
                        float ls;
                        {
                            const f32x2 ms2 = {msub, msub}; f32x2 acc2[4] = {{0.f, 0.f}, {0.f, 0.f}, {0.f, 0.f}, {0.f, 0.f}};
#pragma unroll
                            for (int kb = 0; kb < 2; ++kb)
#pragma unroll
                                for (int r2 = 0; r2 < 8; ++r2) { f32x2 v = {st[kb][2 * r2], st[kb][2 * r2 + 1]}; v = v - ms2;
                                    v[0] = __builtin_amdgcn_exp2f(v[0]); v[1] = __builtin_amdgcn_exp2f(v[1]); acc2[r2 & 3] = acc2[r2 & 3] + v; st[kb][2 * r2] = v[0]; st[kb][2 * r2 + 1] = v[1]; }
                            const f32x2 t2 = (acc2[0] + acc2[1]) + (acc2[2] + acc2[3]);
                            ls = t2[0] + t2[1];
                        }
                        l_run = l_run * alpha + ls; m_run = mnew;
                        if constexpr (kind != 0) { if (__ballot(alpha != 1.f) != 0ull) { O[0] = O[0] * alpha; O[1] = O[1] * alpha; } }
                    } else {
#pragma unroll
                        for (int kb = 0; kb < 2; ++kb) {
#pragma unroll
                            for (int reg = 0; reg < 16; ++reg) st[kb][reg] = __builtin_amdgcn_exp2f(st[kb][reg] - m_c) * linv_c;
#pragma unroll
                            for (int gi = 0; gi < 4; ++gi) {
                                float a = 2.f * (st[kb][4 * gi] + st[kb][4 * gi + 1] + st[kb][4 * gi + 2]) + st[kb][4 * gi + 3], bq = st[kb][4 * gi + 3];
                                a += __shfl_xor(a, 1); a += __shfl_xor(a, 2); a += __shfl_xor(a, 4);
                                bq += __shfl_xor(bq, 1); bq += __shfl_xor(bq, 2); bq += __shfl_xor(bq, 4);
                                const int sidx = 16 * tix + 8 * kb + 2 * gi + hh;
                                if (hd == 0) { IA[tok * 64 + sidx] = a; IB[tok * 68 + sidx + 1] = bq; }
                            }
                        }
                    }
                    if constexpr (kind != 0 && PMODE != 2) {
                        bf16x8 Pf[4];
#pragma unroll
                        for (int kb = 0; kb < 2; ++kb) { Pf[2 * kb] = pack8(st[kb], 0); Pf[2 * kb + 1] = pack8(st[kb], 1); }
                        __builtin_amdgcn_sched_barrier(0);
#pragma unroll
                        for (int ks = 0; ks < 4; ++ks)
#pragma unroll
                            for (int db = 0; db < 2; ++db) O[db] = MFMA32(vf[db * 4 + ks], Pf[ks], O[db]);
                    }
                }
                __builtin_amdgcn_sched_barrier(0);
                if (i + 1 < NT) { if constexpr (par) twrite(kregA, vregA, (i + 1) & 1); else twrite(kregB, vregB, (i + 1) & 1); }
                __syncthreads();
            };
            auto tile_body = [&](auto KT, auto MD, const int i, const int tix) {
                if (i & 1) tile_body_p(KT, MD, std::integral_constant<int, 1>{}, i, tix); else tile_body_p(KT, MD, std::integral_constant<int, 0>{}, i, tix);
            };
            using IC0 = std::integral_constant<int, 0>; using IC1 = std::integral_constant<int, 1>; using IC2 = std::integral_constant<int, 2>; using IC3 = std::integral_constant<int, 3>;
            int ti = 0;
#pragma unroll 1
            for (int t = 0; t < nct; ++t, ++ti) tile_body(IC0{}, IC1{}, ti, t);
            { const float L = l_run + __shfl_xor(l_run, 32); m_c = m_run; linv_c = (tq >= 31) ? 1.f / fmaxf(L, 1e-30f) : 0.f; m_run = NEGBIG; l_run = 0.f; }
#pragma unroll 1
            for (int t = 0; t < nct; ++t, ++ti) tile_body(IC1{}, IC1{}, ti, t);
            finalize(0, true);
            {
                wmask = 0ull; mymask = 0ull;
#pragma unroll 1
                for (int tk = 0; tk < 4; ++tk) {
                    float v = IA[tk * 64 + lane] + IB[tk * 68 + lane];
                    if (lane == 0 || lane == cur || lane == cur - 1) v = 1e9f; else if (lane > cur) v = -1e9f;
                    int rank = 0;
#pragma unroll
                    for (int j = 0; j < 64; ++j) { const float vj = __builtin_bit_cast(float, __builtin_amdgcn_readlane(__builtin_bit_cast(int, v), j)); rank += ((vj > v) || (vj == v && j < lane)) ? 1 : 0; }
                    const unsigned long long mk = __ballot(rank < 16);
                    wmask |= mk; if (tok == tk) mymask = mk;
                }
            }
            const int nfar_s = (tqw - 176 >= 0) ? ((tqw - 176) >> 6) + 1 : 0;
#pragma unroll 1
            for (int t = 0; t <= cur; ++t, ++ti) { if (t < nfar_s) tile_body(IC2{}, IC0{}, ti, t); else tile_body(IC2{}, IC1{}, ti, t); }
            finalize(1, false);
#pragma unroll 1
            for (int t = 0; t < nwin; ++t, ++ti) { const int blk = cur - t;
                const bool oldw = (tqw + 3 - 64 * blk > 511), nearw = (tqw - 64 * blk - 63 < 113);
                if (oldw) tile_body(IC3{}, IC2{}, ti, blk); else if (nearw) tile_body(IC3{}, IC1{}, ti, blk); else tile_body(IC3{}, IC0{}, ti, blk); }
            finalize(2, false);
            if (PMODE != 0) continue;
            bf16_t* yp = (bf16_t*)(ws + WS_RA) + trow * 1024 + head * 64;
#pragma unroll
            for (int db = 0; db < 2; ++db)
#pragma unroll
                for (int gi = 0; gi < 4; ++gi) { const LAS float* yl = YL + (db * 16 + 4 * gi) * 64 + lane; u32x2 o; o.x = cvtpk(yl[0], yl[64]); o.y = cvtpk(yl[128], yl[192]);
                    *(u32x2*)(yp + 32 * db + 8 * gi + 4 * hh) = o; }
        }
    }
}

DI void p11_final(const Params& p) {
    const int tid = otid(), lane = tid & 63, wave = tid >> 6;
    const float* ssq = (const float*)(p.ws + WS_SSQ);
    f32x4 g4[4];
#pragma unroll
    for (int j = 0; j < 4; ++j) g4[j] = *((const f32x4*)p.in[22] + lane + 64 * j);
    const int stride = gridDim.x * 8;
    int m = blockIdx.x * 8 + wave;
    f32x4 vn[4]; float sn = 0.f;
    auto ld = [&](int mm) { f32x4* xr = (f32x4*)(p.out + (size_t)mm * 1024) + lane;
#pragma unroll
        for (int j = 0; j < 4; ++j) vn[j] = xr[64 * j];
        sn = (lane < 16) ? ssq[(size_t)lane * M + mm] : 0.f; };
    if (m < M) ld(m);
    for (; m < M; m += stride) {
        f32x4 v[4]; for (int j = 0; j < 4; ++j) v[j] = vn[j]; float s = sn;
        if (m + stride < M) ld(m + stride);
        s += __shfl_xor(s, 1); s += __shfl_xor(s, 2); s += __shfl_xor(s, 4); s += __shfl_xor(s, 8);
        s = __shfl(s, 0);
        const float rstd = rsqrtf(s * (1.f / 1024.f) + EPS);
        f32x4* xr = (f32x4*)(p.out + (size_t)m * 1024) + lane;
#pragma unroll
        for (int j = 0; j < 4; ++j) xr[64 * j] = v[j] * rstd * g4[j];
    }
}

template <int PH> DI void run_phase(const Params& p, LAS unsigned char* lds) {
    unsigned char* ws = p.ws;
    const int G = gridDim.x;
    bf16_t* h0 = (bf16_t*)((unsigned char*)p.out + 64 * MiB);
    if constexpr (PH == 0) p0_prologue<0>(p, lds, 0, (int)gridDim.x);
    if constexpr (PH == 1) norm_rows<0>(p, lds);
    if constexpr (PH == 2) {
        pg8::Gemm g{h0, h0, 0, (const bf16_t*)(ws + WS_WA), M, 4096, 1024}; pg8::StaticOrder S; S.init(M, 4096, G, (int)blockIdx.x);
        EpiA E{(bf16_t*)(ws + WS_RA), (bf16_t*)p.out, 0};
        pg8::gemm_phase<EpiA, true>(lds, g, S, E);
    }
    if constexpr (PH == 3) p3_prep(p, lds);
    if constexpr (PH == 6) { if (gridDim.x > 64) p0_prologue<1>(p, lds, 64, (int)gridDim.x - 64); else p0_prologue<1>(p, lds, 0, (int)gridDim.x); p4_scan<0>(p, lds); }
    if constexpr (PH == 14) p4b_onorm(p);
    if constexpr (PH == 100) p4_scan<1>(p, lds);
    if constexpr (PH == 101) p4_scan<2>(p, lds);
    if constexpr (PH == 7) {
        const bf16_t* ya = (const bf16_t*)(ws + WS_RA);
        pg8::Gemm g{ya, ya, 0, (const bf16_t*)(ws + WS_WAO), M, 1024, 1024}; pg8::StaticOrder S; S.init(M, 1024, G, (int)blockIdx.x);
        EpiRes<false> E{p.in[0], p.out, (const float*)(ws + WS_MOD), nullptr};
        pg8::gemm_phase<EpiRes<false>, true>(lds, g, S, E);
    }
    if constexpr (PH == 8) norm_rows<1>(p, lds);
    if constexpr (PH == 9) {
        pg8::Gemm g{(const bf16_t*)(ws + WS_S), (const bf16_t*)(ws + WS_RA), 3, (const bf16_t*)(ws + WS_WCAT), M, 5120, 1024}; pg8::StaticOrder S; S.init(M, 5120, G, (int)blockIdx.x);
        EpiB E{(bf16_t*)(ws + WS_KV), (bf16_t*)(ws + WS_PROJB), (float*)(ws + WS_GATES), (bf16_t*)(ws + WS_VT)};
        pg8::gemm_phase<EpiB, true>(lds, g, S, E);
    }
    if constexpr (PH == 10) p8_compress(p, lds);
    if constexpr (PH == 11) p9_nsa<0>(p, lds);
    if constexpr (PH == 110) p9_nsa<1>(p, lds);
    if constexpr (PH == 111) p9_nsa<2>(p, lds);
    if constexpr (PH == 12) {
        const bf16_t* yb = (const bf16_t*)(ws + WS_RA);
        pg8::Gemm g{yb, yb, 0, (const bf16_t*)(ws + WS_WBO), M, 1024, 1024}; pg8::StaticOrder S; S.init(M, 1024, G, (int)blockIdx.x);
        EpiRes<true> E{p.out, p.out, (const float*)(ws + WS_MOD) + 8 * 3072, (float*)(ws + WS_SSQ)};
        pg8::gemm_phase<EpiRes<true>, true>(lds, g, S, E);
    }
    if constexpr (PH == 13) p11_final(p);
}
#if MK_ONE_LAUNCH
__global__ void __launch_bounds__(512, 2) fwd_kernel(Params p) {
    extern __shared__ __attribute__((aligned(16))) unsigned char lds_raw[];
    LAS unsigned char* lds = (LAS unsigned char*)lds_raw;
    volatile LAS unsigned* misc = (volatile LAS unsigned*)(lds + LDS_BYTES - 64);
    if (threadIdx.x < 16) misc[threadIdx.x] = 0u;
    __syncthreads();
    XcdBarrier bar = xcd_barrier_post((unsigned*)(p.ws + WS_CTL) + 1024, misc);
    run_phase<0>(p, lds); xcd_barrier(bar); if (DUP_MASK & (1 << 0)) { run_phase<0>(p, lds); xcd_barrier(bar); }
    run_phase<1>(p, lds); xcd_barrier(bar); if (DUP_MASK & (1 << 1)) { run_phase<1>(p, lds); xcd_barrier(bar); }
    run_phase<2>(p, lds); xcd_barrier(bar); if (DUP_MASK & (1 << 2)) { run_phase<2>(p, lds); xcd_barrier(bar); }
    run_phase<3>(p, lds); xcd_barrier(bar); if (DUP_MASK & (1 << 3)) { run_phase<3>(p, lds); xcd_barrier(bar); }
    run_phase<6>(p, lds); xcd_barrier(bar); if (DUP_MASK & (1 << 6)) { run_phase<6>(p, lds); xcd_barrier(bar); }
#if defined(PROBE_SCAN)
    run_phase<PROBE_SCAN>(p, lds); xcd_barrier(bar);
#endif
    run_phase<14>(p, lds); xcd_barrier(bar);
    run_phase<7>(p, lds); xcd_barrier(bar); if (DUP_MASK & (1 << 7)) { run_phase<7>(p, lds); xcd_barrier(bar); }
    run_phase<8>(p, lds); xcd_barrier(bar); if (DUP_MASK & (1 << 8)) { run_phase<8>(p, lds); xcd_barrier(bar); }
    run_phase<9>(p, lds); xcd_barrier(bar); if (DUP_MASK & (1 << 9)) { run_phase<9>(p, lds); xcd_barrier(bar); }
    run_phase<10>(p, lds); xcd_barrier(bar); if (DUP_MASK & (1 << 10)) { run_phase<10>(p, lds); xcd_barrier(bar); }
    run_phase<11>(p, lds); xcd_barrier(bar); if (DUP_MASK & (1 << 11)) { run_phase<11>(p, lds); xcd_barrier(bar); }
#if defined(PROBE_NSA)
    run_phase<PROBE_NSA>(p, lds); xcd_barrier(bar);
#endif
    run_phase<12>(p, lds); xcd_barrier(bar); if (DUP_MASK & (1 << 12)) { run_phase<12>(p, lds); xcd_barrier(bar); }
    run_phase<13>(p, lds);
}
#else
template <int PH> __global__ void __launch_bounds__(512, 2) phase_kernel(Params p) {
    extern __shared__ __attribute__((aligned(16))) unsigned char lds_raw[];
    run_phase<PH>(p, (LAS unsigned char*)lds_raw);
}
template <int PH> static void launch_phase(const Params& a, int grid, hipStream_t stream) {
    static bool attr = false;
    if (!attr) { (void)hipFuncSetAttribute((const void*)phase_kernel<PH>, hipFuncAttributeMaxDynamicSharedMemorySize, LDS_BYTES); attr = true; }
    hipLaunchKernelGGL(phase_kernel<PH>, dim3(grid), dim3(512), LDS_BYTES, stream, a);
}
#endif

extern "C" void kernel_launch(void* const* d_in, const int* in_sizes, int n_in, void* d_out, int out_size, void* d_ws, size_t ws_size, hipStream_t stream) {
    static int grid = 0;
    if (grid == 0) {
        if (n_in != 23 || out_size != M * D || ws_size < WS_END) { fprintf(stderr, "kernel_launch: unexpected shapes (n_in %d out %d ws %zu)\n", n_in, out_size, ws_size); grid = -1; return; }
        int dev = 0, cus = 0;
        if (hipGetDevice(&dev) != hipSuccess || hipDeviceGetAttribute(&cus, hipDeviceAttributeMultiprocessorCount, dev) != hipSuccess) { grid = -1; return; }
#if MK_ONE_LAUNCH
        if (hipFuncSetAttribute((const void*)fwd_kernel, hipFuncAttributeMaxDynamicSharedMemorySize, LDS_BYTES) != hipSuccess) { fprintf(stderr, "kernel_launch: hipFuncSetAttribute failed\n"); grid = -1; return; }
        int per_cu = 0;
        if (hipOccupancyMaxActiveBlocksPerMultiprocessor(&per_cu, (const void*)fwd_kernel, 512, LDS_BYTES) != hipSuccess || per_cu < 1) fprintf(stderr, "kernel_launch: occupancy query says %d\n", per_cu);
        (void)hipGetLastError();
#endif
        grid = cus;
    }
    if (grid < 0) return;
    Params a{};
    for (int i = 0; i < 23; ++i) a.in[i] = (const float*)d_in[i];
    a.out = (float*)d_out; a.ws = (unsigned char*)d_ws;
    a.ph_lo = 0; a.ph_hi = NPH;
#if MK_ONE_LAUNCH
    hipMemsetAsync((char*)d_ws + WS_CTL, 0, 65536, stream);
    hipLaunchKernelGGL(fwd_kernel, dim3(grid), dim3(512), LDS_BYTES, stream, a);
#else
    launch_phase<0>(a, grid, stream); launch_phase<1>(a, grid, stream); launch_phase<2>(a, grid, stream); launch_phase<3>(a, grid, stream);
    launch_phase<6>(a, grid, stream); launch_phase<14>(a, grid, stream); launch_phase<7>(a, grid, stream);
    launch_phase<8>(a, grid, stream); launch_phase<9>(a, grid, stream); launch_phase<10>(a, grid, stream); launch_phase<11>(a, grid, stream);
    launch_phase<12>(a, grid, stream); launch_phase<13>(a, grid, stream);
#endif
}
```

```cpp
#include <hip/hip_runtime.h>
#include <cstdio>
#include <cstdint>
#include <type_traits>

#define DI __device__ __forceinline__
#define LAS __attribute__((address_space(3)))
typedef unsigned short bf16_t;
typedef short bf16x8 __attribute__((ext_vector_type(8)));
typedef short s16x4 __attribute__((ext_vector_type(4)));
typedef float f32x4 __attribute__((ext_vector_type(4)));
typedef float f32x2 __attribute__((ext_vector_type(2)));
typedef float f32x16 __attribute__((ext_vector_type(16)));
typedef unsigned u32x4 __attribute__((ext_vector_type(4)));
typedef unsigned u32x2 __attribute__((ext_vector_type(2)));
typedef __bf16 bf16x2_t __attribute__((ext_vector_type(2)));

#ifndef DUP_MASK
#define DUP_MASK 0
#endif
#ifndef MK_ONE_LAUNCH
#define MK_ONE_LAUNCH 1
#endif

constexpr int NB = 8, T = 4096, D = 1024, M = NB * T;
constexpr int A_LD = 4112, B_LD = 4144;
constexpr float EPS = 1e-6f;
constexpr int NPH = 14;

constexpr size_t MiB = 1u << 20;
constexpr size_t WS_CTL = 0;
constexpr size_t WS_MODP = 1 * MiB;
constexpr size_t WS_WA = 4 * MiB;
constexpr size_t WS_WAO = 12 * MiB;
constexpr size_t WS_C1P = 14 * MiB;
constexpr size_t WS_MOD = 14 * MiB + 65536;
constexpr size_t WS_SSQ = 15 * MiB;
constexpr size_t WS_BG = 17 * MiB;
constexpr size_t WS_GL = 19 * MiB;
constexpr size_t WS_RA = 20 * MiB;
constexpr size_t WS_RP = 212 * MiB;
constexpr size_t WS_PW = WS_RP;
constexpr size_t WS_PQD = WS_RP + 64 * MiB;
constexpr size_t WS_PKDT = WS_RP + 128 * MiB;
constexpr size_t WS_PU = WS_RP + 192 * MiB;
constexpr size_t WS_PAT = WS_RP + 256 * MiB;
constexpr size_t WS_VT = 84 * MiB;
constexpr size_t WS_KV = 100 * MiB;
constexpr size_t WS_WCAT = 148 * MiB;
constexpr size_t WS_WBO = 158 * MiB;
constexpr size_t WS_W1T = 160 * MiB;
constexpr size_t WS_W2T = 162 * MiB;
constexpr size_t WS_GATES = 163 * MiB;
constexpr size_t WS_S = 169 * MiB;
constexpr size_t WS_CMP = 233 * MiB;
constexpr size_t WS_PROJB = 256 * MiB;
constexpr size_t WS_END = 512 * MiB;

constexpr int LDS_BYTES = 163840;

DI unsigned cvtpk(float lo, float hi) { f32x2 v = {lo, hi}; bf16x2_t b = __builtin_convertvector(v, bf16x2_t); return __builtin_bit_cast(unsigned, b); }
DI bf16_t f2bf(float f) { return (bf16_t)(cvtpk(f, 0.f) & 0xffffu); }
DI float bf2f(bf16_t v) { return __uint_as_float((unsigned)v << 16); }
DI float bflo(unsigned u) { return __uint_as_float(u << 16); }
DI float bfhi(unsigned u) { return __uint_as_float(u & 0xffff0000u); }
DI float sigm(float x) { return __builtin_amdgcn_rcpf(1.f + __builtin_amdgcn_exp2f(-1.4426950408889634f * x)); }
DI float siluf(float x) { return x * sigm(x); }
DI float wave_sum(float v) {
#pragma unroll
    for (int o = 1; o < 64; o <<= 1) v += __shfl_xor(v, o);
    return v;
}
DI int crow(int reg, int h) { return (reg & 3) + 8 * (reg >> 2) + 4 * h; }
#define MFMA32(a, b, c) __builtin_amdgcn_mfma_f32_32x32x16_bf16((a), (b), (c), 0, 0, 0)
DI bf16x8 pack8(const f32x16& x, const int s) {
    u32x4 p;
    p[0] = cvtpk(x[8 * s + 0], x[8 * s + 1]); p[1] = cvtpk(x[8 * s + 2], x[8 * s + 3]);
    p[2] = cvtpk(x[8 * s + 4], x[8 * s + 5]); p[3] = cvtpk(x[8 * s + 6], x[8 * s + 7]);
    return __builtin_bit_cast(bf16x8, p);
}
DI bf16x8 lds128(const LAS unsigned char* p) { return *(const LAS bf16x8*)p; }
DI bf16x8 lds2x64(const LAS unsigned char* lo, const LAS unsigned char* hi) {
    const s16x4 a = *(const LAS s16x4*)lo, b = *(const LAS s16x4*)hi;
    return __builtin_shufflevector(a, b, 0, 1, 2, 3, 4, 5, 6, 7);
}
DI int otid() { int t = threadIdx.x; asm volatile("" : "+v"(t)); return t; }
DI f32x16 zero16() { f32x16 z; for (int i = 0; i < 16; ++i) z[i] = 0.f; return z; }

struct Params { const float* in[23]; float* out; unsigned char* ws; int ph_lo, ph_hi, pad0, pad1; };

#define XB_TMO      128
#define XB_XCNT(j)  (256  + 64 * (j))
#define XB_XSUB(j)  (1280 + 64 * (j))
#define XB_XGEN(j)  (2304 + 64 * (j))
#define XB_TOP      3328
#define XB_TOPGEN   3392
#define XCD_BAR_WORDS 3456
#define XB_SPIN_CAP (1u << 22)
DI unsigned xb_ld(unsigned* p)              { return __hip_atomic_load(p, __ATOMIC_RELAXED, __HIP_MEMORY_SCOPE_AGENT); }
DI unsigned xb_add(unsigned* p, unsigned v) { return __hip_atomic_fetch_add(p, v, __ATOMIC_RELAXED, __HIP_MEMORY_SCOPE_AGENT); }
DI unsigned xb_xcc_id() { return (unsigned)__builtin_amdgcn_s_getreg((3 << 11) | 20) & 0xFu; }
#define XB_SPIN(cond, bar) do { unsigned _sp = 0; while (cond) { __builtin_amdgcn_s_sleep(1); \
    if ((++_sp & 255u) == 0u) { if (xb_ld(&(bar)[XB_TMO])) break; if (_sp > XB_SPIN_CAP) { atomicAdd(&(bar)[XB_TMO], 1u); break; } } } } while (0)
struct XcdBarrier { unsigned* bar; unsigned x; volatile LAS unsigned* st; };
DI XcdBarrier xcd_barrier_post(unsigned* bar, volatile LAS unsigned* st) {
    XcdBarrier b; b.bar = bar; b.x = xb_xcc_id(); b.st = st;
    if (threadIdx.x == 0) (void)xb_add(&bar[XB_XCNT(b.x)], 1u);
    return b;
}
DI void xcd_barrier_complete(unsigned* bar, unsigned x, unsigned& nloc, unsigned& nx) {
    const unsigned G = gridDim.x * gridDim.y * gridDim.z;
    unsigned sum, cnt, mine, sp = 0u;
    for (;;) {
        sum = 0u; cnt = 0u; mine = 0u;
#pragma unroll
        for (unsigned j = 0; j < 16; ++j) { const unsigned c = xb_ld(&bar[XB_XCNT(j)]); sum += c; cnt += (c > 0u) ? 1u : 0u; mine = (j == x) ? c : mine; }
        if (sum == G) break;
        __builtin_amdgcn_s_sleep(1);
        if ((++sp & 255u) == 0u) { if (xb_ld(&bar[XB_TMO])) break; if (sp > XB_SPIN_CAP) { atomicAdd(&bar[XB_TMO], 1u); break; } }
    }
    nloc = mine > 0u ? mine : 1u; nx = cnt > 0u ? cnt : 1u;
}
DI void xcd_barrier(const XcdBarrier& b) {
    asm volatile("s_waitcnt vmcnt(0)" ::: "memory");
    __syncthreads();
    if (threadIdx.x == 0) {
        unsigned* bar = b.bar;
        __builtin_amdgcn_s_waitcnt(0);
        unsigned nloc = b.st[0], nx = b.st[1];
        if (nloc == 0u) { xcd_barrier_complete(bar, b.x, nloc, nx); b.st[0] = nloc; b.st[1] = nx; }
        const unsigned old = xb_add(&bar[XB_XSUB(b.x)], 1u);
        const unsigned gen = old / nloc;
        if (old + 1u == (gen + 1u) * nloc) {
            __builtin_amdgcn_fence(__ATOMIC_RELEASE, "agent");
            asm volatile("s_waitcnt vmcnt(0)" ::: "memory");
            const unsigned og = xb_add(&bar[XB_TOP], 1u);
            const unsigned tg = og / nx;
            if (og + 1u == (tg + 1u) * nx) xb_add(&bar[XB_TOPGEN], 1u);
            else XB_SPIN(xb_ld(&bar[XB_TOPGEN]) == tg, bar);
            __builtin_amdgcn_fence(__ATOMIC_ACQUIRE, "agent");
            xb_add(&bar[XB_XGEN(b.x)], 1u);
            asm volatile("s_waitcnt vmcnt(0)" ::: "memory");
        } else {
            XB_SPIN(xb_ld(&bar[XB_XGEN(b.x)]) == gen, bar);
            __builtin_amdgcn_fence(__ATOMIC_ACQUIRE, "agent");
            asm volatile("s_waitcnt vmcnt(0)" ::: "memory");
        }
    }
    __syncthreads();
}

namespace pg8 {
constexpr int BM = 256, BK = 64, HALF = 128, HTB = HALF * BK * 2, STAGE_BYTES = 8 * HTB, NXCD = 8, WGM = 8;
DI int lds_byte(int r, int c) { const int st = (r >> 4) * 2 + (c >> 5), rr = r & 15, cc = c & 31, ob = rr * 64 + cc * 2; return st * 1024 + (ob ^ (((ob >> 9) & 1) << 5)); }
DI void stage_rc(int b, int& R, int& C) { const int st = b / 1024, sb = b % 1024, swz = sb ^ (((sb >> 9) & 1) << 5); R = (st >> 1) * 16 + swz / 64; C = (st & 1) * 32 + (swz % 64) / 2; }
DI int perm32(int rho) { const int n = rho >> 4, i = rho & 15; return 8 * (i >> 2) + 4 * n + (i & 3); }
struct Unit { int pm, pn; };
struct Gemm { const bf16_t* A0; const bf16_t* A1; int split; const bf16_t* Bt; int M, N, K; };
struct StaticOrder {
    int nM, nN, nwg, G, c;
    DI void init(int M_, int N_, int G_, int c_) { nM = M_ / BM; nN = N_ / BM; nwg = nM * nN; G = G_; c = c_; }
    DI bool next(int i, Unit& u) const {
        const long L = (long)i * G + c; if (L >= nwg) return false;
        int wgid = (int)L; { const int q = nwg / NXCD, r = nwg % NXCD, xcd = wgid % NXCD, off = wgid / NXCD; wgid = (xcd < r ? xcd * (q + 1) : r * (q + 1) + (xcd - r) * q) + off; }
        const int nig = WGM * nN, gid = wgid / nig, fm = gid * WGM, gsz = (nM - fm) < WGM ? (nM - fm) : WGM;
        u.pm = fm + ((wgid % nig) % gsz); u.pn = (wgid % nig) / gsz; return true;
    }
};
template <class Epi, bool ALIGN_EPI>
DI void gemm_phase(LAS unsigned char* lds, const Gemm g, const StaticOrder& S, const Epi& E) {
    const int tid = otid(), wid = __builtin_amdgcn_readfirstlane(tid >> 6), lane = tid & 63, wr = wid >> 2, wc = wid & 3, fr = lane & 15, fq = lane >> 4;
    const int K = g.K, nt = K / BK;
    unsigned voffA[2], voffB[2];
#pragma unroll
    for (int i = 0; i < 2; ++i) { int R, C; stage_rc(tid * 16 + i * 8192, R, C); const int Rb = Epi::PERM ? ((R & ~31) + perm32(R & 31)) : R;
        voffA[i] = (unsigned)(R * K + C) * 2u; voffB[i] = (unsigned)(Rb * K + C) * 2u; }
    const size_t kstep = (size_t)(BK * 2);
    const size_t hstep = (size_t)HALF * K * 2;
    const size_t tstep = 2 * hstep;
    const unsigned ldsw = (unsigned)wid * 1024u;
    const int aoff = lds_byte(wr * 64 + fr, fq * 8), boff = lds_byte(wc * 32 + fr, fq * 8);
#define PG8_SA(b, h) (((b) * 2 + (h)) * HTB)
#define PG8_SB(b, h) ((4 + (b) * 2 + (h)) * HTB)
#define PG8_STAGE(bufoff, gbase, voff) do { _Pragma("unroll") for (int _i = 0; _i < 2; ++_i) \
        __builtin_amdgcn_global_load_lds((const unsigned*)((const char*)(gbase) + (voff)[_i]), (LAS unsigned*)(lds + (bufoff) + ldsw + _i * 8192), 16, 0, 0); } while (0)
#define PG8_LDA(dst, b, h) do { _Pragma("unroll") for (int m = 0; m < 4; ++m) _Pragma("unroll") for (int k = 0; k < 2; ++k) dst[m][k] = *(const LAS bf16x8*)(lds + PG8_SA(b, h) + aoff + m * 2048 + k * 1024); } while (0)
#define PG8_LDB(dst, b, h) do { _Pragma("unroll") for (int n = 0; n < 2; ++n) _Pragma("unroll") for (int k = 0; k < 2; ++k) dst[n][k] = *(const LAS bf16x8*)(lds + PG8_SB(b, h) + boff + n * 2048 + k * 1024); } while (0)
#define PG8_MMA(ai, bj, At, Bt) do { __builtin_amdgcn_s_setprio(1); _Pragma("unroll") for (int m = 0; m < 4; ++m) _Pragma("unroll") for (int n = 0; n < 2; ++n) _Pragma("unroll") for (int k = 0; k < 2; ++k) \
        acc[ai][bj][m][n] = __builtin_amdgcn_mfma_f32_16x16x32_bf16(Bt[n][k], At[m][k], acc[ai][bj][m][n], 0, 0, 0); __builtin_amdgcn_s_setprio(0); } while (0)
#define PG8_WAIT_V(n) asm volatile("s_waitcnt vmcnt(" #n ")" ::: "memory")
#define PG8_WAIT_L(n) asm volatile("s_waitcnt lgkmcnt(" #n ")" ::: "memory")
#define PG8_BAR __builtin_amdgcn_s_barrier()
#define PG8_SCHED __builtin_amdgcn_sched_barrier(0)
    Unit cur, nxt; int ui = 0;
    if (!S.next(0, cur)) return;
    f32x4 acc[2][2][4][2];
#pragma unroll
    for (int a = 0; a < 2; ++a)
#pragma unroll
        for (int b = 0; b < 2; ++b)
#pragma unroll
            for (int m = 0; m < 4; ++m)
#pragma unroll
                for (int n = 0; n < 2; ++n) acc[a][b][m][n] = (f32x4){0.f, 0.f, 0.f, 0.f};
    bf16x8 At[4][2], B0[2][2], B1[2][2];
    const char* cA = (const char*)(cur.pn < g.split ? g.A0 : g.A1) + (size_t)cur.pm * tstep; const char* cB = (const char*)g.Bt + (size_t)cur.pn * tstep;
    PG8_STAGE(PG8_SB(0, 0), cB, voffB); PG8_STAGE(PG8_SB(0, 1), cB + hstep, voffB); PG8_STAGE(PG8_SA(0, 0), cA, voffA); PG8_STAGE(PG8_SA(0, 1), cA + hstep, voffA);
    if (wr == 1) PG8_BAR;
    PG8_WAIT_V(2); PG8_BAR;
    PG8_STAGE(PG8_SB(1, 0), cB + kstep, voffB); PG8_STAGE(PG8_SA(1, 0), cA + kstep, voffA); PG8_STAGE(PG8_SB(1, 1), cB + hstep + kstep, voffB);
    PG8_WAIT_V(6); PG8_BAR;
    for (;;) {
        const bool has_next = S.next(ui + 1, nxt);
        const char* nA = has_next ? (const char*)(nxt.pn < g.split ? g.A0 : g.A1) + (size_t)nxt.pm * tstep : cA; const char* nB = has_next ? (const char*)g.Bt + (size_t)nxt.pn * tstep : cB;
        for (int t = 0; t < nt; t += 2) {
            const bool last = (t == nt - 2);
            const char* a1 = cA + (size_t)(t + 1) * kstep;
            const char* a2 = last ? nA : cA + (size_t)(t + 2) * kstep; const char* b2 = last ? nB : cB + (size_t)(t + 2) * kstep;
            const char* a3 = a2 + kstep; const char* b3 = b2 + kstep;
            PG8_LDB(B0, 0, 0); PG8_LDB(B1, 0, 1); PG8_SCHED; PG8_LDA(At, 0, 0); PG8_STAGE(PG8_SA(1, 1), a1 + hstep, voffA);
            PG8_WAIT_V(8); PG8_WAIT_L(0); PG8_BAR; PG8_MMA(0, 0, At, B0); PG8_MMA(0, 1, At, B1); PG8_BAR; PG8_SCHED;
            PG8_LDA(At, 0, 1); PG8_STAGE(PG8_SB(0, 0), b2, voffB); PG8_STAGE(PG8_SB(0, 1), b2 + hstep, voffB); PG8_STAGE(PG8_SA(0, 0), a2, voffA);
            PG8_WAIT_V(8); PG8_WAIT_L(0); PG8_BAR; PG8_MMA(1, 0, At, B0); PG8_MMA(1, 1, At, B1); PG8_BAR; PG8_SCHED;
            PG8_LDB(B0, 1, 0); PG8_LDB(B1, 1, 1); PG8_SCHED; PG8_LDA(At, 1, 0); PG8_STAGE(PG8_SA(0, 1), a2 + hstep, voffA);
            PG8_WAIT_V(8); PG8_WAIT_L(0); PG8_BAR; PG8_MMA(0, 0, At, B0); PG8_MMA(0, 1, At, B1); PG8_BAR; PG8_SCHED;
            PG8_LDA(At, 1, 1); PG8_STAGE(PG8_SB(1, 0), b3, voffB); PG8_STAGE(PG8_SB(1, 1), b3 + hstep, voffB); PG8_STAGE(PG8_SA(1, 0), a3, voffA);
            PG8_WAIT_V(8); PG8_WAIT_L(0); PG8_BAR; PG8_MMA(1, 0, At, B0); PG8_MMA(1, 1, At, B1); PG8_BAR; PG8_SCHED;
        }
        if constexpr (ALIGN_EPI) { if (wr == 0) PG8_BAR; }
        E(acc, cur, wr, wc, fr, fq);
        if (!has_next) break;
#pragma unroll
        for (int a = 0; a < 2; ++a)
#pragma unroll
            for (int b = 0; b < 2; ++b)
#pragma unroll
                for (int m = 0; m < 4; ++m)
#pragma unroll
                    for (int n = 0; n < 2; ++n) acc[a][b][m][n] = (f32x4){0.f, 0.f, 0.f, 0.f};
        cur = nxt; cA = nA; cB = nB; ++ui;
        if constexpr (ALIGN_EPI) { if (wr == 1) PG8_BAR; }
    }
    PG8_WAIT_V(0);
    if constexpr (!ALIGN_EPI) { if (wr == 0) PG8_BAR; }
    PG8_BAR;
#undef PG8_SA
#undef PG8_SB
#undef PG8_STAGE
#undef PG8_LDA
#undef PG8_LDB
#undef PG8_MMA
#undef PG8_WAIT_V
#undef PG8_WAIT_L
#undef PG8_BAR
#undef PG8_SCHED
}
}

struct EpiA {
    static constexpr bool PERM = true;
    bf16_t* qkv; bf16_t* z; int row_off;
    DI void operator()(const f32x4 (&acc)[2][2][4][2], const pg8::Unit& u, int wr, int wc, int fr, int fq) const {
        const int row0 = u.pm * 256 + wr * 64 + fr; const int ct = u.pn * 256 + wc * 32 + 8 * fq;
        bf16_t* base; int ldc, col0;
        if (u.pn < 12) { base = qkv + (size_t)row0 * 3072; ldc = 3072; col0 = ct; } else { base = z + (size_t)(row_off + row0) * 1024; ldc = 1024; col0 = ct - 3072; }
#pragma unroll
        for (int ai = 0; ai < 2; ++ai)
#pragma unroll
            for (int m = 0; m < 4; ++m) { bf16_t* rowp = base + (size_t)(ai * 128 + m * 16) * ldc + col0;
#pragma unroll
                for (int bj = 0; bj < 2; ++bj) { const f32x4 v0 = acc[ai][bj][m][0], v1 = acc[ai][bj][m][1];
                    u32x4 w; w.x = cvtpk(v0[0], v0[1]); w.y = cvtpk(v0[2], v0[3]); w.z = cvtpk(v1[0], v1[1]); w.w = cvtpk(v1[2], v1[3]);
                    *(u32x4*)(rowp + bj * 128) = w; } }
    }
};
template <bool SSQ> struct EpiRes {
    static constexpr bool PERM = false;
    const float* base; float* out; const float* gate  ; float* ssq;
    DI void operator()(const f32x4 (&acc)[2][2][4][2], const pg8::Unit& u, int wr, int wc, int fr, int fq) const {
        const int col0 = u.pn * 256 + wc * 32 + 4 * fq; const int b = (u.pm * 256) >> 12;
        f32x4 gv[2][2];
#pragma unroll
        for (int bj = 0; bj < 2; ++bj)
#pragma unroll
            for (int n = 0; n < 2; ++n) gv[bj][n] = *(const f32x4*)(gate + (size_t)b * 3072 + 2048 + col0 + bj * 128 + n * 16);
#pragma unroll
        for (int ai = 0; ai < 2; ++ai)
#pragma unroll
            for (int m = 0; m < 4; ++m) { const int r = u.pm * 256 + ai * 128 + wr * 64 + m * 16 + fr; const size_t off = (size_t)r * 1024 + col0; float ss = 0.f;
#pragma unroll
                for (int bj = 0; bj < 2; ++bj)
#pragma unroll
                    for (int n = 0; n < 2; ++n) { const f32x4 bs = *(const f32x4*)(base + off + bj * 128 + n * 16); const f32x4 o = bs + gv[bj][n] * acc[ai][bj][m][n];
                        *(f32x4*)(out + off + bj * 128 + n * 16) = o; if (SSQ) ss += (o[0] * o[0] + o[1] * o[1]) + (o[2] * o[2] + o[3] * o[3]); }
                if (SSQ) { ss += __shfl_xor(ss, 16); ss += __shfl_xor(ss, 32); if (fq == 0) ssq[(size_t)(u.pn * 4 + wc) * M + r] = ss; } }
    }
};
struct EpiB {
    static constexpr bool PERM = true;
    bf16_t* kv; bf16_t* projb; float* gates; bf16_t* vt;
    DI void operator()(const f32x4 (&acc)[2][2][4][2], const pg8::Unit& u, int wr, int wc, int fr, int fq) const {
        const int row0 = u.pm * 256 + wr * 64 + fr; const int cw = wc * 32 + 8 * fq;
        if (u.pn == 19) {
#pragma unroll
            for (int ai = 0; ai < 2; ++ai)
#pragma unroll
                for (int m = 0; m < 4; ++m) { float* rowp = gates + (size_t)(row0 + ai * 128 + m * 16) * 48;
                    if (cw < 48) {
#pragma unroll
                        for (int n = 0; n < 2; ++n) { const f32x4 v = acc[ai][0][m][n]; f32x4 o; o[0] = sigm(v[0]); o[1] = sigm(v[1]); o[2] = sigm(v[2]); o[3] = sigm(v[3]); *(f32x4*)(rowp + cw + 4 * n) = o; } } }
            return;
        }
        if (u.pn == 1 || u.pn == 2) {
            const int gq = wc >> 1, d0 = (wc & 1) * 32 + 8 * fq;
#pragma unroll
            for (int ai = 0; ai < 2; ++ai)
#pragma unroll
                for (int m = 0; m < 4; ++m) { const int row = row0 + ai * 128 + m * 16; const int bb = row >> 12, t = row & 4095;
                    bf16_t* vp = vt + ((size_t)(((u.pn - 1) * 8 + bb) * 2 + gq) * 64 + d0) * 4096 + t;
                    const f32x4 v0 = acc[ai][1][m][0], v1 = acc[ai][1][m][1];
                    vp[0 * 4096] = f2bf(v0[0]); vp[1 * 4096] = f2bf(v0[1]); vp[2 * 4096] = f2bf(v0[2]); vp[3 * 4096] = f2bf(v0[3]);
                    vp[4 * 4096] = f2bf(v1[0]); vp[5 * 4096] = f2bf(v1[1]); vp[6 * 4096] = f2bf(v1[2]); vp[7 * 4096] = f2bf(v1[3]); }
        }
        bf16_t* base; int ldc, col0; float sc = 1.f;
        if (u.pn < 3) { base = kv + (size_t)row0 * 768; ldc = 768; col0 = u.pn * 256 + cw; } else { base = projb + (size_t)row0 * 4096; ldc = 4096; col0 = (u.pn - 3) * 256 + cw; if (u.pn < 7) sc = 0.125f * 1.4426950408889634f; }
#pragma unroll
        for (int ai = 0; ai < 2; ++ai)
#pragma unroll
            for (int m = 0; m < 4; ++m) { bf16_t* rowp = base + (size_t)(ai * 128 + m * 16) * ldc + col0;
#pragma unroll
                for (int bj = 0; bj < 2; ++bj) { const f32x4 v0 = acc[ai][bj][m][0] * sc, v1 = acc[ai][bj][m][1] * sc;
                    u32x4 w; w.x = cvtpk(v0[0], v0[1]); w.y = cvtpk(v0[2], v0[3]); w.z = cvtpk(v1[0], v1[1]); w.w = cvtpk(v1[2], v1[3]);
                    *(u32x4*)(rowp + bj * 128) = w; } }
    }
};

DI void p0_transpose_item(const float* W, int ld, int col0, int nvalid, int K, bf16_t* WT, int row_off, LAS float* scr, int item, int nblk, int lane) {
    const int kb = item / nblk, nb = item % nblk, k0 = 64 * kb, n0 = 32 * nb;
    const int nn = n0 + (lane & 31);
#pragma unroll 8
    for (int i = 0; i < 32; ++i) { const int kk = 2 * i + (lane >> 5); scr[kk * 33 + (lane & 31)] = (nn < nvalid) ? W[(size_t)(k0 + kk) * ld + col0 + nn] : 0.f; }
    asm volatile("s_waitcnt lgkmcnt(0)" ::: "memory");
    const int c = lane & 7;
#pragma unroll
    for (int j = 0; j < 4; ++j) { const int n = (lane >> 3) + 8 * j; const LAS float* s = scr + (8 * c) * 33 + n;
        u32x4 o; o.x = cvtpk(s[0 * 33], s[1 * 33]); o.y = cvtpk(s[2 * 33], s[3 * 33]); o.z = cvtpk(s[4 * 33], s[5 * 33]); o.w = cvtpk(s[6 * 33], s[7 * 33]);
        *(u32x4*)(WT + (size_t)(row_off + n0 + n) * K + k0 + 8 * c) = o; }
    asm volatile("s_waitcnt lgkmcnt(0)" ::: "memory");
}
template <int PART> DI void p0_prologue(const Params& p, LAS unsigned char* lds, const int b0, const int nb) {
    const int tid = otid(), lane = tid & 63, wave = __builtin_amdgcn_readfirstlane(tid >> 6);
    LAS float* scr = (LAS float*)(lds + wave * 8704);
    const int gw = ((int)blockIdx.x - b0) * 8 + wave, NGW = nb * 8;
    if ((int)blockIdx.x < b0 || (int)blockIdx.x >= b0 + nb) return;
    unsigned char* ws = p.ws;
    constexpr int I_ADA = 1536, I_WA = 16 * 128, I_WAO = 16 * 32, I_KV = 16 * 24, I_WB = 16 * 128, I_WG = 16 * 8, I_WBO = 16 * 32, I_W1 = 32 * 8, I_W2 = 4 * 2, I_C1 = 128;
    constexpr int NITEMS = I_ADA + I_WA + I_WAO + I_KV + I_WB + I_WG + I_WBO + 2 * I_W1 + 2 * I_W2 + I_C1;
    constexpr int N_P0 = I_ADA + I_WA + I_WAO;
    constexpr int N_P1 = I_KV + I_WB + I_WG + I_WBO + 2 * I_W1 + 2 * I_W2;
    constexpr int NLOOP = PART == 0 ? N_P0 + I_C1 : N_P1;
    static_assert(N_P0 + N_P1 + I_C1 == NITEMS, "p0 items");
    for (int it0 = gw; it0 < NLOOP; it0 += NGW) {
        int r = __builtin_amdgcn_readfirstlane(it0);
        if (PART == 0) { if (r >= N_P0) r += N_P1; } else r += N_P0;
        if (r < I_ADA) {
            const int l = r / 768, rem = r % 768, jc = rem / 16, kc = rem % 16;
            const float* c = p.in[1]; const float* w = p.in[3] + (size_t)l * 1024 * 3072;
            float a[8]; for (int b = 0; b < 8; ++b) a[b] = 0.f;
            const int j = jc * 64 + lane;
            for (int kk = 0; kk < 64; ++kk) { const int k = kc * 64 + kk; const float wv = w[(size_t)k * 3072 + j];
#pragma unroll
                for (int b = 0; b < 8; ++b) { const float cv = c[b * 1024 + k]; a[b] += siluf(cv) * wv; } }
            float* modp = (float*)(ws + WS_MODP);
#pragma unroll
            for (int b = 0; b < 8; ++b) modp[(size_t)((kc * 2 + l) * 8 + b) * 3072 + j] = a[b];
            continue;
        }
        r -= I_ADA;
        if (r < I_WA) { p0_transpose_item(p.in[6], A_LD, 0, 4096, 1024, (bf16_t*)(ws + WS_WA), 0, scr, r, 128, lane); continue; } r -= I_WA;
        if (r < I_WAO) { p0_transpose_item(p.in[11], 1024, 0, 1024, 1024, (bf16_t*)(ws + WS_WAO), 0, scr, r, 32, lane); continue; } r -= I_WAO;
        if (r < I_KV) { p0_transpose_item(p.in[13], 768, 0, 768, 1024, (bf16_t*)(ws + WS_WCAT), 0, scr, r, 24, lane); continue; } r -= I_KV;
        if (r < I_WB) { p0_transpose_item(p.in[20], B_LD, 0, 4096, 1024, (bf16_t*)(ws + WS_WCAT), 768, scr, r, 128, lane); continue; } r -= I_WB;
        if (r < I_WG) { p0_transpose_item(p.in[20], B_LD, 4096, 48, 1024, (bf16_t*)(ws + WS_WCAT), 4864, scr, r, 8, lane); continue; } r -= I_WG;
        if (r < I_WBO) { p0_transpose_item(p.in[21], 1024, 0, 1024, 1024, (bf16_t*)(ws + WS_WBO), 0, scr, r, 32, lane); continue; } r -= I_WBO;
        if (r < I_W1) { p0_transpose_item(p.in[16], 256, 0, 256, 2048, (bf16_t*)(ws + WS_W1T), 0, scr, r, 8, lane); continue; } r -= I_W1;
        if (r < I_W1) { p0_transpose_item(p.in[18], 256, 0, 256, 2048, (bf16_t*)(ws + WS_W1T), 256, scr, r, 8, lane); continue; } r -= I_W1;
        if (r < I_W2) { p0_transpose_item(p.in[17], 64, 0, 64, 256, (bf16_t*)(ws + WS_W2T), 0, scr, r, 2, lane); continue; } r -= I_W2;
        if (r < I_W2) { p0_transpose_item(p.in[19], 64, 0, 64, 256, (bf16_t*)(ws + WS_W2T), 64, scr, r, 2, lane); continue; } r -= I_W2;
        {
            const int which = r / 64, rem = r % 64, jc = rem / 16, kc = rem % 16;
            const float* pos = p.in[14 + which]; const float* w1 = p.in[16 + 2 * which];
            const int j = jc * 64 + lane; float a = 0.f;
            for (int kk = 0; kk < 128; ++kk) { const int k = kc * 128 + kk; a += pos[k] * w1[(size_t)k * 256 + j]; }
            ((float*)(ws + WS_C1P))[(kc * 2 + which) * 256 + j] = a;
        }
    }
}

template <int LAYER> DI void norm_rows(const Params& p, LAS unsigned char* lds) {
    const int tid = otid(), lane = tid & 63, wave = __builtin_amdgcn_readfirstlane(tid >> 6);
    unsigned char* ws = p.ws;
    LAS float* gs = (LAS float*)lds;
    LAS float* sh = gs + 1024;
    LAS float* g2 = sh + 1024;
    LAS float* wba = g2 + 1024;
    const float* xin = LAYER == 0 ? p.in[0] : p.out;
    bf16_t* hout = LAYER == 0 ? (bf16_t*)((unsigned char*)p.out + 64 * MiB) : (bf16_t*)(ws + WS_RA);
    bf16_t* sout = (bf16_t*)(ws + WS_S);
    const float* modp = (const float*)(ws + WS_MODP);
    float* mod = (float*)(ws + WS_MOD);
    for (int rb = blockIdx.x; rb < 256; rb += gridDim.x) {
        const int b = rb >> 5;
        __syncthreads();
        for (int k = tid; k < 1024; k += 512) {
            float v[3];
#pragma unroll
            for (int part = 0; part < 3; ++part) { float a = p.in[4][LAYER * 3072 + part * 1024 + k];
                for (int kc = 0; kc < 16; ++kc) a += modp[(size_t)((kc * 2 + LAYER) * 8 + b) * 3072 + part * 1024 + k];
                v[part] = a; if ((rb & 31) == 0) mod[(size_t)(LAYER * 8 + b) * 3072 + part * 1024 + k] = a; }
            gs[k] = p.in[5][LAYER * 1024 + k] * (1.f + v[1]); sh[k] = v[0];
            if (LAYER == 1) g2[k] = p.in[12][k];
        }
        if (LAYER == 0) for (int i = tid; i < 16 * 1024; i += 512) { const int c = i & 15, k = i >> 4; wba[c * 1024 + k] = p.in[6][(size_t)k * A_LD + 4096 + c]; }
        __syncthreads();
        f32x4 vn[4];
        { const f32x4* xr0 = (const f32x4*)(xin + (size_t)(rb * 128 + wave * 16) * 1024) + lane;
#pragma unroll
          for (int j = 0; j < 4; ++j) vn[j] = xr0[64 * j]; }
        for (int rr = 0; rr < 16; ++rr) {
            const int m = rb * 128 + wave * 16 + rr;
            f32x4 v[4]; float s = 0.f;
#pragma unroll
            for (int j = 0; j < 4; ++j) { v[j] = vn[j]; s += (v[j][0] * v[j][0] + v[j][1] * v[j][1]) + (v[j][2] * v[j][2] + v[j][3] * v[j][3]); }
            if (rr + 1 < 16) { const f32x4* xr1 = (const f32x4*)(xin + (size_t)(m + 1) * 1024) + lane;
#pragma unroll
                for (int j = 0; j < 4; ++j) vn[j] = xr1[64 * j]; }
            const float rstd = rsqrtf(wave_sum(s) * (1.f / 1024.f) + EPS);
            f32x4 hv[4];
#pragma unroll
            for (int j = 0; j < 4; ++j) { const f32x4 g4 = *(const LAS f32x4*)(gs + 4 * lane + 256 * j), s4 = *(const LAS f32x4*)(sh + 4 * lane + 256 * j);
                const f32x4 xn = v[j] * rstd; hv[j] = xn * g4 + s4;
                u32x2 o; o.x = cvtpk(hv[j][0], hv[j][1]); o.y = cvtpk(hv[j][2], hv[j][3]);
                *((u32x2*)(hout + (size_t)m * 1024) + lane + 64 * j) = o;
                if (LAYER == 1) { const f32x4 k4 = *(const LAS f32x4*)(g2 + 4 * lane + 256 * j); const f32x4 sv = xn * k4; u32x2 o2; o2.x = cvtpk(sv[0], sv[1]); o2.y = cvtpk(sv[2], sv[3]);
                    *((u32x2*)(sout + (size_t)m * 1024) + lane + 64 * j) = o2; } }
            if (LAYER == 0) {
                float pa[16];
#pragma unroll
                for (int c = 0; c < 16; ++c) { float a = 0.f;
#pragma unroll
                    for (int j = 0; j < 4; ++j) { const f32x4 w4 = *(const LAS f32x4*)(wba + c * 1024 + 4 * lane + 256 * j); a += (hv[j][0] * w4[0] + hv[j][1] * w4[1]) + (hv[j][2] * w4[2] + hv[j][3] * w4[3]); }
                    pa[c] = a; if (c & 1) __builtin_amdgcn_sched_barrier(0); }
                {
                    const bool up = (lane & 32) != 0; float q[8];
#pragma unroll
                    for (int c = 0; c < 8; ++c) { const float keep = up ? pa[8 + c] : pa[c], give = up ? pa[c] : pa[8 + c]; q[c] = keep + __shfl_xor(give, 32); }
                    const bool up2 = (lane & 16) != 0; float r4[4];
#pragma unroll
                    for (int c = 0; c < 4; ++c) { const float keep = up2 ? q[4 + c] : q[c], give = up2 ? q[c] : q[4 + c]; r4[c] = keep + __shfl_xor(give, 16); }
                    const bool up3 = (lane & 8) != 0; float r2[2];
#pragma unroll
                    for (int c = 0; c < 2; ++c) { const float keep = up3 ? r4[2 + c] : r4[c], give = up3 ? r4[c] : r4[2 + c]; r2[c] = keep + __shfl_xor(give, 8); }
                    const bool up4 = (lane & 4) != 0;
                    const float keep = up4 ? r2[1] : r2[0], give = up4 ? r2[0] : r2[1];
                    float r1 = keep + __shfl_xor(give, 4);
                    r1 += __shfl_xor(r1, 2); r1 += __shfl_xor(r1, 1);
                    pa[0] = r1;
                }
                const int mycol = ((lane >> 5) & 1) * 8 + ((lane >> 4) & 1) * 4 + ((lane >> 3) & 1) * 2 + ((lane >> 2) & 1);
                const float mine = pa[0];
                if ((lane & 3) == 0) { float o; const int cc = mycol;
                    if (cc < 8) o = sigm(mine);
                    else { const float xx = mine + p.in[9][cc - 8]; const float sp = xx > 20.f ? xx : log1pf(__expf(xx)); o = -__expf(p.in[8][cc - 8]) * sp; }
                    ((float*)(ws + WS_BG))[(size_t)m * 16 + cc] = o; }
            }
        }
    }
}

DI void mm16_acc(float (&acc)[4], const LAS float* X, int px, const LAS float* Y, int py, int c, int q) {
    float y[16];
#pragma unroll
    for (int kk = 0; kk < 16; ++kk) y[kk] = Y[kk * py + c];
#pragma unroll
    for (int h2 = 0; h2 < 2; ++h2) {
        f32x4 xv[2][4];
#pragma unroll
        for (int rr = 0; rr < 2; ++rr)
#pragma unroll
            for (int k4 = 0; k4 < 4; ++k4) xv[rr][k4] = *(const LAS f32x4*)(X + (4 * q + 2 * h2 + rr) * px + 4 * k4);
#pragma unroll
        for (int k4 = 0; k4 < 4; ++k4)
#pragma unroll
            for (int rr = 0; rr < 2; ++rr)
                acc[2 * h2 + rr] += (xv[rr][k4][0] * y[4 * k4] + xv[rr][k4][1] * y[4 * k4 + 1]) + (xv[rr][k4][2] * y[4 * k4 + 2] + xv[rr][k4][3] * y[4 * k4 + 3]);
    }
}
template <int K> DI float row_bcast16(float v) {
    return __builtin_bit_cast(float, __builtin_amdgcn_update_dpp(0, __builtin_bit_cast(int, v), 0x150 + K, 0xf, 0xf, false));
}
template <int I, int K> struct InvRow {
    static DI void run(const float (&mcol)[16], const float (&tt)[16], float& s) { InvRow<I, K - 1>::run(mcol, tt, s); s += row_bcast16<K>(mcol[I]) * tt[K]; }
};
template <int I> struct InvRow<I, -1> { static DI void run(const float (&)[16], const float (&)[16], float&) {} };
template <int I> struct InvAll {
    static DI void run(const float (&mcol)[16], float (&tt)[16], int c) { InvAll<I - 1>::run(mcol, tt, c); float s = 0.f; InvRow<I, I - 1>::run(mcol, tt, s); tt[I] = (I == c ? 1.f : 0.f) - s;
        __builtin_amdgcn_sched_barrier(0); }
};
template <> struct InvAll<-1> { static DI void run(const float (&)[16], float (&)[16], int) {} };
DI void p3_prep(const Params& p, LAS unsigned char* lds) {
    const int tid = otid(), lane_k = tid & 63, wave = __builtin_amdgcn_readfirstlane(tid >> 6);
    unsigned char* ws = p.ws;
    constexpr int L_CW = 0, L_QS = 6144, L_KS = L_QS + 17408, L_VBT = L_KS + 17408, L_KBGT = L_VBT + 18432, L_KDT = L_KBGT + 18432,
                  L_LM = L_KDT + 18432, L_TM = L_LM + 17408, L_TB = L_TM + 17408  , L_PM = L_TB + 9216, L_GC = L_PM + 2560, L_BETA = L_GC + 256, L_SS = L_BETA + 256;
    static_assert(L_SS + 4096 <= LDS_BYTES, "p3 lds");
    LAS float* Lm = (LAS float*)(lds + L_LM);
    LAS float* Tm = (LAS float*)(lds + L_TM);
    LAS float* Pm = (LAS float*)(lds + L_PM);
    LAS float* gcs = (LAS float*)(lds + L_GC);
    LAS float* betas = (LAS float*)(lds + L_BETA);
    const bf16_t* qkv = (const bf16_t*)(ws + WS_RA);
    const float* bg = (const float*)(ws + WS_BG);
    for (int g8 = blockIdx.x; g8 < 512; g8 += gridDim.x) {
        const int bl = g8 >> 6, h = (g8 >> 3) & 7, nbase = (g8 & 7) * 8;
        __syncthreads();
        float cwr[3][4][2];
#pragma unroll
        for (int X = 0; X < 3; ++X)
#pragma unroll
            for (int k = 0; k < 4; ++k) { const f32x2 w2 = *(const f32x2*)(p.in[7] + (size_t)k * 3072 + X * 1024 + h * 128 + 2 * lane_k); cwr[X][k][0] = w2[0]; cwr[X][k][1] = w2[1]; }
        unsigned xr[3][11];
        float gpre = 0.f, bpre = 0.f;
        auto xload = [&](int n_) {
            int ln = lane_k; asm volatile("" : "+v"(ln));
#pragma unroll
            for (int X = 0; X < 3; ++X)
#pragma unroll
                for (int j = 0; j < 11; ++j) { const int tt = n_ * 64 + 8 * wave + j - 3;
                    xr[X][j] = (tt >= 0) ? *(const unsigned*)(qkv + ((size_t)bl * 4096 + tt) * 3072 + X * 1024 + h * 128 + 2 * ln) : 0u; }
        };
        auto gload = [&](int n_) { if (wave == 0) { const size_t row = (size_t)bl * 4096 + n_ * 64 + lane_k; gpre = bg[row * 16 + 8 + h]; bpre = bg[row * 16 + h]; } };
        xload(nbase); gload(nbase);
        for (int nn = 0; nn < 8; ++nn) {
            int lane = lane_k, r32, hh; asm volatile("" : "+v"(lane));
            r32 = lane & 31; hh = lane >> 5;
            const int tid = wave * 64 + lane;
            const int n = nbase + nn;
            const int bglob = bl;
            const int ug = (bglob * 8 + h) * 64 + n;
            if (wave == 0) {
                float gv = gpre;
#pragma unroll
                for (int o = 1; o < 64; o <<= 1) { const float t = __shfl_up(gv, o); if (lane >= o) gv += t; }
                gcs[lane] = gv; betas[lane] = bpre;
            }
            if (nn + 1 < 8) gload(n + 1);
            __syncthreads();
            {
                const int tb = 8 * wave;
                const float gc_last = gcs[63];
#pragma unroll
                for (int X = 0; X < 3; ++X) {
                    float x0[11], x1[11];
#pragma unroll
                    for (int j = 0; j < 11; ++j) { x0[j] = bflo(xr[X][j]); x1[j] = bfhi(xr[X][j]); }
                    float y0[8], y1[8];
#pragma unroll
                    for (int tk = 0; tk < 8; ++tk) {
                        float a0 = 0.f, a1 = 0.f;
#pragma unroll
                        for (int k = 0; k < 4; ++k) { a0 += cwr[X][k][0] * x0[tk + k]; a1 += cwr[X][k][1] * x1[tk + k]; }
                        y0[tk] = siluf(a0); y1[tk] = siluf(a1);
                    }
                    if (X == 0) {
#pragma unroll
                        for (int tk = 0; tk < 8; ++tk) {
                            const int i = tb + tk;
                            const float rq = rsqrtf(wave_sum(y0[tk] * y0[tk] + y1[tk] * y1[tk]) + EPS) * 0.08838834764831845f;
                            const float q0 = y0[tk] * rq, q1 = y1[tk] * rq, eg = __expf(gcs[i]);
                            *(LAS unsigned*)(lds + L_QS + i * 272 + lane * 4) = cvtpk(q0, q1);
                            *(unsigned*)((bf16_t*)(ws + WS_PQD) + ((size_t)ug * 64 + i) * 128 + 2 * lane) = cvtpk(q0 * eg, q1 * eg);
                        }
                    } else if (X == 1) {
                        float b0[8], b1[8], d0[8], d1[8];
#pragma unroll
                        for (int tk = 0; tk < 8; ++tk) {
                            const int i = tb + tk;
                            const float rk = rsqrtf(wave_sum(y0[tk] * y0[tk] + y1[tk] * y1[tk]) + EPS);
                            const float k0 = y0[tk] * rk, k1 = y1[tk] * rk, gci = gcs[i];
                            const float fb = betas[i] * __expf(gci), fd = __expf(gc_last - gci);
                            *(LAS unsigned*)(lds + L_KS + i * 272 + lane * 4) = cvtpk(k0, k1);
                            b0[tk] = k0 * fb; b1[tk] = k1 * fb; d0[tk] = k0 * fd; d1[tk] = k1 * fd;
                        }
                        u32x4 w;
                        w.x = cvtpk(b0[0], b0[1]); w.y = cvtpk(b0[2], b0[3]); w.z = cvtpk(b0[4], b0[5]); w.w = cvtpk(b0[6], b0[7]); *(LAS u32x4*)(lds + L_KBGT + (2 * lane) * 144 + tb * 2) = w;
                        w.x = cvtpk(b1[0], b1[1]); w.y = cvtpk(b1[2], b1[3]); w.z = cvtpk(b1[4], b1[5]); w.w = cvtpk(b1[6], b1[7]); *(LAS u32x4*)(lds + L_KBGT + (2 * lane + 1) * 144 + tb * 2) = w;
                        w.x = cvtpk(d0[0], d0[1]); w.y = cvtpk(d0[2], d0[3]); w.z = cvtpk(d0[4], d0[5]); w.w = cvtpk(d0[6], d0[7]); *(LAS u32x4*)(lds + L_KDT + (2 * lane) * 144 + tb * 2) = w;
                        w.x = cvtpk(d1[0], d1[1]); w.y = cvtpk(d1[2], d1[3]); w.z = cvtpk(d1[4], d1[5]); w.w = cvtpk(d1[6], d1[7]); *(LAS u32x4*)(lds + L_KDT + (2 * lane + 1) * 144 + tb * 2) = w;
                    } else {
#pragma unroll
                        for (int tk = 0; tk < 8; ++tk) { const float bt = betas[tb + tk]; y0[tk] *= bt; y1[tk] *= bt; }
                        u32x4 w;
                        w.x = cvtpk(y0[0], y0[1]); w.y = cvtpk(y0[2], y0[3]); w.z = cvtpk(y0[4], y0[5]); w.w = cvtpk(y0[6], y0[7]); *(LAS u32x4*)(lds + L_VBT + (2 * lane) * 144 + tb * 2) = w;
                        w.x = cvtpk(y1[0], y1[1]); w.y = cvtpk(y1[2], y1[3]); w.z = cvtpk(y1[4], y1[5]); w.w = cvtpk(y1[6], y1[7]); *(LAS u32x4*)(lds + L_VBT + (2 * lane + 1) * 144 + tb * 2) = w;
                    }
                }
            }
            if (nn + 1 < 8) xload(n + 1);
            __syncthreads();
            {
                int lane_c = lane; asm volatile("" : "+v"(lane_c)); const int r32 = lane_c & 31, hh = lane_c >> 5;
                const int which = wave >> 2, mi = (wave >> 1) & 1, ni = wave & 1;
                f32x16 acc = zero16();
                if (!(mi == 0 && ni == 1)) {
                    const LAS unsigned char* ab = lds + (which ? L_QS : L_KS) + (32 * mi + r32) * 272 + hh * 16;
                    const LAS unsigned char* bb = lds + L_KS + (32 * ni + r32) * 272 + hh * 16;
#pragma unroll
                    for (int ks = 0; ks < 8; ++ks) acc = MFMA32(lds128(ab + ks * 32), lds128(bb + ks * 32), acc);
                }
                const int j = 32 * ni + r32; const float gcj = gcs[j];
                bf16_t* at = (bf16_t*)(ws + WS_PAT) + (size_t)ug * 4096;
#pragma unroll
                for (int reg = 0; reg < 16; ++reg) {
                    const int ii = 32 * mi + crow(reg, hh);
                    const float dec = (ii >= j) ? __expf(gcs[ii] - gcj) : 0.f;
                    if (which == 0) Lm[ii * 68 + j] = (ii > j) ? betas[ii] * acc[reg] * dec : 0.f;
                    else at[ii * 64 + j] = f2bf(acc[reg] * dec);
                }
            }
            __syncthreads();
            if (wave == 0) {
                const int a = lane >> 4, c = lane & 15;
                float mcol[16], tt[16];
#pragma unroll
                for (int ii = 0; ii < 16; ++ii) mcol[ii] = Lm[(16 * a + ii) * 68 + 16 * a + c];
                InvAll<15>::run(mcol, tt, c);
#pragma unroll
                for (int ii = 0; ii < 16; ++ii) Tm[(16 * a + ii) * 68 + 16 * a + c] = tt[ii];
            } else {
                int tid_d = tid; asm volatile("" : "+v"(tid_d));
                bf16_t* dst = (bf16_t*)(ws + WS_PKDT) + (size_t)ug * 8192;
                for (int ci = tid_d - 64; ci < 1024; ci += 448) { const int row = ci >> 3, ch = ci & 7;
                    *(u32x4*)(dst + row * 64 + ch * 8) = *(const LAS u32x4*)(lds + L_KDT + row * 144 + ch * 16); }
                if (tid_d == 64) ((float*)(ws + WS_GL))[ug] = __expf(gcs[63]);
            }
            __syncthreads();
            if (wave < 2) {
                const int aa = 2 * wave + 1, bb = 2 * wave, c = lane & 15, q = lane >> 4;
                LAS float* Pw = Pm + wave * 320;
                float acc[4] = {0.f, 0.f, 0.f, 0.f};
                mm16_acc(acc, Lm + (16 * aa) * 68 + 16 * bb, 68, Tm + (16 * bb) * 68 + 16 * bb, 68, c, q);
#pragma unroll
                for (int rr = 0; rr < 4; ++rr) Pw[(4 * q + rr) * 20 + c] = acc[rr];
                float acc2[4] = {0.f, 0.f, 0.f, 0.f};
                mm16_acc(acc2, Tm + (16 * aa) * 68 + 16 * aa, 68, Pw, 20, c, q);
#pragma unroll
                for (int rr = 0; rr < 4; ++rr) Tm[(16 * aa + 4 * q + rr) * 68 + 16 * bb + c] = -acc2[rr];
            }
            __syncthreads();
            for (int e = tid; e < 3072; e += 512) { const int which = e >> 10, ii = (e >> 5) & 31, j = e & 31;
                float v;
                if (which == 2) v = -Lm[(32 + ii) * 68 + j];
                else { const int o = 32 * which; v = ((j >> 4) > (ii >> 4)) ? 0.f : Tm[(o + ii) * 68 + o + j]; }
                *(LAS bf16_t*)(lds + L_TB + which * 2560 + ii * 80 + j * 2) = f2bf(v); }
            __syncthreads();
            {
                int lane_e = lane; asm volatile("" : "+v"(lane_e)); const int r32 = lane_e & 31, hh = lane_e >> 5;
                const int mat = wave >> 2, nb = wave & 3;
                const LAS unsigned char* xt = lds + (mat ? L_KBGT : L_VBT) + (32 * nb + r32) * 144;
                const LAS unsigned char* td0 = lds + L_TB + r32 * 80, *td1 = td0 + 2560, *nm = td0 + 5120;
                f32x16 acc0 = zero16();
#pragma unroll
                for (int ks = 0; ks < 2; ++ks) acc0 = MFMA32(lds128(td0 + hh * 16 + ks * 32), lds128(xt + hh * 16 + ks * 32), acc0);
                f32x16 acc1;
#pragma unroll
                for (int gq = 0; gq < 4; ++gq) { const u32x2 v = *(const LAS u32x2*)(xt + (32 + 8 * gq + 4 * hh) * 2);
                    acc1[4 * gq] = bflo(v[0]); acc1[4 * gq + 1] = bfhi(v[0]); acc1[4 * gq + 2] = bflo(v[1]); acc1[4 * gq + 3] = bfhi(v[1]); }
#pragma unroll
                for (int s2 = 0; s2 < 2; ++s2) acc1 = MFMA32(lds2x64(nm + hh * 8 + s2 * 32, nm + hh * 8 + s2 * 32 + 16), pack8(acc0, s2), acc1);
                f32x16 acc2 = zero16();
#pragma unroll
                for (int s2 = 0; s2 < 2; ++s2) acc2 = MFMA32(lds2x64(td1 + hh * 8 + s2 * 32, td1 + hh * 8 + s2 * 32 + 16), pack8(acc1, s2), acc2);
#pragma unroll
                for (int mi = 0; mi < 2; ++mi) {
                    const f32x16 acc = mi ? acc2 : acc0;
                    if (mat == 0) {
                        bf16_t* up = (bf16_t*)(ws + WS_PU) + ((((size_t)ug * 4 + nb) * 2 + mi) * 64 + lane_e) * 16;
                        u32x4 o0, o1;
#pragma unroll
                        for (int e = 0; e < 4; ++e) { o0[e] = cvtpk(acc[2 * e], acc[2 * e + 1]); o1[e] = cvtpk(acc[8 + 2 * e], acc[8 + 2 * e + 1]); }
                        *(u32x4*)up = o0; *(u32x4*)(up + 8) = o1;
                    } else {
                        bf16_t* wp = (bf16_t*)(ws + WS_PW) + (size_t)ug * 8192;
#pragma unroll
                        for (int reg = 0; reg < 16; ++reg) wp[(32 * mi + crow(reg, hh)) * 128 + 32 * nb + r32] = f2bf(acc[reg]);
                    }
                }
            }
            __syncthreads();
        }
    }
}

template <int PMODE> DI void p4_scan(const Params& p, LAS unsigned char* lds) {
    const int tid = otid(), lane = tid & 63, wave = __builtin_amdgcn_readfirstlane(tid >> 6);
    const int r32 = lane & 31, hh = lane >> 5;
    unsigned char* ws = p.ws;
    constexpr int ST = 59904, S_W = 0, S_QD = 16896, S_KDT = 33792, S_AT = 51200, L_OS = 2 * ST, OSB = 16896;
    static_assert(L_OS + 2 * OSB <= LDS_BYTES, "p4 lds");
    for (int bh = blockIdx.x; bh < 64; bh += gridDim.x) {
        const int b = bh >> 3, h = bh & 7;
        __syncthreads();
        if (wave >= 4) {
            const int lt_k = tid - 256;
            u32x4 rgA[14], rgB[14];
            auto issue = [&](u32x4 (&rg)[14], int n) {
                int lt = lt_k; asm volatile("" : "+v"(lt));
                const size_t ug = (size_t)bh * 64 + n;
                const bf16_t* pw = (const bf16_t*)(ws + WS_PW) + ug * 8192; const bf16_t* pq = (const bf16_t*)(ws + WS_PQD) + ug * 8192;
                const bf16_t* pk = (const bf16_t*)(ws + WS_PKDT) + ug * 8192; const bf16_t* pa = (const bf16_t*)(ws + WS_PAT) + ug * 4096;
#pragma unroll
                for (int k = 0; k < 4; ++k) { const int ci = lt + 256 * k; rg[k] = *(const u32x4*)(pw + ci * 8); rg[4 + k] = *(const u32x4*)(pq + ci * 8); rg[8 + k] = *(const u32x4*)(pk + ci * 8); }
#pragma unroll
                for (int k = 0; k < 2; ++k) { const int ci = lt + 256 * k; rg[12 + k] = *(const u32x4*)(pa + ci * 8); }
            };
            auto commit = [&](const u32x4 (&rg)[14], int st) {
                int lt = lt_k; asm volatile("" : "+v"(lt));
                LAS unsigned char* sb = lds + st * ST;
#pragma unroll
                for (int k = 0; k < 4; ++k) { const int ci = lt + 256 * k; const int row = ci >> 4, ch = ci & 15;
                    LAS u32x2* d0 = (LAS u32x2*)(sb + S_W + row * 264 + ch * 16); d0[0] = (u32x2){rg[k][0], rg[k][1]}; d0[1] = (u32x2){rg[k][2], rg[k][3]};
                    LAS u32x2* d1 = (LAS u32x2*)(sb + S_QD + row * 264 + ch * 16); d1[0] = (u32x2){rg[4 + k][0], rg[4 + k][1]}; d1[1] = (u32x2){rg[4 + k][2], rg[4 + k][3]};
                    const int row2 = ci >> 3, ch2 = ci & 7;
                    LAS u32x2* d2 = (LAS u32x2*)(sb + S_KDT + row2 * 136 + ch2 * 16); d2[0] = (u32x2){rg[8 + k][0], rg[8 + k][1]}; d2[1] = (u32x2){rg[8 + k][2], rg[8 + k][3]}; }
#pragma unroll
                for (int k = 0; k < 2; ++k) { const int ci = lt + 256 * k; const int row2 = ci >> 3, ch2 = ci & 7;
                    LAS u32x2* d3 = (LAS u32x2*)(sb + S_AT + row2 * 136 + ch2 * 16); d3[0] = (u32x2){rg[12 + k][0], rg[12 + k][1]}; d3[1] = (u32x2){rg[12 + k][2], rg[12 + k][3]}; }
            };
            auto ocopy = [&](int mstep) {
                int lt = lt_k; asm volatile("" : "+v"(lt));
                const int row = lt >> 2, part = lt & 3;
                const LAS unsigned char* ob = lds + L_OS + (mstep & 1) * OSB + row * 264 + part * 64;
                const size_t tok = (size_t)b * 4096 + mstep * 64 + row;
                bf16_t* yp = (bf16_t*)(ws + WS_RA) + tok * 1024 + h * 128 + part * 32;
#pragma unroll
                for (int e = 0; e < 4; ++e) { const u32x2 v0 = *(const LAS u32x2*)(ob + e * 16), v1 = *(const LAS u32x2*)(ob + e * 16 + 8); *(u32x4*)(yp + 8 * e) = (u32x4){v0[0], v0[1], v1[0], v1[1]}; }
            };
            issue(rgA, 0); commit(rgA, 0); issue(rgB, 1);
            __syncthreads();
            for (int n = 0; n <= 64; n += 2) {
                if (n + 2 < 64) issue(rgA, n + 2);
                if (PMODE == 0) { if (n >= 1) ocopy(n - 1); }
                if (n + 1 < 64) commit(rgB, (n + 1) & 1);
                __syncthreads();
                if (n + 1 <= 64) {
                    if (n + 3 < 64) issue(rgB, n + 3);
                    if (PMODE == 0) ocopy(n);
                    if (n + 2 < 64) commit(rgA, (n + 2) & 1);
                    __syncthreads();
                }
            }
        } else {
            const int sl = wave;
            f32x16 Sacc[4]; for (int kb = 0; kb < 4; ++kb) Sacc[kb] = zero16();
            u32x4 un[2][2]; float gln;
            auto uload = [&](int n) { const size_t ug = (size_t)bh * 64 + n;
                const bf16_t* up = (const bf16_t*)(ws + WS_PU) + (((ug * 4 + sl) * 2) * 64 + lane) * 16;
                un[0][0] = *(const u32x4*)up; un[0][1] = *(const u32x4*)(up + 8); un[1][0] = *(const u32x4*)(up + 1024); un[1][1] = *(const u32x4*)(up + 1032);
                gln = ((const float*)(ws + WS_GL))[ug]; };
            uload(0);
            __syncthreads();
            for (int n = 0; n <= 64; ++n) {
                if (n < 64 && PMODE != 1) {
                    const LAS unsigned char* sb = lds + (n & 1) * ST;
                    u32x4 uc[2][2]; uc[0][0] = un[0][0]; uc[0][1] = un[0][1]; uc[1][0] = un[1][0]; uc[1][1] = un[1][1]; const float gl = gln;
                    if (n + 1 < 64) uload(n + 1);
                    f32x16 vacc[2], qacc[2];
                    vacc[0] = zero16(); vacc[1] = zero16(); qacc[0] = zero16(); qacc[1] = zero16();
                    {
                        const LAS unsigned char* wrow = sb + S_W + r32 * 264 + hh * 8;
                        const LAS unsigned char* qrow = sb + S_QD + r32 * 264 + hh * 8;
#pragma unroll
                        for (int kb = 0; kb < 4; ++kb) {
                            bf16x8 fw[2][2], fq[2][2];
#pragma unroll
                            for (int s2 = 0; s2 < 2; ++s2)
#pragma unroll
                                for (int mi = 0; mi < 2; ++mi) { const int off = mi * 32 * 264 + (2 * kb + s2) * 32;
                                    fw[s2][mi] = lds2x64(wrow + off, wrow + off + 16); fq[s2][mi] = lds2x64(qrow + off, qrow + off + 16); }
                            const bf16x8 Sb0 = pack8(Sacc[kb], 0), Sb1 = pack8(Sacc[kb], 1);
                            __builtin_amdgcn_sched_barrier(0);
#pragma unroll
                            for (int mi = 0; mi < 2; ++mi) { vacc[mi] = MFMA32(fw[0][mi], Sb0, vacc[mi]); qacc[mi] = MFMA32(fq[0][mi], Sb0, qacc[mi]); }
#pragma unroll
                            for (int mi = 0; mi < 2; ++mi) { vacc[mi] = MFMA32(fw[1][mi], Sb1, vacc[mi]); qacc[mi] = MFMA32(fq[1][mi], Sb1, qacc[mi]); }
                        }
                    }
                    __builtin_amdgcn_sched_barrier(0);
                    bf16x8 Vb[4];
#pragma unroll
                    for (int mi = 0; mi < 2; ++mi) { f32x16 vn;
#pragma unroll
                        for (int e = 0; e < 4; ++e) { vn[2 * e] = bflo(uc[mi][0][e]) - vacc[mi][2 * e]; vn[2 * e + 1] = bfhi(uc[mi][0][e]) - vacc[mi][2 * e + 1];
                                                      vn[8 + 2 * e] = bflo(uc[mi][1][e]) - vacc[mi][8 + 2 * e]; vn[8 + 2 * e + 1] = bfhi(uc[mi][1][e]) - vacc[mi][8 + 2 * e + 1]; }
                        Vb[2 * mi] = pack8(vn, 0); Vb[2 * mi + 1] = pack8(vn, 1); }
                    {
                        bf16x8 fa[6];
                        const LAS unsigned char* arow = sb + S_AT + r32 * 136 + hh * 8;
                        fa[0] = lds2x64(arow, arow + 16); fa[1] = lds2x64(arow + 32, arow + 48);
#pragma unroll
                        for (int ks = 0; ks < 4; ++ks) fa[2 + ks] = lds2x64(arow + 32 * 136 + ks * 32, arow + 32 * 136 + ks * 32 + 16);
                        __builtin_amdgcn_sched_barrier(0);
                        qacc[0] = MFMA32(fa[0], Vb[0], qacc[0]); qacc[1] = MFMA32(fa[2], Vb[0], qacc[1]);
                        qacc[0] = MFMA32(fa[1], Vb[1], qacc[0]); qacc[1] = MFMA32(fa[3], Vb[1], qacc[1]);
                        qacc[1] = MFMA32(fa[4], Vb[2], qacc[1]); qacc[1] = MFMA32(fa[5], Vb[3], qacc[1]);
                    }
#pragma unroll
                    for (int kp = 0; kp < 2; ++kp) {
                        bf16x8 fk[2][4];
#pragma unroll
                        for (int k2 = 0; k2 < 2; ++k2)
#pragma unroll
                            for (int ks = 0; ks < 4; ++ks) { const LAS unsigned char* krow = sb + S_KDT + (32 * (2 * kp + k2) + r32) * 136 + hh * 8 + ks * 32; fk[k2][ks] = lds2x64(krow, krow + 16); }
                        f32x16 sn0 = Sacc[2 * kp] * gl, sn1 = Sacc[2 * kp + 1] * gl;
                        __builtin_amdgcn_sched_barrier(0);
#pragma unroll
                        for (int ks = 0; ks < 4; ++ks) { sn0 = MFMA32(fk[0][ks], Vb[ks], sn0); sn1 = MFMA32(fk[1][ks], Vb[ks], sn1); }
                        Sacc[2 * kp] = sn0; Sacc[2 * kp + 1] = sn1;
                    }
                    {
                        LAS bf16_t* ob = (LAS bf16_t*)(lds + L_OS + (n & 1) * OSB);
#pragma unroll
                        for (int mo = 0; mo < 2; ++mo)
#pragma unroll
                            for (int reg = 0; reg < 16; ++reg) ob[(32 * mo + crow(reg, hh)) * 132 + 32 * sl + r32] = f2bf(qacc[mo][reg]);
                    }
                }
                __syncthreads();
            }
        }
    }
}

DI void p4b_onorm(const Params& p) {
    const int tid = otid(), lane = tid & 63, wave = tid >> 6;
    bf16_t* ob = (bf16_t*)(p.ws + WS_RA);
    const bf16_t* zb = (const bf16_t*)p.out;
    const float* og = p.in[10] + (lane & 7) * 16;
    float g[16];
#pragma unroll
    for (int e = 0; e < 16; ++e) g[e] = og[e];
    const int stride = gridDim.x * 8;
    int m = blockIdx.x * 8 + wave;
    u32x4 no0, no1, nz0, nz1;
    auto ld = [&](int mm) { const bf16_t* op = ob + (size_t)mm * 1024 + lane * 16; const bf16_t* zp = zb + (size_t)mm * 1024 + lane * 16;
        no0 = *(const u32x4*)op; no1 = *(const u32x4*)(op + 8); nz0 = *(const u32x4*)zp; nz1 = *(const u32x4*)(zp + 8); };
    if (m < M) ld(m);
    for (; m < M; m += stride) {
        bf16_t* op = ob + (size_t)m * 1024 + lane * 16;
        const u32x4 o0 = no0, o1 = no1, z0 = nz0, z1 = nz1;
        if (m + stride < M) ld(m + stride);
        float ss = 0.f;
#pragma unroll
        for (int e = 0; e < 4; ++e) { const float a = bflo(o0[e]), b2 = bfhi(o0[e]), c = bflo(o1[e]), d = bfhi(o1[e]); ss += (a * a + b2 * b2) + (c * c + d * d); }
        ss += __shfl_xor(ss, 1); ss += __shfl_xor(ss, 2); ss += __shfl_xor(ss, 4);
        const float rstd = rsqrtf(ss * (1.f / 128.f) + EPS);
        u32x4 y0, y1;
#pragma unroll
        for (int e = 0; e < 4; ++e) {
            y0[e] = cvtpk(bflo(o0[e]) * rstd * g[2 * e] * siluf(bflo(z0[e])), bfhi(o0[e]) * rstd * g[2 * e + 1] * siluf(bfhi(z0[e])));
            y1[e] = cvtpk(bflo(o1[e]) * rstd * g[8 + 2 * e] * siluf(bflo(z1[e])), bfhi(o1[e]) * rstd * g[8 + 2 * e + 1] * siluf(bfhi(z1[e])));
        }
        *(u32x4*)op = y0; *(u32x4*)(op + 8) = y1;
    }
}

DI void p8_compress(const Params& p, LAS unsigned char* lds) {
    const int tid = otid(), lane = tid & 63, wave = __builtin_amdgcn_readfirstlane(tid >> 6);
    const int r32 = lane & 31, hh = lane >> 5;
    unsigned char* ws = p.ws;
    constexpr int L_AS = 0  , L_BS = 4608  , L_HS = L_BS + 36864  , L_C1 = L_HS + 16896  ;
    const bf16_t* kv = (const bf16_t*)(ws + WS_KV);
    for (int u = blockIdx.x; u < 256; u += gridDim.x) {
        const int which = u >> 7, bg = (u >> 3) & 15, nb = u & 7, b = bg >> 1, g = bg & 1;
        __syncthreads();
        if (tid < 256) { float a = 0.f; for (int kc = 0; kc < 16; ++kc) a += ((const float*)(ws + WS_C1P))[(kc * 2 + which) * 256 + tid]; ((LAS float*)(lds + L_C1))[tid] = a; }
        const bf16_t* w1t = (const bf16_t*)(ws + WS_W1T) + (size_t)which * 256 * 2048;
        f32x16 acc = zero16();
        for (int l = 0; l < 32; ++l) {
            __syncthreads();
            if (tid < 256) { const int row = tid >> 3, ch = tid & 7; int tk = 16 * (32 * nb + row) + l; tk = tk > 4095 ? 4095 : tk;
                *(LAS u32x4*)(lds + L_AS + row * 144 + ch * 16) = *(const u32x4*)(kv + ((size_t)b * 4096 + tk) * 768 + which * 128 + g * 64 + ch * 8); }
#pragma unroll
            for (int k = 0; k < 4; ++k) { const int ci = tid + 512 * k; const int row = ci >> 3, ch = ci & 7;
                *(LAS u32x4*)(lds + L_BS + row * 144 + ch * 16) = *(const u32x4*)(w1t + (size_t)row * 2048 + l * 64 + ch * 8); }
            __syncthreads();
            const LAS unsigned char* ab = lds + L_AS + r32 * 144 + hh * 16;
            const LAS unsigned char* bb = lds + L_BS + (32 * wave + r32) * 144 + hh * 16;
#pragma unroll
            for (int ks = 0; ks < 4; ++ks) acc = MFMA32(lds128(ab + ks * 32), lds128(bb + ks * 32), acc);
        }
        {
            const float c1 = ((LAS float*)(lds + L_C1))[32 * wave + r32];
#pragma unroll
            for (int reg = 0; reg < 16; ++reg) *(LAS bf16_t*)(lds + L_HS + crow(reg, hh) * 528 + (32 * wave + r32) * 2) = f2bf(siluf(acc[reg] + c1));
        }
        __syncthreads();
        if (wave < 2) {
            const bf16_t* w2t = (const bf16_t*)(ws + WS_W2T) + (size_t)(which * 64 + 32 * wave + r32) * 256 + hh * 8;
            const LAS unsigned char* ab = lds + L_HS + r32 * 528 + hh * 16;
            f32x16 o = zero16();
#pragma unroll
            for (int ks = 0; ks < 16; ++ks) o = MFMA32(lds128(ab + ks * 32), *(const bf16x8*)(w2t + ks * 16), o);
            bf16_t* dst = (bf16_t*)(ws + WS_CMP) + (size_t)(which * 16 + bg) * 256 * 64;
#pragma unroll
            for (int reg = 0; reg < 16; ++reg) { const int n = 32 * nb + crow(reg, hh); const bf16_t val = (n < 255) ? f2bf(o[reg]) : (bf16_t)0;
                if (which == 0) dst[n * 64 + 32 * wave + r32] = val; else dst[(32 * wave + r32) * 256 + n] = val; }
        }
    }
}

__device__ const unsigned char T5_BUCKET[128] = {0, 1, 2, 3, 4, 5, 6, 7, 8, 9, 10, 11, 12, 13, 14, 15, 16, 16, 16, 17, 17, 18, 18, 18, 19, 19, 19, 20, 20, 20, 20, 21, 21, 21, 21, 22, 22, 22, 22, 22, 23, 23, 23, 23, 23, 23, 24, 24, 24, 24, 24, 24, 25, 25, 25, 25, 25, 25, 25, 26, 26, 26, 26, 26, 26, 26, 26, 27, 27, 27, 27, 27, 27, 27, 27, 27, 27, 28, 28, 28, 28, 28, 28, 28, 28, 28, 28, 29, 29, 29, 29, 29, 29, 29, 29, 29, 29, 29, 29, 30, 30, 30, 30, 30, 30, 30, 30, 30, 30, 30, 30, 30, 30, 31, 31, 31, 31, 31, 31, 31, 31, 31, 31, 31, 31, 31, 31, 31};
constexpr float NEGBIG = -1e30f;

template <int PMODE> DI void p9_nsa(const Params& p, LAS unsigned char* lds) {
    const int tid0 = otid(); const int lane_k = tid0 & 63, wave = __builtin_amdgcn_readfirstlane(tid0 >> 6);
    unsigned char* ws = p.ws;
    constexpr int STG = 17920, L_K = 0, L_V = 9216, L_BT = 4 * STG, L_IA = L_BT + 4224, L_IB = L_IA + 8192, L_Y = L_IB + 8704;
    static_assert(L_Y + 65536 <= LDS_BYTES - 64, "p9 lds");
    constexpr float LOG2E = 1.4426950408889634f;
    LAS float* YL = (LAS float*)(lds + L_Y) + wave * 2048;
    LAS float* BT = (LAS float*)(lds + L_BT);
    LAS float* IA = (LAS float*)(lds + L_IA) + wave * 256;
    LAS float* IB = (LAS float*)(lds + L_IB) + wave * 272;
    const bf16_t* kvb = (const bf16_t*)(ws + WS_KV);
    const bf16_t* cmpb = (const bf16_t*)(ws + WS_CMP);
    const bf16_t* vtb = (const bf16_t*)(ws + WS_VT);
    const bf16_t* projb = (const bf16_t*)(ws + WS_PROJB);
    const float* gates = (const float*)(ws + WS_GATES);
    const float* relb = p.in[2];
    for (int vc0 = blockIdx.x; vc0 < 256; vc0 += gridDim.x) {
        const int vc = (gridDim.x == 256) ? ((vc0 & 7) * 32 + (vc0 >> 3)) : vc0;
        const int bg = vc >> 4, kk16 = vc & 15, b = bg >> 1, g = bg & 1;
        __syncthreads();
        for (int idx = otid(); idx < 1040; idx += 512) { const int hd_ = idx / 130, e = idx - hd_ * 130;
            BT[idx] = (e == 0) ? NEGBIG : relb[(e == 129 ? 31 : (int)T5_BUCKET[e - 1]) * 16 + g * 8 + hd_] * LOG2E; }
        for (int ju = 0; ju < 8; ++ju) {
            int lane = lane_k; asm volatile("" : "+v"(lane));
            const int tid = wave * 64 + lane, r32 = lane & 31, hh = lane >> 5, tok = r32 >> 3, hd = r32 & 7;
            const int srow = tid >> 3, sch = tid & 7;
            const int ub = (ju & 1) ? (32 * (ju >> 1) + 31 - kk16) : (32 * (ju >> 1) + kk16);
            const int t0 = 32 * ub, cur = ub >> 1;
            const int tq = t0 + 4 * wave + tok, head = g * 8 + hd;
            const int tqw = t0 + 4 * wave;
            const size_t trow = (size_t)b * 4096 + tq;
            __syncthreads();
            for (int idx = lane; idx < 256; idx += 64) IA[idx] = 0.f;
            for (int idx = lane; idx < 272; idx += 64) IB[idx] = 0.f;
            const float bfar = relb[31 * 16 + head] * LOG2E;
            bf16x8 Qf[4];
#pragma unroll
            for (int ks = 0; ks < 4; ++ks) Qf[ks] = *(const bf16x8*)(projb + trow * 4096 + head * 64 + 16 * ks + 8 * hh);
            const int nct = (ub >> 5) + 1;
            const int wlo = (t0 - 511) > 0 ? ((t0 - 511) >> 6) : 0;
            const int nwin = cur - wlo + 1;
            const int NT = 2 * nct + (cur + 1) + nwin;
            u32x4 kregA, vregA, kregB, vregB;
            auto tload = [&](u32x4& kreg, u32x4& vreg, int i) {
                const bf16_t *kp, *vp; int kstride, vstride;
                if (i < 2 * nct) { const int ti = i < nct ? i : i - nct; kp = cmpb + ((size_t)(0 * 16 + bg) * 256 + 64 * ti) * 64; kstride = 64; vp = cmpb + (size_t)(1 * 16 + bg) * 256 * 64 + 64 * ti; vstride = 256; }
                else if (i < 2 * nct + cur + 1) { const int s_ = i - 2 * nct; kp = kvb + ((size_t)b * 4096 + 64 * s_) * 768 + 256 + g * 64; kstride = 768; vp = vtb + (size_t)((0 * 8 + b) * 2 + g) * 64 * 4096 + 64 * s_; vstride = 4096; }
                else { const int blk = cur - (i - 2 * nct - cur - 1); kp = kvb + ((size_t)b * 4096 + 64 * blk) * 768 + 512 + g * 64; kstride = 768; vp = vtb + (size_t)((1 * 8 + b) * 2 + g) * 64 * 4096 + 64 * blk; vstride = 4096; }
                kreg = *(const u32x4*)(kp + (size_t)srow * kstride + sch * 8); vreg = *(const u32x4*)(vp + (size_t)srow * vstride + sch * 8);
            };
            auto twrite = [&](const u32x4& kreg, const u32x4& vreg, int st) {
                *(LAS u32x4*)(lds + st * STG + L_K + srow * 144 + sch * 16) = kreg;
                LAS u32x2* vd = (LAS u32x2*)(lds + st * STG + L_V + srow * 136 + sch * 16);
                vd[0] = (u32x2){vreg[0], vreg[1]}; vd[1] = (u32x2){vreg[2], vreg[3]};
            };
            tload(kregA, vregA, 0); twrite(kregA, vregA, 0);
            if (NT > 1) { tload(kregB, vregB, 1); twrite(kregB, vregB, 1); }
            if (NT > 2) tload(kregA, vregA, 2);
            __syncthreads();
            float m_run = NEGBIG, l_run = 0.f, m_c = NEGBIG, linv_c = 0.f;
            f32x16 O[2]; O[0] = zero16(); O[1] = zero16();
            unsigned long long mymask = 0ull, wmask = 0ull;
            u32x2 zpre[8]; float gpre;
            auto zfetch = [&](int br) {
                int l2 = lane; asm volatile("" : "+v"(l2)); const int hh2 = l2 >> 5;
                gpre = gates[trow * 48 + br * 16 + head];
                const bf16_t* zp = projb + trow * 4096 + 1024 + br * 1024 + head * 64;
#pragma unroll
                for (int db = 0; db < 2; ++db)
#pragma unroll
                    for (int gi = 0; gi < 4; ++gi) zpre[db * 4 + gi] = *(const u32x2*)(zp + 32 * db + 8 * gi + 4 * hh2);
            };
            zfetch(0);
            auto finalize = [&](int br, bool normalized) {
                float inv = 1.f;
                if (!normalized) { const float L = l_run + __shfl_xor(l_run, 32); inv = 1.f / fmaxf(L, 1e-30f); }
                const float gt = gpre * inv;
#pragma unroll
                for (int db = 0; db < 2; ++db)
#pragma unroll
                    for (int gi = 0; gi < 4; ++gi) { const u32x2 zv = zpre[db * 4 + gi];
                        LAS float* yl = YL + (db * 16 + 4 * gi) * 64 + lane;
                        const float c0 = gt * O[db][4 * gi + 0] * siluf(bflo(zv[0])), c1 = gt * O[db][4 * gi + 1] * siluf(bfhi(zv[0]));
                        const float c2 = gt * O[db][4 * gi + 2] * siluf(bflo(zv[1])), c3 = gt * O[db][4 * gi + 3] * siluf(bfhi(zv[1]));
                        if (br == 0) { yl[0] = c0; yl[64] = c1; yl[128] = c2; yl[192] = c3; }
                        else { yl[0] += c0; yl[64] += c1; yl[128] += c2; yl[192] += c3; } }
                O[0] = zero16(); O[1] = zero16(); m_run = NEGBIG; l_run = 0.f;
                if (br < 2) zfetch(br + 1);
            };
            auto tile_body_p = [&](auto KT, auto MD, auto PAR, const int i, const int tix) {
                constexpr int kind = decltype(KT)::value; constexpr int mode = decltype(MD)::value; constexpr int par = decltype(PAR)::value;
                if (i + 3 < NT) { if constexpr (par) tload(kregA, vregA, i + 3); else tload(kregB, vregB, i + 3); }
                const LAS unsigned char* sb = lds + (i & 3) * STG;
                const bool skip = ((kind == 2) && (((wmask >> tix) & 1ull) == 0ull)) || PMODE == 1;
                if (!skip) {
                    bf16x8 kf[8];
#pragma unroll
                    for (int kb = 0; kb < 2; ++kb)
#pragma unroll
                        for (int ks = 0; ks < 4; ++ks) kf[kb * 4 + ks] = lds128(sb + L_K + (32 * kb + r32) * 144 + hh * 16 + ks * 32);
                    __builtin_amdgcn_sched_barrier(0);
                    f32x16 st[2];
#pragma unroll
                    for (int kb = 0; kb < 2; ++kb) { st[kb] = zero16();
#pragma unroll
                        for (int ks = 0; ks < 4; ++ks) st[kb] = MFMA32(kf[kb * 4 + ks], Qf[ks], st[kb]); }
                    bf16x8 vf[8];
                    if constexpr (kind != 0) {
#pragma unroll
                        for (int db = 0; db < 2; ++db)
#pragma unroll
                            for (int ks = 0; ks < 4; ++ks) { const LAS unsigned char* vr = sb + L_V + (32 * db + r32) * 136 + hh * 8 + ks * 32; vf[db * 4 + ks] = lds2x64(vr, vr + 16); }
                    }
                    __builtin_amdgcn_sched_barrier(0);
                    const bool selected = (kind != 2) || (((mymask >> tix) & 1ull) != 0ull);
                    float mx = NEGBIG;
                    if constexpr (mode == 1) {
                        int dbase = (kind <= 1) ? (tq - 30 - 1024 * tix - 64 * hh) : (tq + 1 - 64 * tix - 4 * hh);
                        asm volatile("" : "+v"(dbase));
                        constexpr int dmul = (kind <= 1) ? 16 : 1;
                        const LAS float* btl = BT + hd * 130;
                        float man[4] = {NEGBIG, NEGBIG, NEGBIG, NEGBIG};
#pragma unroll
                        for (int kb = 0; kb < 2; ++kb)
#pragma unroll
                            for (int reg = 0; reg < 16; ++reg) {
                                const int dr_ = dbase - dmul * (32 * kb + (reg & 3) + 8 * (reg >> 2)); const int di = dr_ < 0 ? 0 : (dr_ > 129 ? 129 : dr_);
                                const float sv = st[kb][reg] + btl[di];
                                st[kb][reg] = sv; man[reg & 3] = fmaxf(man[reg & 3], sv);
                            }
                        mx = fmaxf(fmaxf(man[0], man[1]), fmaxf(man[2], man[3]));
                        if (!selected) mx = NEGBIG;
                    } else if constexpr (mode == 2) {
                        int dbase = tq - 64 * tix - 4 * hh; asm volatile("" : "+v"(dbase));
#pragma unroll
                        for (int kb = 0; kb < 2; ++kb)
#pragma unroll
                            for (int reg = 0; reg < 16; ++reg) {
                                const int dist = dbase - (32 * kb + (reg & 3) + 8 * (reg >> 2));
                                const float sv = dist < 512 ? st[kb][reg] + bfar : NEGBIG;
                                st[kb][reg] = sv; mx = fmaxf(mx, sv);
                            }
                    } else {
                        float ma[4] = {NEGBIG, NEGBIG, NEGBIG, NEGBIG};
#pragma unroll
                        for (int kb = 0; kb < 2; ++kb)
#pragma unroll
                            for (int reg = 0; reg < 16; ++reg) ma[reg & 3] = fmaxf(ma[reg & 3], st[kb][reg]);
                        mx = fmaxf(fmaxf(ma[0], ma[1]), fmaxf(ma[2], ma[3]));
                        mx = selected ? mx + bfar : NEGBIG;
                    }
                    if constexpr (kind != 1) {
                        mx = fmaxf(mx, __shfl_xor(mx, 32));
                        const float mnew = fmaxf(m_run, mx);
                        const float alpha = __builtin_amdgcn_exp2f(m_run - mnew);
                        const float msub = selected ? (mode == 0 ? mnew - bfar : mnew) : 1e30f;
                        float ls;
                        {
                            const f32x2 ms2 = {msub, msub}; f32x2 acc2[4] = {{0.f, 0.f}, {0.f, 0.f}, {0.f, 0.f}, {0.f, 0.f}};
#pragma unroll
                            for (int kb = 0; kb < 2; ++kb)
#pragma unroll
                                for (int r2 = 0; r2 < 8; ++r2) { f32x2 v = {st[kb][2 * r2], st[kb][2 * r2 + 1]}; v = v - ms2;
                                    v[0] = __builtin_amdgcn_exp2f(v[0]); v[1] = __builtin_amdgcn_exp2f(v[1]); acc2[r2 & 3] = acc2[r2 & 3] + v; st[kb][2 * r2] = v[0]; st[kb][2 * r2 + 1] = v[1]; }
                            const f32x2 t2 = (acc2[0] + acc2[1]) + (acc2[2] + acc2[3]);
                            ls = t2[0] + t2[1];
                        }
                        l_run = l_run * alpha + ls; m_run = mnew;
                        if constexpr (kind != 0) { if (__ballot(alpha != 1.f) != 0ull) { O[0] = O[0] * alpha; O[1] = O[1] * alpha; } }
                    } else {
#pragma unroll
                        for (int kb = 0; kb < 2; ++kb) {
#pragma unroll
                            for (int reg = 0; reg < 16; ++reg) st[kb][reg] = __builtin_amdgcn_exp2f(st[kb][reg] - m_c) * linv_c;
#pragma unroll
                            for (int gi = 0; gi < 4; ++gi) {
                                float a = 2.f * (st[kb][4 * gi] + st[kb][4 * gi + 1] + st[kb][4 * gi + 2]) + st[kb][4 * gi + 3], bq = st[kb][4 * gi + 3];
                                a += __shfl_xor(a, 1); a += __shfl_xor(a, 2); a += __shfl_xor(a, 4);
                                bq += __shfl_xor(bq, 1); bq += __shfl_xor(bq, 2); bq += __shfl_xor(bq, 4);
                                const int sidx = 16 * tix + 8 * kb + 2 * gi + hh;
                                if (hd == 0) { IA[tok * 64 + sidx] = a; IB[tok * 68 + sidx + 1] = bq; }
                            }
                        }
                    }
                    if constexpr (kind != 0 && PMODE != 2) {
                        bf16x8 Pf[4];
#pragma unroll
                        for (int kb = 0; kb < 2; ++kb) { Pf[2 * kb] = pack8(st[kb], 0); Pf[2 * kb + 1] = pack8(st[kb], 1); }
                        __builtin_amdgcn_sched_barrier(0);
#pragma unroll
                        for (int ks = 0; ks < 4; ++ks)
#pragma unroll
                            for (int db = 0; db < 2; ++db) O[db] = MFMA32(vf[db * 4 + ks], Pf[ks], O[db]);
                    }
                }
                __builtin_amdgcn_sched_barrier(0);
                if (i + 2 < NT) { if constexpr (par) twrite(kregB, vregB, (i + 2) & 3); else twrite(kregA, vregA, (i + 2) & 3); }
                __syncthreads();
            };
            auto tile_body = [&](auto KT, auto MD, const int i, const int tix) {
                if (i & 1) tile_body_p(KT, MD, std::integral_constant<int, 1>{}, i, tix); else tile_body_p(KT, MD, std::integral_constant<int, 0>{}, i, tix);
            };
#define NSBAR() __builtin_amdgcn_sched_barrier(0)
#define NPIN(x) asm volatile("" : "+v"(x))
            auto far_run = [&](auto PAR0, const int i0, const int n) {
                constexpr int par0 = decltype(PAR0)::value;
                using PE = std::integral_constant<int, par0>; using PO = std::integral_constant<int, par0 ^ 1>;
                constexpr float THR = 8.f;
                f32x16 sA[2], sB[2]; bf16x8 kf[8], vfr[4]; u32x4 pw[4]; f32x16 cin;
                auto stg_begin = [&](auto PR, int i) { if (i + 3 < NT) { if constexpr (decltype(PR)::value) tload(kregA, vregA, i + 3); else tload(kregB, vregB, i + 3); } };
                auto stg_end = [&](auto PR, int i) { if (i + 2 < NT) { if constexpr (decltype(PR)::value) twrite(kregB, vregB, (i + 2) & 3); else twrite(kregA, vregA, (i + 2) & 3); } __syncthreads(); };
                const int e2 = 2 * nct;
                auto sel_of = [&](int tix) -> bool { return ((mymask >> tix) & 1ull) != 0ull; };
                auto rowmax = [&](const f32x16& c0, const f32x16& c1) -> float {
                    float a = fmaxf(fmaxf(c0[0], c0[1]), c1[0]), b2 = fmaxf(fmaxf(c0[2], c0[3]), c1[1]); a = fmaxf(fmaxf(a, c1[2]), c1[3]);
#pragma unroll
                    for (int r = 4; r < 16; r += 4) { a = fmaxf(fmaxf(a, c0[r]), c0[r + 1]); b2 = fmaxf(fmaxf(b2, c0[r + 2]), c0[r + 3]); a = fmaxf(fmaxf(a, c1[r]), c1[r + 1]); b2 = fmaxf(fmaxf(b2, c1[r + 2]), c1[r + 3]); }
                    const float m = fmaxf(a, b2); return fmaxf(m, __shfl_xor(m, 32)); };
                {
                    const int i = i0; stg_begin(PE{}, i);
                    const LAS unsigned char* kb0 = lds + (i & 3) * STG + L_K + r32 * 144 + hh * 16;
#pragma unroll
                    for (int g = 0; g < 8; ++g) kf[g] = lds128(kb0 + (g & 1) * 32 * 144 + (g >> 1) * 32);
                    const float c0 = sel_of(i - e2) ? bfar : NEGBIG;
#pragma unroll
                    for (int r = 0; r < 16; ++r) cin[r] = c0;
#pragma unroll
                    for (int g = 0; g < 8; ++g) { const int kb = g & 1, ks = g >> 1; sA[kb] = MFMA32(kf[g], Qf[ks], ks == 0 ? cin : sA[kb]); }
                    const LAS unsigned char* kn = lds + ((i + 1) & 3) * STG + L_K + r32 * 144 + hh * 16;
#pragma unroll
                    for (int g = 0; g < 8; ++g) kf[g] = lds128(kn + (g & 1) * 32 * 144 + (g >> 1) * 32);
                    const float mx = rowmax(sA[0], sA[1]);
                    const float mnew = fmaxf(m_run, mx), alpha = __builtin_amdgcn_exp2f(m_run - mnew);
                    l_run *= alpha; m_run = mnew;
                    if (__ballot(alpha != 1.f) != 0ull) { O[0] = O[0] * alpha; O[1] = O[1] * alpha; }
#pragma unroll
                    for (int kb = 0; kb < 2; ++kb)
#pragma unroll
                        for (int r = 0; r < 16; ++r) sA[kb][r] = __builtin_amdgcn_exp2f(sA[kb][r] - mnew);
                    stg_end(PE{}, i);
                }
#define NSTEP(C, P, PR, i_, GL) do { const int it_ = (i_); stg_begin(PR{}, it_); NSBAR(); \
                    const LAS unsigned char* vp_ = lds + ((it_ - 1) & 3) * STG + L_V + r32 * 136 + hh * 8; \
                    const LAS unsigned char* kn_ = lds + ((it_ + 1) & 3) * STG + L_K + r32 * 144 + hh * 16; \
                    { const float c0_ = sel_of(it_ - e2) ? (bfar - m_run) : NEGBIG; _Pragma("unroll") for (int r = 0; r < 16; ++r) cin[r] = c0_; } \
                    float sacc = 0.f; \
                    _Pragma("unroll") for (int g = 0; g < 8; ++g) { const int kb = g & 1, ks = g >> 1, pk = g >> 2, pr = 4 * (g & 3); \
                        C[kb] = MFMA32(kf[g], Qf[ks], ks == 0 ? cin : C[kb]); \
                        sacc += (P[pk][pr] + P[pk][pr + 1]) + (P[pk][pr + 2] + P[pk][pr + 3]); \
                        pw[g >> 1][(g & 1) * 2] = cvtpk(P[pk][pr], P[pk][pr + 1]); pw[g >> 1][(g & 1) * 2 + 1] = cvtpk(P[pk][pr + 2], P[pk][pr + 3]); \
                        if (g >= 6) { const int f = g - 6; vfr[f] = lds2x64(vp_ + (f & 1) * 32 * 136 + (f >> 1) * 32, vp_ + (f & 1) * 32 * 136 + (f >> 1) * 32 + 16); } \
                        NPIN(pw[g >> 1]); NPIN(sacc); NSBAR(); } \
                    l_run += sacc; \
                    float fs_ = 1.f; bool resc_ = false; \
                    { const float mx = rowmax(C[0], C[1]);                        \
                      if (__builtin_expect(__ballot(mx > THR) != 0ull, 0)) { const float dl = fmaxf(mx, 0.f); m_run += dl; fs_ = __builtin_amdgcn_exp2f(-dl); l_run *= fs_; resc_ = true; \
                          _Pragma("unroll") for (int kb = 0; kb < 2; ++kb) _Pragma("unroll") for (int r = 0; r < 16; ++r) C[kb][r] -= dl; } } \
                    NSBAR(); \
                    _Pragma("unroll") for (int g = 0; g < 8; ++g) { const int db = g & 1, ks = g >> 1, ck = g >> 2, cr = 4 * (g & 3); \
                        O[db] = MFMA32(vfr[g & 3], __builtin_bit_cast(bf16x8, pw[ks]), O[db]); \
                        C[ck][cr] = __builtin_amdgcn_exp2f(C[ck][cr]); C[ck][cr + 1] = __builtin_amdgcn_exp2f(C[ck][cr + 1]); C[ck][cr + 2] = __builtin_amdgcn_exp2f(C[ck][cr + 2]); C[ck][cr + 3] = __builtin_amdgcn_exp2f(C[ck][cr + 3]); \
                        if (g + 2 < 8) { const int f = g + 2; vfr[f & 3] = lds2x64(vp_ + (f & 1) * 32 * 136 + (f >> 1) * 32, vp_ + (f & 1) * 32 * 136 + (f >> 1) * 32 + 16); } \
                        if (GL) kf[g] = lds128(kn_ + (g & 1) * 32 * 144 + (g >> 1) * 32); \
                        NPIN(C[ck]); NSBAR(); } \
                    if (resc_) { O[0] = O[0] * fs_; O[1] = O[1] * fs_; } \
                    stg_end(PR{}, it_); } while (0)
                int i = i0 + 1; const int iend = i0 + n;
#pragma unroll 1
                for (; i + 1 < iend; i += 2) { NSTEP(sB, sA, PO, i, true); NSTEP(sA, sB, PE, i + 1, (i + 2 < iend)); }
                const bool lastB = (i < iend);
                if (lastB) { NSTEP(sB, sA, PO, i, false); }
                auto drain = [&](const f32x16 (&P)[2]) {
                    float sacc = 0.f;
#pragma unroll
                    for (int kb = 0; kb < 2; ++kb)
#pragma unroll
                        for (int r = 0; r < 16; ++r) sacc += P[kb][r];
                    l_run += sacc;
                    bf16x8 Pf[4];
#pragma unroll
                    for (int kb = 0; kb < 2; ++kb) { Pf[2 * kb] = pack8(P[kb], 0); Pf[2 * kb + 1] = pack8(P[kb], 1); }
                    const LAS unsigned char* vp_ = lds + ((iend - 1) & 3) * STG + L_V + r32 * 136 + hh * 8;
                    bf16x8 vf[8];
#pragma unroll
                    for (int g = 0; g < 8; ++g) vf[g] = lds2x64(vp_ + (g & 1) * 32 * 136 + (g >> 1) * 32, vp_ + (g & 1) * 32 * 136 + (g >> 1) * 32 + 16);
#pragma unroll
                    for (int g = 0; g < 8; ++g) O[g & 1] = MFMA32(vf[g], Pf[g >> 1], O[g & 1]);
                };
                if (lastB) drain(sB); else drain(sA);
#undef NSTEP
            };
            using IC0 = std::integral_constant<int, 0>; using IC1 = std::integral_constant<int, 1>; using IC2 = std::integral_constant<int, 2>; using IC3 = std::integral_constant<int, 3>;
            int ti = 0;
#pragma unroll 1
            for (int t = 0; t < nct; ++t, ++ti) tile_body(IC0{}, IC1{}, ti, t);
            { const float L = l_run + __shfl_xor(l_run, 32); m_c = m_run; linv_c = (tq >= 31) ? 1.f / fmaxf(L, 1e-30f) : 0.f; m_run = NEGBIG; l_run = 0.f; }
#pragma unroll 1
            for (int t = 0; t < nct; ++t, ++ti) tile_body(IC1{}, IC1{}, ti, t);
            finalize(0, true);
            {
                wmask = 0ull; mymask = 0ull;
#pragma unroll 1
                for (int tk = 0; tk < 4; ++tk) {
                    float v = IA[tk * 64 + lane] + IB[tk * 68 + lane];
                    if (lane == 0 || lane == cur || lane == cur - 1) v = 1e9f; else if (lane > cur) v = -1e9f;
                    int rank = 0;
#pragma unroll
                    for (int j = 0; j < 64; ++j) { const float vj = __builtin_bit_cast(float, __builtin_amdgcn_readlane(__builtin_bit_cast(int, v), j)); rank += ((vj > v) || (vj == v && j < lane)) ? 1 : 0; }
                    const unsigned long long mk = __ballot(rank < 16);
                    wmask |= mk; if (tok == tk) mymask = mk;
                }
            }
            const int nfar_s = (tqw - 176 >= 0) ? ((tqw - 176) >> 6) + 1 : 0;
            const int nfar_blk = (PMODE == 0 && t0 - 176 >= 0) ? ((t0 - 176) >> 6) + 1 : 0;
            int tsel = 0;
            if (nfar_blk >= 2) { if (ti & 1) far_run(std::integral_constant<int, 1>{}, ti, nfar_blk); else far_run(std::integral_constant<int, 0>{}, ti, nfar_blk); ti += nfar_blk; tsel = nfar_blk; }
#pragma unroll 1
            for (int t = tsel; t <= cur; ++t, ++ti) { if (t < nfar_s) tile_body(IC2{}, IC0{}, ti, t); else tile_body(IC2{}, IC1{}, ti, t); }
            finalize(1, false);
#pragma unroll 1
            for (int t = 0; t < nwin; ++t, ++ti) { const int blk = cur - t;
                const bool oldw = (tqw + 3 - 64 * blk > 511), nearw = (tqw - 64 * blk - 63 < 113);
                if (oldw) tile_body(IC3{}, IC2{}, ti, blk); else if (nearw) tile_body(IC3{}, IC1{}, ti, blk); else tile_body(IC3{}, IC0{}, ti, blk); }
            finalize(2, false);
            if (PMODE != 0) continue;
            bf16_t* yp = (bf16_t*)(ws + WS_RA) + trow * 1024 + head * 64;
#pragma unroll
            for (int db = 0; db < 2; ++db)
#pragma unroll
                for (int gi = 0; gi < 4; ++gi) { const LAS float* yl = YL + (db * 16 + 4 * gi) * 64 + lane; u32x2 o; o.x = cvtpk(yl[0], yl[64]); o.y = cvtpk(yl[128], yl[192]);
                    *(u32x2*)(yp + 32 * db + 8 * gi + 4 * hh) = o; }
        }
    }
}

DI void p11_final(const Params& p) {
    const int tid = otid(), lane = tid & 63, wave = tid >> 6;
    const float* ssq = (const float*)(p.ws + WS_SSQ);
    f32x4 g4[4];
#pragma unroll
    for (int j = 0; j < 4; ++j) g4[j] = *((const f32x4*)p.in[22] + lane + 64 * j);
    const int stride = gridDim.x * 8;
    int m = blockIdx.x * 8 + wave;
    f32x4 vn[4]; float sn = 0.f;
    auto ld = [&](int mm) { f32x4* xr = (f32x4*)(p.out + (size_t)mm * 1024) + lane;
#pragma unroll
        for (int j = 0; j < 4; ++j) vn[j] = xr[64 * j];
        sn = (lane < 16) ? ssq[(size_t)lane * M + mm] : 0.f; };
    if (m < M) ld(m);
    for (; m < M; m += stride) {
        f32x4 v[4]; for (int j = 0; j < 4; ++j) v[j] = vn[j]; float s = sn;
        if (m + stride < M) ld(m + stride);
        s += __shfl_xor(s, 1); s += __shfl_xor(s, 2); s += __shfl_xor(s, 4); s += __shfl_xor(s, 8);
        s = __shfl(s, 0);
        const float rstd = rsqrtf(s * (1.f / 1024.f) + EPS);
        f32x4* xr = (f32x4*)(p.out + (size_t)m * 1024) + lane;
#pragma unroll
        for (int j = 0; j < 4; ++j) xr[64 * j] = v[j] * rstd * g4[j];
    }
}

template <int PH> DI void run_phase(const Params& p, LAS unsigned char* lds) {
    unsigned char* ws = p.ws;
    const int G = gridDim.x;
    bf16_t* h0 = (bf16_t*)((unsigned char*)p.out + 64 * MiB);
    if constexpr (PH == 0) p0_prologue<0>(p, lds, 0, (int)gridDim.x);
    if constexpr (PH == 1) norm_rows<0>(p, lds);
    if constexpr (PH == 2) {
        pg8::Gemm g{h0, h0, 0, (const bf16_t*)(ws + WS_WA), M, 4096, 1024}; pg8::StaticOrder S; S.init(M, 4096, G, (int)blockIdx.x);
        EpiA E{(bf16_t*)(ws + WS_RA), (bf16_t*)p.out, 0};
        pg8::gemm_phase<EpiA, true>(lds, g, S, E);
    }
    if constexpr (PH == 3) p3_prep(p, lds);
    if constexpr (PH == 6) { if (gridDim.x > 64) p0_prologue<1>(p, lds, 64, (int)gridDim.x - 64); else p0_prologue<1>(p, lds, 0, (int)gridDim.x); p4_scan<0>(p, lds); }
    if constexpr (PH == 14) p4b_onorm(p);
    if constexpr (PH == 100) p4_scan<1>(p, lds);
    if constexpr (PH == 101) p4_scan<2>(p, lds);
    if constexpr (PH == 7) {
        const bf16_t* ya = (const bf16_t*)(ws + WS_RA);
        pg8::Gemm g{ya, ya, 0, (const bf16_t*)(ws + WS_WAO), M, 1024, 1024}; pg8::StaticOrder S; S.init(M, 1024, G, (int)blockIdx.x);
        EpiRes<false> E{p.in[0], p.out, (const float*)(ws + WS_MOD), nullptr};
        pg8::gemm_phase<EpiRes<false>, true>(lds, g, S, E);
    }
    if constexpr (PH == 8) norm_rows<1>(p, lds);
    if constexpr (PH == 9) {
        pg8::Gemm g{(const bf16_t*)(ws + WS_S), (const bf16_t*)(ws + WS_RA), 3, (const bf16_t*)(ws + WS_WCAT), M, 5120, 1024}; pg8::StaticOrder S; S.init(M, 5120, G, (int)blockIdx.x);
        EpiB E{(bf16_t*)(ws + WS_KV), (bf16_t*)(ws + WS_PROJB), (float*)(ws + WS_GATES), (bf16_t*)(ws + WS_VT)};
        pg8::gemm_phase<EpiB, true>(lds, g, S, E);
    }
    if constexpr (PH == 10) p8_compress(p, lds);
    if constexpr (PH == 11) p9_nsa<0>(p, lds);
    if constexpr (PH == 110) p9_nsa<1>(p, lds);
    if constexpr (PH == 111) p9_nsa<2>(p, lds);
    if constexpr (PH == 12) {
        const bf16_t* yb = (const bf16_t*)(ws + WS_RA);
        pg8::Gemm g{yb, yb, 0, (const bf16_t*)(ws + WS_WBO), M, 1024, 1024}; pg8::StaticOrder S; S.init(M, 1024, G, (int)blockIdx.x);
        EpiRes<true> E{p.out, p.out, (const float*)(ws + WS_MOD) + 8 * 3072, (float*)(ws + WS_SSQ)};
        pg8::gemm_phase<EpiRes<true>, true>(lds, g, S, E);
    }
    if constexpr (PH == 13) p11_final(p);
}
#if MK_ONE_LAUNCH
__global__ void __launch_bounds__(512, 2) fwd_kernel(Params p) {
    extern __shared__ __attribute__((aligned(16))) unsigned char lds_raw[];
    LAS unsigned char* lds = (LAS unsigned char*)lds_raw;
    volatile LAS unsigned* misc = (volatile LAS unsigned*)(lds + LDS_BYTES - 64);
    if (threadIdx.x < 16) misc[threadIdx.x] = 0u;
    __syncthreads();
    XcdBarrier bar = xcd_barrier_post((unsigned*)(p.ws + WS_CTL) + 1024, misc);
    run_phase<0>(p, lds); xcd_barrier(bar); if (DUP_MASK & (1 << 0)) { run_phase<0>(p, lds); xcd_barrier(bar); }
    run_phase<1>(p, lds); xcd_barrier(bar); if (DUP_MASK & (1 << 1)) { run_phase<1>(p, lds); xcd_barrier(bar); }
    run_phase<2>(p, lds); xcd_barrier(bar); if (DUP_MASK & (1 << 2)) { run_phase<2>(p, lds); xcd_barrier(bar); }
    run_phase<3>(p, lds); xcd_barrier(bar); if (DUP_MASK & (1 << 3)) { run_phase<3>(p, lds); xcd_barrier(bar); }
    run_phase<6>(p, lds); xcd_barrier(bar); if (DUP_MASK & (1 << 6)) { run_phase<6>(p, lds); xcd_barrier(bar); }
#if defined(PROBE_SCAN)
    run_phase<PROBE_SCAN>(p, lds); xcd_barrier(bar);
#endif
    run_phase<14>(p, lds); xcd_barrier(bar);
    run_phase<7>(p, lds); xcd_barrier(bar); if (DUP_MASK & (1 << 7)) { run_phase<7>(p, lds); xcd_barrier(bar); }
    run_phase<8>(p, lds); xcd_barrier(bar); if (DUP_MASK & (1 << 8)) { run_phase<8>(p, lds); xcd_barrier(bar); }
    run_phase<9>(p, lds); xcd_barrier(bar); if (DUP_MASK & (1 << 9)) { run_phase<9>(p, lds); xcd_barrier(bar); }
    run_phase<10>(p, lds); xcd_barrier(bar); if (DUP_MASK & (1 << 10)) { run_phase<10>(p, lds); xcd_barrier(bar); }
    run_phase<11>(p, lds); xcd_barrier(bar); if (DUP_MASK & (1 << 11)) { run_phase<11>(p, lds); xcd_barrier(bar); }
#if defined(PROBE_NSA)
    run_phase<PROBE_NSA>(p, lds); xcd_barrier(bar);
#endif
    run_phase<12>(p, lds); xcd_barrier(bar); if (DUP_MASK & (1 << 12)) { run_phase<12>(p, lds); xcd_barrier(bar); }
    run_phase<13>(p, lds);
}
#else
template <int PH> __global__ void __launch_bounds__(512, 2) phase_kernel(Params p) {
    extern __shared__ __attribute__((aligned(16))) unsigned char lds_raw[];
    run_phase<PH>(p, (LAS unsigned char*)lds_raw);
}
template <int PH> static void launch_phase(const Params& a, int grid, hipStream_t stream) {
    static bool attr = false;
    if (!attr) { (void)hipFuncSetAttribute((const void*)phase_kernel<PH>, hipFuncAttributeMaxDynamicSharedMemorySize, LDS_BYTES); attr = true; }
    hipLaunchKernelGGL(phase_kernel<PH>, dim3(grid), dim3(512), LDS_BYTES, stream, a);
}
#endif

extern "C" void kernel_launch(void* const* d_in, const int* in_sizes, int n_in, void* d_out, int out_size, void* d_ws, size_t ws_size, hipStream_t stream) {
    static int grid = 0;
    if (grid == 0) {
        if (n_in != 23 || out_size != M * D || ws_size < WS_END) { fprintf(stderr, "kernel_launch: unexpected shapes (n_in %d out %d ws %zu)\n", n_in, out_size, ws_size); grid = -1; return; }
        int dev = 0, cus = 0;
        if (hipGetDevice(&dev) != hipSuccess || hipDeviceGetAttribute(&cus, hipDeviceAttributeMultiprocessorCount, dev) != hipSuccess) { grid = -1; return; }
#if MK_ONE_LAUNCH
        if (hipFuncSetAttribute((const void*)fwd_kernel, hipFuncAttributeMaxDynamicSharedMemorySize, LDS_BYTES) != hipSuccess) { fprintf(stderr, "kernel_launch: hipFuncSetAttribute failed\n"); grid = -1; return; }
        int per_cu = 0;
        if (hipOccupancyMaxActiveBlocksPerMultiprocessor(&per_cu, (const void*)fwd_kernel, 512, LDS_BYTES) != hipSuccess || per_cu < 1) fprintf(stderr, "kernel_launch: occupancy query says %d\n", per_cu);
        (void)hipGetLastError();
#endif
        grid = cus;
    }
    if (grid < 0) return;
    Params a{};
    for (int i = 0; i < 23; ++i) a.in[i] = (const float*)d_in[i];
    a.out = (float*)d_out; a.ws = (unsigned char*)d_ws;
    a.ph_lo = 0; a.ph_hi = NPH;
#if MK_ONE_LAUNCH
    hipMemsetAsync((char*)d_ws + WS_CTL, 0, 65536, stream);
    hipLaunchKernelGGL(fwd_kernel, dim3(grid), dim3(512), LDS_BYTES, stream, a);
#else
    launch_phase<0>(a, grid, stream); launch_phase<1>(a, grid, stream); launch_phase<2>(a, grid, stream); launch_phase<3>(a, grid, stream);
    launch_phase<6>(a, grid, stream); launch_phase<14>(a, grid, stream); launch_phase<7>(a, grid, stream);
    launch_phase<8>(a, grid, stream); launch_phase<9>(a, grid, stream); launch_phase<10>(a, grid, stream); launch_phase<11>(a, grid, stream);
    launch_phase<12>(a, grid, stream); launch_phase<13>(a, grid, stream);
#endif
}
```

```cpp
#include <hip/hip_runtime.h>
#include <cstdio>
#include <cstdint>
#include <type_traits>

#define DI __device__ __forceinline__
#define LAS __attribute__((address_space(3)))
typedef unsigned short bf16_t;
typedef short bf16x8 __attribute__((ext_vector_type(8)));
typedef short s16x4 __attribute__((ext_vector_type(4)));
typedef float f32x4 __attribute__((ext_vector_type(4)));
typedef float f32x2 __attribute__((ext_vector_type(2)));
typedef float f32x16 __attribute__((ext_vector_type(16)));
typedef unsigned u32x4 __attribute__((ext_vector_type(4)));
typedef unsigned u32x2 __attribute__((ext_vector_type(2)));
typedef __bf16 bf16x2_t __attribute__((ext_vector_type(2)));

#ifndef DUP_MASK
#define DUP_MASK 0
#endif
#ifndef MK_ONE_LAUNCH
#define MK_ONE_LAUNCH 1
#endif

constexpr int NB = 8, T = 4096, D = 1024, M = NB * T;
constexpr int A_LD = 4112, B_LD = 4144;
constexpr float EPS = 1e-6f;
constexpr int NPH = 14;

constexpr size_t MiB = 1u << 20;
constexpr size_t WS_CTL = 0;
constexpr size_t WS_MODP = 1 * MiB;
constexpr size_t WS_WA = 4 * MiB;
constexpr size_t WS_WAO = 12 * MiB;
constexpr size_t WS_C1P = 14 * MiB;
constexpr size_t WS_MOD = 14 * MiB + 65536;
constexpr size_t WS_SSQ = 15 * MiB;
constexpr size_t WS_BG = 17 * MiB;
constexpr size_t WS_GL = 19 * MiB;
constexpr size_t WS_RA = 20 * MiB;
constexpr size_t WS_RP = 212 * MiB;
constexpr size_t WS_PW = WS_RP;
constexpr size_t WS_PQD = WS_RP + 64 * MiB;
constexpr size_t WS_PKDT = WS_RP + 128 * MiB;
constexpr size_t WS_PU = WS_RP + 192 * MiB;
constexpr size_t WS_PAT = WS_RP + 256 * MiB;
constexpr size_t WS_VT = 84 * MiB;
constexpr size_t WS_KV = 100 * MiB;
constexpr size_t WS_WCAT = 148 * MiB;
constexpr size_t WS_WBO = 158 * MiB;
constexpr size_t WS_W1T = 160 * MiB;
constexpr size_t WS_W2T = 162 * MiB;
constexpr size_t WS_GATES = 163 * MiB;
constexpr size_t WS_S = 169 * MiB;
constexpr size_t WS_CMP = 233 * MiB;
constexpr size_t WS_PROJB = 256 * MiB;
constexpr size_t WS_END = 512 * MiB;

constexpr int LDS_BYTES = 163840;

DI unsigned cvtpk(float lo, float hi) { f32x2 v = {lo, hi}; bf16x2_t b = __builtin_convertvector(v, bf16x2_t); return __builtin_bit_cast(unsigned, b); }
DI bf16_t f2bf(float f) { return (bf16_t)(cvtpk(f, 0.f) & 0xffffu); }
DI float bf2f(bf16_t v) { return __uint_as_float((unsigned)v << 16); }
DI float bflo(unsigned u) { return __uint_as_float(u << 16); }
DI float bfhi(unsigned u) { return __uint_as_float(u & 0xffff0000u); }
DI float sigm(float x) { return __builtin_amdgcn_rcpf(1.f + __builtin_amdgcn_exp2f(-1.4426950408889634f * x)); }
DI float siluf(float x) { return x * sigm(x); }
DI float wave_sum(float v) {
#pragma unroll
    for (int o = 1; o < 64; o <<= 1) v += __shfl_xor(v, o);
    return v;
}
DI int crow(int reg, int h) { return (reg & 3) + 8 * (reg >> 2) + 4 * h; }
#define MFMA32(a, b, c) __builtin_amdgcn_mfma_f32_32x32x16_bf16((a), (b), (c), 0, 0, 0)
DI bf16x8 pack8(const f32x16& x, const int s) {
    u32x4 p;
    p[0] = cvtpk(x[8 * s + 0], x[8 * s + 1]); p[1] = cvtpk(x[8 * s + 2], x[8 * s + 3]);
    p[2] = cvtpk(x[8 * s + 4], x[8 * s + 5]); p[3] = cvtpk(x[8 * s + 6], x[8 * s + 7]);
    return __builtin_bit_cast(bf16x8, p);
}
DI bf16x8 lds128(const LAS unsigned char* p) { return *(const LAS bf16x8*)p; }
DI bf16x8 lds2x64(const LAS unsigned char* lo, const LAS unsigned char* hi) {
    const s16x4 a = *(const LAS s16x4*)lo, b = *(const LAS s16x4*)hi;
    return __builtin_shufflevector(a, b, 0, 1, 2, 3, 4, 5, 6, 7);
}
DI int otid() { int t = threadIdx.x; asm volatile("" : "+v"(t)); return t; }
DI f32x16 zero16() { f32x16 z; for (int i = 0; i < 16; ++i) z[i] = 0.f; return z; }

struct Params { const float* in[23]; float* out; unsigned char* ws; int ph_lo, ph_hi, pad0, pad1; };

#define XB_TMO      128
#define XB_XCNT(j)  (256  + 64 * (j))
#define XB_XSUB(j)  (1280 + 64 * (j))
#define XB_XGEN(j)  (2304 + 64 * (j))
#define XB_TOP      3328
#define XB_TOPGEN   3392
#define XCD_BAR_WORDS 3456
#define XB_SPIN_CAP (1u << 22)
DI unsigned xb_ld(unsigned* p)              { return __hip_atomic_load(p, __ATOMIC_RELAXED, __HIP_MEMORY_SCOPE_AGENT); }
DI unsigned xb_add(unsigned* p, unsigned v) { return __hip_atomic_fetch_add(p, v, __ATOMIC_RELAXED, __HIP_MEMORY_SCOPE_AGENT); }
DI unsigned xb_xcc_id() { return (unsigned)__builtin_amdgcn_s_getreg((3 << 11) | 20) & 0xFu; }
#define XB_SPIN(cond, bar) do { unsigned _sp = 0; while (cond) { __builtin_amdgcn_s_sleep(1); \
    if ((++_sp & 255u) == 0u) { if (xb_ld(&(bar)[XB_TMO])) break; if (_sp > XB_SPIN_CAP) { atomicAdd(&(bar)[XB_TMO], 1u); break; } } } } while (0)
struct XcdBarrier { unsigned* bar; unsigned x; volatile LAS unsigned* st; };
DI XcdBarrier xcd_barrier_post(unsigned* bar, volatile LAS unsigned* st) {
    XcdBarrier b; b.bar = bar; b.x = xb_xcc_id(); b.st = st;
    if (threadIdx.x == 0) (void)xb_add(&bar[XB_XCNT(b.x)], 1u);
    return b;
}
DI void xcd_barrier_complete(unsigned* bar, unsigned x, unsigned& nloc, unsigned& nx) {
    const unsigned G = gridDim.x * gridDim.y * gridDim.z;
    unsigned sum, cnt, mine, sp = 0u;
    for (;;) {
        sum = 0u; cnt = 0u; mine = 0u;
#pragma unroll
        for (unsigned j = 0; j < 16; ++j) { const unsigned c = xb_ld(&bar[XB_XCNT(j)]); sum += c; cnt += (c > 0u) ? 1u : 0u; mine = (j == x) ? c : mine; }
        if (sum == G) break;
        __builtin_amdgcn_s_sleep(1);
        if ((++sp & 255u) == 0u) { if (xb_ld(&bar[XB_TMO])) break; if (sp > XB_SPIN_CAP) { atomicAdd(&bar[XB_TMO], 1u); break; } }
    }
    nloc = mine > 0u ? mine : 1u; nx = cnt > 0u ? cnt : 1u;
}
DI void xcd_barrier(const XcdBarrier& b) {
    asm volatile("s_waitcnt vmcnt(0)" ::: "memory");
    __syncthreads();
    if (threadIdx.x == 0) {
        unsigned* bar = b.bar;
        __builtin_amdgcn_s_waitcnt(0);
        unsigned nloc = b.st[0], nx = b.st[1];
        if (nloc == 0u) { xcd_barrier_complete(bar, b.x, nloc, nx); b.st[0] = nloc; b.st[1] = nx; }
        const unsigned old = xb_add(&bar[XB_XSUB(b.x)], 1u);
        const unsigned gen = old / nloc;
        if (old + 1u == (gen + 1u) * nloc) {
            __builtin_amdgcn_fence(__ATOMIC_RELEASE, "agent");
            asm volatile("s_waitcnt vmcnt(0)" ::: "memory");
            const unsigned og = xb_add(&bar[XB_TOP], 1u);
            const unsigned tg = og / nx;
            if (og + 1u == (tg + 1u) * nx) xb_add(&bar[XB_TOPGEN], 1u);
            else XB_SPIN(xb_ld(&bar[XB_TOPGEN]) == tg, bar);
            __builtin_amdgcn_fence(__ATOMIC_ACQUIRE, "agent");
            xb_add(&bar[XB_XGEN(b.x)], 1u);
            asm volatile("s_waitcnt vmcnt(0)" ::: "memory");
        } else {
            XB_SPIN(xb_ld(&bar[XB_XGEN(b.x)]) == gen, bar);
            __builtin_amdgcn_fence(__ATOMIC_ACQUIRE, "agent");
            asm volatile("s_waitcnt vmcnt(0)" ::: "memory");
        }
    }
    __syncthreads();
}

namespace pg8 {
constexpr int BM = 256, BK = 64, HALF = 128, HTB = HALF * BK * 2, STAGE_BYTES = 8 * HTB, NXCD = 8, WGM = 8;
DI int lds_byte(int r, int c) { const int st = (r >> 4) * 2 + (c >> 5), rr = r & 15, cc = c & 31, ob = rr * 64 + cc * 2; return st * 1024 + (ob ^ (((ob >> 9) & 1) << 5)); }
DI void stage_rc(int b, int& R, int& C) { const int st = b / 1024, sb = b % 1024, swz = sb ^ (((sb >> 9) & 1) << 5); R = (st >> 1) * 16 + swz / 64; C = (st & 1) * 32 + (swz % 64) / 2; }
DI int perm32(int rho) { const int n = rho >> 4, i = rho & 15; return 8 * (i >> 2) + 4 * n + (i & 3); }
struct Unit { int pm, pn; };
struct Gemm { const bf16_t* A0; const bf16_t* A1; int split; const bf16_t* Bt; int M, N, K; };
struct StaticOrder {
    int nM, nN, nwg, G, c;
    DI void init(int M_, int N_, int G_, int c_) { nM = M_ / BM; nN = N_ / BM; nwg = nM * nN; G = G_; c = c_; }
    DI bool next(int i, Unit& u) const {
        const long L = (long)i * G + c; if (L >= nwg) return false;
        int wgid = (int)L; { const int q = nwg / NXCD, r = nwg % NXCD, xcd = wgid % NXCD, off = wgid / NXCD; wgid = (xcd < r ? xcd * (q + 1) : r * (q + 1) + (xcd - r) * q) + off; }
        const int nig = WGM * nN, gid = wgid / nig, fm = gid * WGM, gsz = (nM - fm) < WGM ? (nM - fm) : WGM;
        u.pm = fm + ((wgid % nig) % gsz); u.pn = (wgid % nig) / gsz; return true;
    }
};
template <class Epi, bool ALIGN_EPI>
DI void gemm_phase(LAS unsigned char* lds, const Gemm g, const StaticOrder& S, const Epi& E) {
    const int tid = otid(), wid = __builtin_amdgcn_readfirstlane(tid >> 6), lane = tid & 63, wr = wid >> 2, wc = wid & 3, fr = lane & 15, fq = lane >> 4;
    const int K = g.K, nt = K / BK;
    unsigned voffA[2], voffB[2];
#pragma unroll
    for (int i = 0; i < 2; ++i) { int R, C; stage_rc(tid * 16 + i * 8192, R, C); const int Rb = Epi::PERM ? ((R & ~31) + perm32(R & 31)) : R;
        voffA[i] = (unsigned)(R * K + C) * 2u; voffB[i] = (unsigned)(Rb * K + C) * 2u; }
    const size_t kstep = (size_t)(BK * 2);
    const size_t hstep = (size_t)HALF * K * 2;
    const size_t tstep = 2 * hstep;
    const unsigned ldsw = (unsigned)wid * 1024u;
    const int aoff = lds_byte(wr * 64 + fr, fq * 8), boff = lds_byte(wc * 32 + fr, fq * 8);
#define PG8_SA(b, h) (((b) * 2 + (h)) * HTB)
#define PG8_SB(b, h) ((4 + (b) * 2 + (h)) * HTB)
#define PG8_STAGE(bufoff, gbase, voff) do { _Pragma("unroll") for (int _i = 0; _i < 2; ++_i) \
        __builtin_amdgcn_global_load_lds((const unsigned*)((const char*)(gbase) + (voff)[_i]), (LAS unsigned*)(lds + (bufoff) + ldsw + _i * 8192), 16, 0, 0); } while (0)
#define PG8_LDA(dst, b, h) do { _Pragma("unroll") for (int m = 0; m < 4; ++m) _Pragma("unroll") for (int k = 0; k < 2; ++k) dst[m][k] = *(const LAS bf16x8*)(lds + PG8_SA(b, h) + aoff + m * 2048 + k * 1024); } while (0)
#define PG8_LDB(dst, b, h) do { _Pragma("unroll") for (int n = 0; n < 2; ++n) _Pragma("unroll") for (int k = 0; k < 2; ++k) dst[n][k] = *(const LAS bf16x8*)(lds + PG8_SB(b, h) + boff + n * 2048 + k * 1024); } while (0)
#define PG8_MMA(ai, bj, At, Bt) do { __builtin_amdgcn_s_setprio(1); _Pragma("unroll") for (int m = 0; m < 4; ++m) _Pragma("unroll") for (int n = 0; n < 2; ++n) _Pragma("unroll") for (int k = 0; k < 2; ++k) \
        acc[ai][bj][m][n] = __builtin_amdgcn_mfma_f32_16x16x32_bf16(Bt[n][k], At[m][k], acc[ai][bj][m][n], 0, 0, 0); __builtin_amdgcn_s_setprio(0); } while (0)
#define PG8_WAIT_V(n) asm volatile("s_waitcnt vmcnt(" #n ")" ::: "memory")
#define PG8_WAIT_L(n) asm volatile("s_waitcnt lgkmcnt(" #n ")" ::: "memory")
#define PG8_BAR __builtin_amdgcn_s_barrier()
#define PG8_SCHED __builtin_amdgcn_sched_barrier(0)
    Unit cur, nxt; int ui = 0;
    if (!S.next(0, cur)) return;
    f32x4 acc[2][2][4][2];
#pragma unroll
    for (int a = 0; a < 2; ++a)
#pragma unroll
        for (int b = 0; b < 2; ++b)
#pragma unroll
            for (int m = 0; m < 4; ++m)
#pragma unroll
                for (int n = 0; n < 2; ++n) acc[a][b][m][n] = (f32x4){0.f, 0.f, 0.f, 0.f};
    bf16x8 At[4][2], B0[2][2], B1[2][2];
    const char* cA = (const char*)(cur.pn < g.split ? g.A0 : g.A1) + (size_t)cur.pm * tstep; const char* cB = (const char*)g.Bt + (size_t)cur.pn * tstep;
    PG8_STAGE(PG8_SB(0, 0), cB, voffB); PG8_STAGE(PG8_SB(0, 1), cB + hstep, voffB); PG8_STAGE(PG8_SA(0, 0), cA, voffA); PG8_STAGE(PG8_SA(0, 1), cA + hstep, voffA);
    if (wr == 1) PG8_BAR;
    PG8_WAIT_V(2); PG8_BAR;
    PG8_STAGE(PG8_SB(1, 0), cB + kstep, voffB); PG8_STAGE(PG8_SA(1, 0), cA + kstep, voffA); PG8_STAGE(PG8_SB(1, 1), cB + hstep + kstep, voffB);
    PG8_WAIT_V(6); PG8_BAR;
    for (;;) {
        const bool has_next = S.next(ui + 1, nxt);
        const char* nA = has_next ? (const char*)(nxt.pn < g.split ? g.A0 : g.A1) + (size_t)nxt.pm * tstep : cA; const char* nB = has_next ? (const char*)g.Bt + (size_t)nxt.pn * tstep : cB;
        for (int t = 0; t < nt; t += 2) {
            const bool last = (t == nt - 2);
            const char* a1 = cA + (size_t)(t + 1) * kstep;
            const char* a2 = last ? nA : cA + (size_t)(t + 2) * kstep; const char* b2 = last ? nB : cB + (size_t)(t + 2) * kstep;
            const char* a3 = a2 + kstep; const char* b3 = b2 + kstep;
            PG8_LDB(B0, 0, 0); PG8_LDB(B1, 0, 1); PG8_SCHED; PG8_LDA(At, 0, 0); PG8_STAGE(PG8_SA(1, 1), a1 + hstep, voffA);
            PG8_WAIT_V(8); PG8_WAIT_L(0); PG8_BAR; PG8_MMA(0, 0, At, B0); PG8_MMA(0, 1, At, B1); PG8_BAR; PG8_SCHED;
            PG8_LDA(At, 0, 1); PG8_STAGE(PG8_SB(0, 0), b2, voffB); PG8_STAGE(PG8_SB(0, 1), b2 + hstep, voffB); PG8_STAGE(PG8_SA(0, 0), a2, voffA);
            PG8_WAIT_V(8); PG8_WAIT_L(0); PG8_BAR; PG8_MMA(1, 0, At, B0); PG8_MMA(1, 1, At, B1); PG8_BAR; PG8_SCHED;
            PG8_LDB(B0, 1, 0); PG8_LDB(B1, 1, 1); PG8_SCHED; PG8_LDA(At, 1, 0); PG8_STAGE(PG8_SA(0, 1), a2 + hstep, voffA);
            PG8_WAIT_V(8); PG8_WAIT_L(0); PG8_BAR; PG8_MMA(0, 0, At, B0); PG8_MMA(0, 1, At, B1); PG8_BAR; PG8_SCHED;
            PG8_LDA(At, 1, 1); PG8_STAGE(PG8_SB(1, 0), b3, voffB); PG8_STAGE(PG8_SB(1, 1), b3 + hstep, voffB); PG8_STAGE(PG8_SA(1, 0), a3, voffA);
            PG8_WAIT_V(8); PG8_WAIT_L(0); PG8_BAR; PG8_MMA(1, 0, At, B0); PG8_MMA(1, 1, At, B1); PG8_BAR; PG8_SCHED;
        }
        if constexpr (ALIGN_EPI) { if (wr == 0) PG8_BAR; }
        E(acc, cur, wr, wc, fr, fq);
        if (!has_next) break;
#pragma unroll
        for (int a = 0; a < 2; ++a)
#pragma unroll
            for (int b = 0; b < 2; ++b)
#pragma unroll
                for (int m = 0; m < 4; ++m)
#pragma unroll
                    for (int n = 0; n < 2; ++n) acc[a][b][m][n] = (f32x4){0.f, 0.f, 0.f, 0.f};
        cur = nxt; cA = nA; cB = nB; ++ui;
        if constexpr (ALIGN_EPI) { if (wr == 1) PG8_BAR; }
    }
    PG8_WAIT_V(0);
    if constexpr (!ALIGN_EPI) { if (wr == 0) PG8_BAR; }
    PG8_BAR;
#undef PG8_SA
#undef PG8_SB
#undef PG8_STAGE
#undef PG8_LDA
#undef PG8_LDB
#undef PG8_MMA
#undef PG8_WAIT_V
#undef PG8_WAIT_L
#undef PG8_BAR
#undef PG8_SCHED
}
}

struct EpiA {
    static constexpr bool PERM = true;
    bf16_t* qkv; bf16_t* z; int row_off;
    DI void operator()(const f32x4 (&acc)[2][2][4][2], const pg8::Unit& u, int wr, int wc, int fr, int fq) const {
        const int row0 = u.pm * 256 + wr * 64 + fr; const int ct = u.pn * 256 + wc * 32 + 8 * fq;
        bf16_t* base; int ldc, col0;
        if (u.pn < 12) { base = qkv + (size_t)row0 * 3072; ldc = 3072; col0 = ct; } else { base = z + (size_t)(row_off + row0) * 1024; ldc = 1024; col0 = ct - 3072; }
#pragma unroll
        for (int ai = 0; ai < 2; ++ai)
#pragma unroll
            for (int m = 0; m < 4; ++m) { bf16_t* rowp = base + (size_t)(ai * 128 + m * 16) * ldc + col0;
#pragma unroll
                for (int bj = 0; bj < 2; ++bj) { const f32x4 v0 = acc[ai][bj][m][0], v1 = acc[ai][bj][m][1];
                    u32x4 w; w.x = cvtpk(v0[0], v0[1]); w.y = cvtpk(v0[2], v0[3]); w.z = cvtpk(v1[0], v1[1]); w.w = cvtpk(v1[2], v1[3]);
                    *(u32x4*)(rowp + bj * 128) = w; } }
    }
};
template <bool SSQ> struct EpiRes {
    static constexpr bool PERM = false;
    const float* base; float* out; const float* gate  ; float* ssq;
    DI void operator()(const f32x4 (&acc)[2][2][4][2], const pg8::Unit& u, int wr, int wc, int fr, int fq) const {
        const int col0 = u.pn * 256 + wc * 32 + 4 * fq; const int b = (u.pm * 256) >> 12;
        f32x4 gv[2][2];
#pragma unroll
        for (int bj = 0; bj < 2; ++bj)
#pragma unroll
            for (int n = 0; n < 2; ++n) gv[bj][n] = *(const f32x4*)(gate + (size_t)b * 3072 + 2048 + col0 + bj * 128 + n * 16);
#pragma unroll
        for (int ai = 0; ai < 2; ++ai)
#pragma unroll
            for (int m = 0; m < 4; ++m) { const int r = u.pm * 256 + ai * 128 + wr * 64 + m * 16 + fr; const size_t off = (size_t)r * 1024 + col0; float ss = 0.f;
#pragma unroll
                for (int bj = 0; bj < 2; ++bj)
#pragma unroll
                    for (int n = 0; n < 2; ++n) { const f32x4 bs = *(const f32x4*)(base + off + bj * 128 + n * 16); const f32x4 o = bs + gv[bj][n] * acc[ai][bj][m][n];
                        *(f32x4*)(out + off + bj * 128 + n * 16) = o; if (SSQ) ss += (o[0] * o[0] + o[1] * o[1]) + (o[2] * o[2] + o[3] * o[3]); }
                if (SSQ) { ss += __shfl_xor(ss, 16); ss += __shfl_xor(ss, 32); if (fq == 0) ssq[(size_t)(u.pn * 4 + wc) * M + r] = ss; } }
    }
};
struct EpiB {
    static constexpr bool PERM = true;
    bf16_t* kv; bf16_t* projb; float* gates; bf16_t* vt;
    DI void operator()(const f32x4 (&acc)[2][2][4][2], const pg8::Unit& u, int wr, int wc, int fr, int fq) const {
        const int row0 = u.pm * 256 + wr * 64 + fr; const int cw = wc * 32 + 8 * fq;
        if (u.pn == 19) {
#pragma unroll
            for (int ai = 0; ai < 2; ++ai)
#pragma unroll
                for (int m = 0; m < 4; ++m) { float* rowp = gates + (size_t)(row0 + ai * 128 + m * 16) * 48;
                    if (cw < 48) {
#pragma unroll
                        for (int n = 0; n < 2; ++n) { const f32x4 v = acc[ai][0][m][n]; f32x4 o; o[0] = sigm(v[0]); o[1] = sigm(v[1]); o[2] = sigm(v[2]); o[3] = sigm(v[3]); *(f32x4*)(rowp + cw + 4 * n) = o; } } }
            return;
        }
        if (u.pn == 1 || u.pn == 2) {
            const int gq = wc >> 1, d0 = (wc & 1) * 32 + 8 * fq;
#pragma unroll
            for (int ai = 0; ai < 2; ++ai)
#pragma unroll
                for (int m = 0; m < 4; ++m) { const int row = row0 + ai * 128 + m * 16; const int bb = row >> 12, t = row & 4095;
                    bf16_t* vp = vt + ((size_t)(((u.pn - 1) * 8 + bb) * 2 + gq) * 64 + d0) * 4096 + t;
                    const f32x4 v0 = acc[ai][1][m][0], v1 = acc[ai][1][m][1];
                    vp[0 * 4096] = f2bf(v0[0]); vp[1 * 4096] = f2bf(v0[1]); vp[2 * 4096] = f2bf(v0[2]); vp[3 * 4096] = f2bf(v0[3]);
                    vp[4 * 4096] = f2bf(v1[0]); vp[5 * 4096] = f2bf(v1[1]); vp[6 * 4096] = f2bf(v1[2]); vp[7 * 4096] = f2bf(v1[3]); }
        }
        bf16_t* base; int ldc, col0; float sc = 1.f;
        if (u.pn < 3) { base = kv + (size_t)row0 * 768; ldc = 768; col0 = u.pn * 256 + cw; } else { base = projb + (size_t)row0 * 4096; ldc = 4096; col0 = (u.pn - 3) * 256 + cw; if (u.pn < 7) sc = 0.125f * 1.4426950408889634f; }
#pragma unroll
        for (int ai = 0; ai < 2; ++ai)
#pragma unroll
            for (int m = 0; m < 4; ++m) { bf16_t* rowp = base + (size_t)(ai * 128 + m * 16) * ldc + col0;
#pragma unroll
                for (int bj = 0; bj < 2; ++bj) { const f32x4 v0 = acc[ai][bj][m][0] * sc, v1 = acc[ai][bj][m][1] * sc;
                    u32x4 w; w.x = cvtpk(v0[0], v0[1]); w.y = cvtpk(v0[2], v0[3]); w.z = cvtpk(v1[0], v1[1]); w.w = cvtpk(v1[2], v1[3]);
                    *(u32x4*)(rowp + bj * 128) = w; } }
    }
};

DI void p0_transpose_item(const float* W, int ld, int col0, int nvalid, int K, bf16_t* WT, int row_off, LAS float* scr, int item, int nblk, int lane) {
    const int kb = item / nblk, nb = item % nblk, k0 = 64 * kb, n0 = 32 * nb;
    const int nn = n0 + (lane & 31);
#pragma unroll 8
    for (int i = 0; i < 32; ++i) { const int kk = 2 * i + (lane >> 5); scr[kk * 33 + (lane & 31)] = (nn < nvalid) ? W[(size_t)(k0 + kk) * ld + col0 + nn] : 0.f; }
    asm volatile("s_waitcnt lgkmcnt(0)" ::: "memory");
    const int c = lane & 7;
#pragma unroll
    for (int j = 0; j < 4; ++j) { const int n = (lane >> 3) + 8 * j; const LAS float* s = scr + (8 * c) * 33 + n;
        u32x4 o; o.x = cvtpk(s[0 * 33], s[1 * 33]); o.y = cvtpk(s[2 * 33], s[3 * 33]); o.z = cvtpk(s[4 * 33], s[5 * 33]); o.w = cvtpk(s[6 * 33], s[7 * 33]);
        *(u32x4*)(WT + (size_t)(row_off + n0 + n) * K + k0 + 8 * c) = o; }
    asm volatile("s_waitcnt lgkmcnt(0)" ::: "memory");
}
template <int PART> DI void p0_prologue(const Params& p, LAS unsigned char* lds, const int b0, const int nb) {
    const int tid = otid(), lane = tid & 63, wave = __builtin_amdgcn_readfirstlane(tid >> 6);
    LAS float* scr = (LAS float*)(lds + wave * 8704);
    const int gw = ((int)blockIdx.x - b0) * 8 + wave, NGW = nb * 8;
    if ((int)blockIdx.x < b0 || (int)blockIdx.x >= b0 + nb) return;
    unsigned char* ws = p.ws;
    constexpr int I_ADA = 1536, I_WA = 16 * 128, I_WAO = 16 * 32, I_KV = 16 * 24, I_WB = 16 * 128, I_WG = 16 * 8, I_WBO = 16 * 32, I_W1 = 32 * 8, I_W2 = 4 * 2, I_C1 = 128;
    constexpr int NITEMS = I_ADA + I_WA + I_WAO + I_KV + I_WB + I_WG + I_WBO + 2 * I_W1 + 2 * I_W2 + I_C1;
    constexpr int N_P0 = I_ADA + I_WA + I_WAO;
    constexpr int N_P1 = I_KV + I_WB + I_WG + I_WBO + 2 * I_W1 + 2 * I_W2;
    constexpr int NLOOP = PART == 0 ? N_P0 + I_C1 : N_P1;
    static_assert(N_P0 + N_P1 + I_C1 == NITEMS, "p0 items");
    for (int it0 = gw; it0 < NLOOP; it0 += NGW) {
        int r = __builtin_amdgcn_readfirstlane(it0);
        if (PART == 0) { if (r >= N_P0) r += N_P1; } else r += N_P0;
        if (r < I_ADA) {
            const int l = r / 768, rem = r % 768, jc = rem / 16, kc = rem % 16;
            const float* c = p.in[1]; const float* w = p.in[3] + (size_t)l * 1024 * 3072;
            float a[8]; for (int b = 0; b < 8; ++b) a[b] = 0.f;
            const int j = jc * 64 + lane;
            for (int kk = 0; kk < 64; ++kk) { const int k = kc * 64 + kk; const float wv = w[(size_t)k * 3072 + j];
#pragma unroll
                for (int b = 0; b < 8; ++b) { const float cv = c[b * 1024 + k]; a[b] += siluf(cv) * wv; } }
            float* modp = (float*)(ws + WS_MODP);
#pragma unroll
            for (int b = 0; b < 8; ++b) modp[(size_t)((kc * 2 + l) * 8 + b) * 3072 + j] = a[b];
            continue;
        }
        r -= I_ADA;
        if (r < I_WA) { p0_transpose_item(p.in[6], A_LD, 0, 4096, 1024, (bf16_t*)(ws + WS_WA), 0, scr, r, 128, lane); continue; } r -= I_WA;
        if (r < I_WAO) { p0_transpose_item(p.in[11], 1024, 0, 1024, 1024, (bf16_t*)(ws + WS_WAO), 0, scr, r, 32, lane); continue; } r -= I_WAO;
        if (r < I_KV) { p0_transpose_item(p.in[13], 768, 0, 768, 1024, (bf16_t*)(ws + WS_WCAT), 0, scr, r, 24, lane); continue; } r -= I_KV;
        if (r < I_WB) { p0_transpose_item(p.in[20], B_LD, 0, 4096, 1024, (bf16_t*)(ws + WS_WCAT), 768, scr, r, 128, lane); continue; } r -= I_WB;
        if (r < I_WG) { p0_transpose_item(p.in[20], B_LD, 4096, 48, 1024, (bf16_t*)(ws + WS_WCAT), 4864, scr, r, 8, lane); continue; } r -= I_WG;
        if (r < I_WBO) { p0_transpose_item(p.in[21], 1024, 0, 1024, 1024, (bf16_t*)(ws + WS_WBO), 0, scr, r, 32, lane); continue; } r -= I_WBO;
        if (r < I_W1) { p0_transpose_item(p.in[16], 256, 0, 256, 2048, (bf16_t*)(ws + WS_W1T), 0, scr, r, 8, lane); continue; } r -= I_W1;
        if (r < I_W1) { p0_transpose_item(p.in[18], 256, 0, 256, 2048, (bf16_t*)(ws + WS_W1T), 256, scr, r, 8, lane); continue; } r -= I_W1;
        if (r < I_W2) { p0_transpose_item(p.in[17], 64, 0, 64, 256, (bf16_t*)(ws + WS_W2T), 0, scr, r, 2, lane); continue; } r -= I_W2;
        if (r < I_W2) { p0_transpose_item(p.in[19], 64, 0, 64, 256, (bf16_t*)(ws + WS_W2T), 64, scr, r, 2, lane); continue; } r -= I_W2;
        {
            const int which = r / 64, rem = r % 64, jc = rem / 16, kc = rem % 16;
            const float* pos = p.in[14 + which]; const float* w1 = p.in[16 + 2 * which];
            const int j = jc * 64 + lane; float a = 0.f;
            for (int kk = 0; kk < 128; ++kk) { const int k = kc * 128 + kk; a += pos[k] * w1[(size_t)k * 256 + j]; }
            ((float*)(ws + WS_C1P))[(kc * 2 + which) * 256 + j] = a;
        }
    }
}

template <int LAYER> DI void norm_rows(const Params& p, LAS unsigned char* lds) {
    const int tid = otid(), lane = tid & 63, wave = __builtin_amdgcn_readfirstlane(tid >> 6);
    unsigned char* ws = p.ws;
    LAS float* gs = (LAS float*)lds;
    LAS float* sh = gs + 1024;
    LAS float* g2 = sh + 1024;
    LAS float* wba = g2 + 1024;
    const float* xin = LAYER == 0 ? p.in[0] : p.out;
    bf16_t* hout = LAYER == 0 ? (bf16_t*)((unsigned char*)p.out + 64 * MiB) : (bf16_t*)(ws + WS_RA);
    bf16_t* sout = (bf16_t*)(ws + WS_S);
    const float* modp = (const float*)(ws + WS_MODP);
    float* mod = (float*)(ws + WS_MOD);
    for (int rb = blockIdx.x; rb < 256; rb += gridDim.x) {
        const int b = rb >> 5;
        __syncthreads();
        for (int k = tid; k < 1024; k += 512) {
            float v[3];
#pragma unroll
            for (int part = 0; part < 3; ++part) { float a = p.in[4][LAYER * 3072 + part * 1024 + k];
                for (int kc = 0; kc < 16; ++kc) a += modp[(size_t)((kc * 2 + LAYER) * 8 + b) * 3072 + part * 1024 + k];
                v[part] = a; if ((rb & 31) == 0) mod[(size_t)(LAYER * 8 + b) * 3072 + part * 1024 + k] = a; }
            gs[k] = p.in[5][LAYER * 1024 + k] * (1.f + v[1]); sh[k] = v[0];
            if (LAYER == 1) g2[k] = p.in[12][k];
        }
        if (LAYER == 0) for (int i = tid; i < 16 * 1024; i += 512) { const int c = i & 15, k = i >> 4; wba[c * 1024 + k] = p.in[6][(size_t)k * A_LD + 4096 + c]; }
        __syncthreads();
        f32x4 vn[4];
        { const f32x4* xr0 = (const f32x4*)(xin + (size_t)(rb * 128 + wave * 16) * 1024) + lane;
#pragma unroll
          for (int j = 0; j < 4; ++j) vn[j] = xr0[64 * j]; }
        for (int rr = 0; rr < 16; ++rr) {
            const int m = rb * 128 + wave * 16 + rr;
            f32x4 v[4]; float s = 0.f;
#pragma unroll
            for (int j = 0; j < 4; ++j) { v[j] = vn[j]; s += (v[j][0] * v[j][0] + v[j][1] * v[j][1]) + (v[j][2] * v[j][2] + v[j][3] * v[j][3]); }
            if (rr + 1 < 16) { const f32x4* xr1 = (const f32x4*)(xin + (size_t)(m + 1) * 1024) + lane;
#pragma unroll
                for (int j = 0; j < 4; ++j) vn[j] = xr1[64 * j]; }
            const float rstd = rsqrtf(wave_sum(s) * (1.f / 1024.f) + EPS);
            f32x4 hv[4];
#pragma unroll
            for (int j = 0; j < 4; ++j) { const f32x4 g4 = *(const LAS f32x4*)(gs + 4 * lane + 256 * j), s4 = *(const LAS f32x4*)(sh + 4 * lane + 256 * j);
                const f32x4 xn = v[j] * rstd; hv[j] = xn * g4 + s4;
                u32x2 o; o.x = cvtpk(hv[j][0], hv[j][1]); o.y = cvtpk(hv[j][2], hv[j][3]);
                *((u32x2*)(hout + (size_t)m * 1024) + lane + 64 * j) = o;
                if (LAYER == 1) { const f32x4 k4 = *(const LAS f32x4*)(g2 + 4 * lane + 256 * j); const f32x4 sv = xn * k4; u32x2 o2; o2.x = cvtpk(sv[0], sv[1]); o2.y = cvtpk(sv[2], sv[3]);
                    *((u32x2*)(sout + (size_t)m * 1024) + lane + 64 * j) = o2; } }
            if (LAYER == 0) {
                float pa[16];
#pragma unroll
                for (int c = 0; c < 16; ++c) { float a = 0.f;
#pragma unroll
                    for (int j = 0; j < 4; ++j) { const f32x4 w4 = *(const LAS f32x4*)(wba + c * 1024 + 4 * lane + 256 * j); a += (hv[j][0] * w4[0] + hv[j][1] * w4[1]) + (hv[j][2] * w4[2] + hv[j][3] * w4[3]); }
                    pa[c] = a; if (c & 1) __builtin_amdgcn_sched_barrier(0); }
                {
                    const bool up = (lane & 32) != 0; float q[8];
#pragma unroll
                    for (int c = 0; c < 8; ++c) { const float keep = up ? pa[8 + c] : pa[c], give = up ? pa[c] : pa[8 + c]; q[c] = keep + __shfl_xor(give, 32); }
                    const bool up2 = (lane & 16) != 0; float r4[4];
#pragma unroll
                    for (int c = 0; c < 4; ++c) { const float keep = up2 ? q[4 + c] : q[c], give = up2 ? q[c] : q[4 + c]; r4[c] = keep + __shfl_xor(give, 16); }
                    const bool up3 = (lane & 8) != 0; float r2[2];
#pragma unroll
                    for (int c = 0; c < 2; ++c) { const float keep = up3 ? r4[2 + c] : r4[c], give = up3 ? r4[c] : r4[2 + c]; r2[c] = keep + __shfl_xor(give, 8); }
                    const bool up4 = (lane & 4) != 0;
                    const float keep = up4 ? r2[1] : r2[0], give = up4 ? r2[0] : r2[1];
                    float r1 = keep + __shfl_xor(give, 4);
                    r1 += __shfl_xor(r1, 2); r1 += __shfl_xor(r1, 1);
                    pa[0] = r1;
                }
                const int mycol = ((lane >> 5) & 1) * 8 + ((lane >> 4) & 1) * 4 + ((lane >> 3) & 1) * 2 + ((lane >> 2) & 1);
                const float mine = pa[0];
                if ((lane & 3) == 0) { float o; const int cc = mycol;
                    if (cc < 8) o = sigm(mine);
                    else { const float xx = mine + p.in[9][cc - 8]; const float sp = xx > 20.f ? xx : log1pf(__expf(xx)); o = -__expf(p.in[8][cc - 8]) * sp; }
                    ((float*)(ws + WS_BG))[(size_t)m * 16 + cc] = o; }
            }
        }
    }
}

DI void mm16_acc(float (&acc)[4], const LAS float* X, int px, const LAS float* Y, int py, int c, int q) {
    float y[16];
#pragma unroll
    for (int kk = 0; kk < 16; ++kk) y[kk] = Y[kk * py + c];
#pragma unroll
    for (int h2 = 0; h2 < 2; ++h2) {
        f32x4 xv[2][4];
#pragma unroll
        for (int rr = 0; rr < 2; ++rr)
#pragma unroll
            for (int k4 = 0; k4 < 4; ++k4) xv[rr][k4] = *(const LAS f32x4*)(X + (4 * q + 2 * h2 + rr) * px + 4 * k4);
#pragma unroll
        for (int k4 = 0; k4 < 4; ++k4)
#pragma unroll
            for (int rr = 0; rr < 2; ++rr)
                acc[2 * h2 + rr] += (xv[rr][k4][0] * y[4 * k4] + xv[rr][k4][1] * y[4 * k4 + 1]) + (xv[rr][k4][2] * y[4 * k4 + 2] + xv[rr][k4][3] * y[4 * k4 + 3]);
    }
}
template <int K> DI float row_bcast16(float v) {
    return __builtin_bit_cast(float, __builtin_amdgcn_update_dpp(0, __builtin_bit_cast(int, v), 0x150 + K, 0xf, 0xf, false));
}
template <int I, int K> struct InvRow {
    static DI void run(const float (&mcol)[16], const float (&tt)[16], float& s) { InvRow<I, K - 1>::run(mcol, tt, s); s += row_bcast16<K>(mcol[I]) * tt[K]; }
};
template <int I> struct InvRow<I, -1> { static DI void run(const float (&)[16], const float (&)[16], float&) {} };
template <int I> struct InvAll {
    static DI void run(const float (&mcol)[16], float (&tt)[16], int c) { InvAll<I - 1>::run(mcol, tt, c); float s = 0.f; InvRow<I, I - 1>::run(mcol, tt, s); tt[I] = (I == c ? 1.f : 0.f) - s;
        __builtin_amdgcn_sched_barrier(0); }
};
template <> struct InvAll<-1> { static DI void run(const float (&)[16], float (&)[16], int) {} };
DI void p3_prep(const Params& p, LAS unsigned char* lds) {
    const int tid = otid(), lane_k = tid & 63, wave = __builtin_amdgcn_readfirstlane(tid >> 6);
    unsigned char* ws = p.ws;
    constexpr int L_CW = 0, L_QS = 6144, L_KS = L_QS + 17408, L_VBT = L_KS + 17408, L_KBGT = L_VBT + 18432, L_KDT = L_KBGT + 18432,
                  L_LM = L_KDT + 18432, L_TM = L_LM + 17408, L_TB = L_TM + 17408  , L_PM = L_TB + 9216, L_GC = L_PM + 2560, L_BETA = L_GC + 256, L_SS = L_BETA + 256;
    static_assert(L_SS + 4096 <= LDS_BYTES, "p3 lds");
    LAS float* Lm = (LAS float*)(lds + L_LM);
    LAS float* Tm = (LAS float*)(lds + L_TM);
    LAS float* Pm = (LAS float*)(lds + L_PM);
    LAS float* gcs = (LAS float*)(lds + L_GC);
    LAS float* betas = (LAS float*)(lds + L_BETA);
    const bf16_t* qkv = (const bf16_t*)(ws + WS_RA);
    const float* bg = (const float*)(ws + WS_BG);
    for (int g8 = blockIdx.x; g8 < 512; g8 += gridDim.x) {
        const int bl = g8 >> 6, h = (g8 >> 3) & 7, nbase = (g8 & 7) * 8;
        __syncthreads();
        float cwr[3][4][2];
#pragma unroll
        for (int X = 0; X < 3; ++X)
#pragma unroll
            for (int k = 0; k < 4; ++k) { const f32x2 w2 = *(const f32x2*)(p.in[7] + (size_t)k * 3072 + X * 1024 + h * 128 + 2 * lane_k); cwr[X][k][0] = w2[0]; cwr[X][k][1] = w2[1]; }
        unsigned xr[3][11];
        float gpre = 0.f, bpre = 0.f;
        auto xload = [&](int n_) {
            int ln = lane_k; asm volatile("" : "+v"(ln));
#pragma unroll
            for (int X = 0; X < 3; ++X)
#pragma unroll
                for (int j = 0; j < 11; ++j) { const int tt = n_ * 64 + 8 * wave + j - 3;
                    xr[X][j] = (tt >= 0) ? *(const unsigned*)(qkv + ((size_t)bl * 4096 + tt) * 3072 + X * 1024 + h * 128 + 2 * ln) : 0u; }
        };
        auto gload = [&](int n_) { if (wave == 0) { const size_t row = (size_t)bl * 4096 + n_ * 64 + lane_k; gpre = bg[row * 16 + 8 + h]; bpre = bg[row * 16 + h]; } };
        xload(nbase); gload(nbase);
        for (int nn = 0; nn < 8; ++nn) {
            int lane = lane_k, r32, hh; asm volatile("" : "+v"(lane));
            r32 = lane & 31; hh = lane >> 5;
            const int tid = wave * 64 + lane;
            const int n = nbase + nn;
            const int bglob = bl;
            const int ug = (bglob * 8 + h) * 64 + n;
            if (wave == 0) {
                float gv = gpre;
#pragma unroll
                for (int o = 1; o < 64; o <<= 1) { const float t = __shfl_up(gv, o); if (lane >= o) gv += t; }
                gcs[lane] = gv; betas[lane] = bpre;
            }
            if (nn + 1 < 8) gload(n + 1);
            __syncthreads();
            {
                const int tb = 8 * wave;
                const float gc_last = gcs[63];
#pragma unroll
                for (int X = 0; X < 3; ++X) {
                    float x0[11], x1[11];
#pragma unroll
                    for (int j = 0; j < 11; ++j) { x0[j] = bflo(xr[X][j]); x1[j] = bfhi(xr[X][j]); }
                    float y0[8], y1[8];
#pragma unroll
                    for (int tk = 0; tk < 8; ++tk) {
                        float a0 = 0.f, a1 = 0.f;
#pragma unroll
                        for (int k = 0; k < 4; ++k) { a0 += cwr[X][k][0] * x0[tk + k]; a1 += cwr[X][k][1] * x1[tk + k]; }
                        y0[tk] = siluf(a0); y1[tk] = siluf(a1);
                    }
                    if (X == 0) {
#pragma unroll
                        for (int tk = 0; tk < 8; ++tk) {
                            const int i = tb + tk;
                            const float rq = rsqrtf(wave_sum(y0[tk] * y0[tk] + y1[tk] * y1[tk]) + EPS) * 0.08838834764831845f;
                            const float q0 = y0[tk] * rq, q1 = y1[tk] * rq, eg = __expf(gcs[i]);
                            *(LAS unsigned*)(lds + L_QS + i * 272 + lane * 4) = cvtpk(q0, q1);
                            *(unsigned*)((bf16_t*)(ws + WS_PQD) + ((size_t)ug * 64 + i) * 128 + 2 * lane) = cvtpk(q0 * eg, q1 * eg);
                        }
                    } else if (X == 1) {
                        float b0[8], b1[8], d0[8], d1[8];
#pragma unroll
                        for (int tk = 0; tk < 8; ++tk) {
                            const int i = tb + tk;
                            const float rk = rsqrtf(wave_sum(y0[tk] * y0[tk] + y1[tk] * y1[tk]) + EPS);
                            const float k0 = y0[tk] * rk, k1 = y1[tk] * rk, gci = gcs[i];
                            const float fb = betas[i] * __expf(gci), fd = __expf(gc_last - gci);
                            *(LAS unsigned*)(lds + L_KS + i * 272 + lane * 4) = cvtpk(k0, k1);
                            b0[tk] = k0 * fb; b1[tk] = k1 * fb; d0[tk] = k0 * fd; d1[tk] = k1 * fd;
                        }
                        u32x4 w;
                        w.x = cvtpk(b0[0], b0[1]); w.y = cvtpk(b0[2], b0[3]); w.z = cvtpk(b0[4], b0[5]); w.w = cvtpk(b0[6], b0[7]); *(LAS u32x4*)(lds + L_KBGT + (2 * lane) * 144 + tb * 2) = w;
                        w.x = cvtpk(b1[0], b1[1]); w.y = cvtpk(b1[2], b1[3]); w.z = cvtpk(b1[4], b1[5]); w.w = cvtpk(b1[6], b1[7]); *(LAS u32x4*)(lds + L_KBGT + (2 * lane + 1) * 144 + tb * 2) = w;
                        w.x = cvtpk(d0[0], d0[1]); w.y = cvtpk(d0[2], d0[3]); w.z = cvtpk(d0[4], d0[5]); w.w = cvtpk(d0[6], d0[7]); *(LAS u32x4*)(lds + L_KDT + (2 * lane) * 144 + tb * 2) = w;
                        w.x = cvtpk(d1[0], d1[1]); w.y = cvtpk(d1[2], d1[3]); w.z = cvtpk(d1[4], d1[5]); w.w = cvtpk(d1[6], d1[7]); *(LAS u32x4*)(lds + L_KDT + (2 * lane + 1) * 144 + tb * 2) = w;
                    } else {
#pragma unroll
                        for (int tk = 0; tk < 8; ++tk) { const float bt = betas[tb + tk]; y0[tk] *= bt; y1[tk] *= bt; }
                        u32x4 w;
                        w.x = cvtpk(y0[0], y0[1]); w.y = cvtpk(y0[2], y0[3]); w.z = cvtpk(y0[4], y0[5]); w.w = cvtpk(y0[6], y0[7]); *(LAS u32x4*)(lds + L_VBT + (2 * lane) * 144 + tb * 2) = w;
                        w.x = cvtpk(y1[0], y1[1]); w.y = cvtpk(y1[2], y1[3]); w.z = cvtpk(y1[4], y1[5]); w.w = cvtpk(y1[6], y1[7]); *(LAS u32x4*)(lds + L_VBT + (2 * lane + 1) * 144 + tb * 2) = w;
                    }
                }
            }
            if (nn + 1 < 8) xload(n + 1);
            __syncthreads();
            {
                int lane_c = lane; asm volatile("" : "+v"(lane_c)); const int r32 = lane_c & 31, hh = lane_c >> 5;
                const int which = wave >> 2, mi = (wave >> 1) & 1, ni = wave & 1;
                f32x16 acc = zero16();
                if (!(mi == 0 && ni == 1)) {
                    const LAS unsigned char* ab = lds + (which ? L_QS : L_KS) + (32 * mi + r32) * 272 + hh * 16;
                    const LAS unsigned char* bb = lds + L_KS + (32 * ni + r32) * 272 + hh * 16;
#pragma unroll
                    for (int ks = 0; ks < 8; ++ks) acc = MFMA32(lds128(ab + ks * 32), lds128(bb + ks * 32), acc);
                }
                const int j = 32 * ni + r32; const float gcj = gcs[j];
                bf16_t* at = (bf16_t*)(ws + WS_PAT) + (size_t)ug * 4096;
#pragma unroll
                for (int reg = 0; reg < 16; ++reg) {
                    const int ii = 32 * mi + crow(reg, hh);
                    const float dec = (ii >= j) ? __expf(gcs[ii] - gcj) : 0.f;
                    if (which == 0) Lm[ii * 68 + j] = (ii > j) ? betas[ii] * acc[reg] * dec : 0.f;
                    else at[ii * 64 + j] = f2bf(acc[reg] * dec);
                }
            }
            __syncthreads();
            if (wave == 0) {
                const int a = lane >> 4, c = lane & 15;
                float mcol[16], tt[16];
#pragma unroll
                for (int ii = 0; ii < 16; ++ii) mcol[ii] = Lm[(16 * a + ii) * 68 + 16 * a + c];
                InvAll<15>::run(mcol, tt, c);
#pragma unroll
                for (int ii = 0; ii < 16; ++ii) Tm[(16 * a + ii) * 68 + 16 * a + c] = tt[ii];
            } else {
                int tid_d = tid; asm volatile("" : "+v"(tid_d));
                bf16_t* dst = (bf16_t*)(ws + WS_PKDT) + (size_t)ug * 8192;
                for (int ci = tid_d - 64; ci < 1024; ci += 448) { const int row = ci >> 3, ch = ci & 7;
                    *(u32x4*)(dst + row * 64 + ch * 8) = *(const LAS u32x4*)(lds + L_KDT + row * 144 + ch * 16); }
                if (tid_d == 64) ((float*)(ws + WS_GL))[ug] = __expf(gcs[63]);
            }
            __syncthreads();
            if (wave < 2) {
                const int aa = 2 * wave + 1, bb = 2 * wave, c = lane & 15, q = lane >> 4;
                LAS float* Pw = Pm + wave * 320;
                float acc[4] = {0.f, 0.f, 0.f, 0.f};
                mm16_acc(acc, Lm + (16 * aa) * 68 + 16 * bb, 68, Tm + (16 * bb) * 68 + 16 * bb, 68, c, q);
#pragma unroll
                for (int rr = 0; rr < 4; ++rr) Pw[(4 * q + rr) * 20 + c] = acc[rr];
                float acc2[4] = {0.f, 0.f, 0.f, 0.f};
                mm16_acc(acc2, Tm + (16 * aa) * 68 + 16 * aa, 68, Pw, 20, c, q);
#pragma unroll
                for (int rr = 0; rr < 4; ++rr) Tm[(16 * aa + 4 * q + rr) * 68 + 16 * bb + c] = -acc2[rr];
            }
            __syncthreads();
            for (int e = tid; e < 3072; e += 512) { const int which = e >> 10, ii = (e >> 5) & 31, j = e & 31;
                float v;
                if (which == 2) v = -Lm[(32 + ii) * 68 + j];
                else { const int o = 32 * which; v = ((j >> 4) > (ii >> 4)) ? 0.f : Tm[(o + ii) * 68 + o + j]; }
                *(LAS bf16_t*)(lds + L_TB + which * 2560 + ii * 80 + j * 2) = f2bf(v); }
            __syncthreads();
            {
                int lane_e = lane; asm volatile("" : "+v"(lane_e)); const int r32 = lane_e & 31, hh = lane_e >> 5;
                const int mat = wave >> 2, nb = wave & 3;
                const LAS unsigned char* xt = lds + (mat ? L_KBGT : L_VBT) + (32 * nb + r32) * 144;
                const LAS unsigned char* td0 = lds + L_TB + r32 * 80, *td1 = td0 + 2560, *nm = td0 + 5120;
                f32x16 acc0 = zero16();
#pragma unroll
                for (int ks = 0; ks < 2; ++ks) acc0 = MFMA32(lds128(td0 + hh * 16 + ks * 32), lds128(xt + hh * 16 + ks * 32), acc0);
                f32x16 acc1;
#pragma unroll
                for (int gq = 0; gq < 4; ++gq) { const u32x2 v = *(const LAS u32x2*)(xt + (32 + 8 * gq + 4 * hh) * 2);
                    acc1[4 * gq] = bflo(v[0]); acc1[4 * gq + 1] = bfhi(v[0]); acc1[4 * gq + 2] = bflo(v[1]); acc1[4 * gq + 3] = bfhi(v[1]); }
#pragma unroll
                for (int s2 = 0; s2 < 2; ++s2) acc1 = MFMA32(lds2x64(nm + hh * 8 + s2 * 32, nm + hh * 8 + s2 * 32 + 16), pack8(acc0, s2), acc1);
                f32x16 acc2 = zero16();
#pragma unroll
                for (int s2 = 0; s2 < 2; ++s2) acc2 = MFMA32(lds2x64(td1 + hh * 8 + s2 * 32, td1 + hh * 8 + s2 * 32 + 16), pack8(acc1, s2), acc2);
#pragma unroll
                for (int mi = 0; mi < 2; ++mi) {
                    const f32x16 acc = mi ? acc2 : acc0;
                    if (mat == 0) {
                        bf16_t* up = (bf16_t*)(ws + WS_PU) + ((((size_t)ug * 4 + nb) * 2 + mi) * 64 + lane_e) * 16;
                        u32x4 o0, o1;
#pragma unroll
                        for (int e = 0; e < 4; ++e) { o0[e] = cvtpk(acc[2 * e], acc[2 * e + 1]); o1[e] = cvtpk(acc[8 + 2 * e], acc[8 + 2 * e + 1]); }
                        *(u32x4*)up = o0; *(u32x4*)(up + 8) = o1;
                    } else {
                        bf16_t* wp = (bf16_t*)(ws + WS_PW) + (size_t)ug * 8192;
#pragma unroll
                        for (int reg = 0; reg < 16; ++reg) wp[(32 * mi + crow(reg, hh)) * 128 + 32 * nb + r32] = f2bf(acc[reg]);
                    }
                }
            }
            __syncthreads();
        }
    }
}

template <int PMODE> DI void p4_scan(const Params& p, LAS unsigned char* lds) {
    const int tid = otid(), lane = tid & 63, wave = __builtin_amdgcn_readfirstlane(tid >> 6);
    const int r32 = lane & 31, hh = lane >> 5;
    unsigned char* ws = p.ws;
    constexpr int ST = 59904, S_W = 0, S_QD = 16896, S_KDT = 33792, S_AT = 51200, L_OS = 2 * ST, OSB = 16896;
    static_assert(L_OS + 2 * OSB <= LDS_BYTES, "p4 lds");
    for (int bh = blockIdx.x; bh < 64; bh += gridDim.x) {
        const int b = bh >> 3, h = bh & 7;
        __syncthreads();
        if (wave >= 4) {
            const int lt_k = tid - 256;
            u32x4 rgA[14], rgB[14];
            auto issue = [&](u32x4 (&rg)[14], int n) {
                int lt = lt_k; asm volatile("" : "+v"(lt));
                const size_t ug = (size_t)bh * 64 + n;
                const bf16_t* pw = (const bf16_t*)(ws + WS_PW) + ug * 8192; const bf16_t* pq = (const bf16_t*)(ws + WS_PQD) + ug * 8192;
                const bf16_t* pk = (const bf16_t*)(ws + WS_PKDT) + ug * 8192; const bf16_t* pa = (const bf16_t*)(ws + WS_PAT) + ug * 4096;
#pragma unroll
                for (int k = 0; k < 4; ++k) { const int ci = lt + 256 * k; rg[k] = *(const u32x4*)(pw + ci * 8); rg[4 + k] = *(const u32x4*)(pq + ci * 8); rg[8 + k] = *(const u32x4*)(pk + ci * 8); }
#pragma unroll
                for (int k = 0; k < 2; ++k) { const int ci = lt + 256 * k; rg[12 + k] = *(const u32x4*)(pa + ci * 8); }
            };
            auto commit = [&](const u32x4 (&rg)[14], int st) {
                int lt = lt_k; asm volatile("" : "+v"(lt));
                LAS unsigned char* sb = lds + st * ST;
#pragma unroll
                for (int k = 0; k < 4; ++k) { const int ci = lt + 256 * k; const int row = ci >> 4, ch = ci & 15;
                    LAS u32x2* d0 = (LAS u32x2*)(sb + S_W + row * 264 + ch * 16); d0[0] = (u32x2){rg[k][0], rg[k][1]}; d0[1] = (u32x2){rg[k][2], rg[k][3]};
                    LAS u32x2* d1 = (LAS u32x2*)(sb + S_QD + row * 264 + ch * 16); d1[0] = (u32x2){rg[4 + k][0], rg[4 + k][1]}; d1[1] = (u32x2){rg[4 + k][2], rg[4 + k][3]};
                    const int row2 = ci >> 3, ch2 = ci & 7;
                    LAS u32x2* d2 = (LAS u32x2*)(sb + S_KDT + row2 * 136 + ch2 * 16); d2[0] = (u32x2){rg[8 + k][0], rg[8 + k][1]}; d2[1] = (u32x2){rg[8 + k][2], rg[8 + k][3]}; }
#pragma unroll
                for (int k = 0; k < 2; ++k) { const int ci = lt + 256 * k; const int row2 = ci >> 3, ch2 = ci & 7;
                    LAS u32x2* d3 = (LAS u32x2*)(sb + S_AT + row2 * 136 + ch2 * 16); d3[0] = (u32x2){rg[12 + k][0], rg[12 + k][1]}; d3[1] = (u32x2){rg[12 + k][2], rg[12 + k][3]}; }
            };
            auto ocopy = [&](int mstep) {
                int lt = lt_k; asm volatile("" : "+v"(lt));
                const int row = lt >> 2, part = lt & 3;
                const LAS unsigned char* ob = lds + L_OS + (mstep & 1) * OSB + row * 264 + part * 64;
                const size_t tok = (size_t)b * 4096 + mstep * 64 + row;
                bf16_t* yp = (bf16_t*)(ws + WS_RA) + tok * 1024 + h * 128 + part * 32;
#pragma unroll
                for (int e = 0; e < 4; ++e) { const u32x2 v0 = *(const LAS u32x2*)(ob + e * 16), v1 = *(const LAS u32x2*)(ob + e * 16 + 8); *(u32x4*)(yp + 8 * e) = (u32x4){v0[0], v0[1], v1[0], v1[1]}; }
            };
            issue(rgA, 0); commit(rgA, 0); issue(rgB, 1);
            __syncthreads();
            for (int n = 0; n <= 64; n += 2) {
                if (n + 2 < 64) issue(rgA, n + 2);
                if (PMODE == 0) { if (n >= 1) ocopy(n - 1); }
                if (n + 1 < 64) commit(rgB, (n + 1) & 1);
                __syncthreads();
                if (n + 1 <= 64) {
                    if (n + 3 < 64) issue(rgB, n + 3);
                    if (PMODE == 0) ocopy(n);
                    if (n + 2 < 64) commit(rgA, (n + 2) & 1);
                    __syncthreads();
                }
            }
        } else {
            const int sl = wave;
            f32x16 Sacc[4]; for (int kb = 0; kb < 4; ++kb) Sacc[kb] = zero16();
            u32x4 un[2][2]; float gln;
            auto uload = [&](int n) { const size_t ug = (size_t)bh * 64 + n;
                const bf16_t* up = (const bf16_t*)(ws + WS_PU) + (((ug * 4 + sl) * 2) * 64 + lane) * 16;
                un[0][0] = *(const u32x4*)up; un[0][1] = *(const u32x4*)(up + 8); un[1][0] = *(const u32x4*)(up + 1024); un[1][1] = *(const u32x4*)(up + 1032);
                gln = ((const float*)(ws + WS_GL))[ug]; };
            uload(0);
            __syncthreads();
            for (int n = 0; n <= 64; ++n) {
                if (n < 64 && PMODE != 1) {
                    const LAS unsigned char* sb = lds + (n & 1) * ST;
                    u32x4 uc[2][2]; uc[0][0] = un[0][0]; uc[0][1] = un[0][1]; uc[1][0] = un[1][0]; uc[1][1] = un[1][1]; const float gl = gln;
                    if (n + 1 < 64) uload(n + 1);
                    f32x16 vacc[2], qacc[2];
                    vacc[0] = zero16(); vacc[1] = zero16(); qacc[0] = zero16(); qacc[1] = zero16();
                    {
                        const LAS unsigned char* wrow = sb + S_W + r32 * 264 + hh * 8;
                        const LAS unsigned char* qrow = sb + S_QD + r32 * 264 + hh * 8;
#pragma unroll
                        for (int kb = 0; kb < 4; ++kb) {
                            bf16x8 fw[2][2], fq[2][2];
#pragma unroll
                            for (int s2 = 0; s2 < 2; ++s2)
#pragma unroll
                                for (int mi = 0; mi < 2; ++mi) { const int off = mi * 32 * 264 + (2 * kb + s2) * 32;
                                    fw[s2][mi] = lds2x64(wrow + off, wrow + off + 16); fq[s2][mi] = lds2x64(qrow + off, qrow + off + 16); }
                            const bf16x8 Sb0 = pack8(Sacc[kb], 0), Sb1 = pack8(Sacc[kb], 1);
                            __builtin_amdgcn_sched_barrier(0);
#pragma unroll
                            for (int mi = 0; mi < 2; ++mi) { vacc[mi] = MFMA32(fw[0][mi], Sb0, vacc[mi]); qacc[mi] = MFMA32(fq[0][mi], Sb0, qacc[mi]); }
#pragma unroll
                            for (int mi = 0; mi < 2; ++mi) { vacc[mi] = MFMA32(fw[1][mi], Sb1, vacc[mi]); qacc[mi] = MFMA32(fq[1][mi], Sb1, qacc[mi]); }
                        }
                    }
                    __builtin_amdgcn_sched_barrier(0);
                    bf16x8 Vb[4];
#pragma unroll
                    for (int mi = 0; mi < 2; ++mi) { f32x16 vn;
#pragma unroll
                        for (int e = 0; e < 4; ++e) { vn[2 * e] = bflo(uc[mi][0][e]) - vacc[mi][2 * e]; vn[2 * e + 1] = bfhi(uc[mi][0][e]) - vacc[mi][2 * e + 1];
                                                      vn[8 + 2 * e] = bflo(uc[mi][1][e]) - vacc[mi][8 + 2 * e]; vn[8 + 2 * e + 1] = bfhi(uc[mi][1][e]) - vacc[mi][8 + 2 * e + 1]; }
                        Vb[2 * mi] = pack8(vn, 0); Vb[2 * mi + 1] = pack8(vn, 1); }
                    {
                        bf16x8 fa[6];
                        const LAS unsigned char* arow = sb + S_AT + r32 * 136 + hh * 8;
                        fa[0] = lds2x64(arow, arow + 16); fa[1] = lds2x64(arow + 32, arow + 48);
#pragma unroll
                        for (int ks = 0; ks < 4; ++ks) fa[2 + ks] = lds2x64(arow + 32 * 136 + ks * 32, arow + 32 * 136 + ks * 32 + 16);
                        __builtin_amdgcn_sched_barrier(0);
                        qacc[0] = MFMA32(fa[0], Vb[0], qacc[0]); qacc[1] = MFMA32(fa[2], Vb[0], qacc[1]);
                        qacc[0] = MFMA32(fa[1], Vb[1], qacc[0]); qacc[1] = MFMA32(fa[3], Vb[1], qacc[1]);
                        qacc[1] = MFMA32(fa[4], Vb[2], qacc[1]); qacc[1] = MFMA32(fa[5], Vb[3], qacc[1]);
                    }
#pragma unroll
                    for (int kp = 0; kp < 2; ++kp) {
                        bf16x8 fk[2][4];
#pragma unroll
                        for (int k2 = 0; k2 < 2; ++k2)
#pragma unroll
                            for (int ks = 0; ks < 4; ++ks) { const LAS unsigned char* krow = sb + S_KDT + (32 * (2 * kp + k2) + r32) * 136 + hh * 8 + ks * 32; fk[k2][ks] = lds2x64(krow, krow + 16); }
                        f32x16 sn0 = Sacc[2 * kp] * gl, sn1 = Sacc[2 * kp + 1] * gl;
                        __builtin_amdgcn_sched_barrier(0);
#pragma unroll
                        for (int ks = 0; ks < 4; ++ks) { sn0 = MFMA32(fk[0][ks], Vb[ks], sn0); sn1 = MFMA32(fk[1][ks], Vb[ks], sn1); }
                        Sacc[2 * kp] = sn0; Sacc[2 * kp + 1] = sn1;
                    }
                    {
                        LAS bf16_t* ob = (LAS bf16_t*)(lds + L_OS + (n & 1) * OSB);
#pragma unroll
                        for (int mo = 0; mo < 2; ++mo)
#pragma unroll
                            for (int reg = 0; reg < 16; ++reg) ob[(32 * mo + crow(reg, hh)) * 132 + 32 * sl + r32] = f2bf(qacc[mo][reg]);
                    }
                }
                __syncthreads();
            }
        }
    }
}

DI void p4b_onorm(const Params& p) {
    const int tid = otid(), lane = tid & 63, wave = tid >> 6;
    bf16_t* ob = (bf16_t*)(p.ws + WS_RA);
    const bf16_t* zb = (const bf16_t*)p.out;
    const float* og = p.in[10] + (lane & 7) * 16;
    float g[16];
#pragma unroll
    for (int e = 0; e < 16; ++e) g[e] = og[e];
    const int stride = gridDim.x * 8;
    int m = blockIdx.x * 8 + wave;
    u32x4 no0, no1, nz0, nz1;
    auto ld = [&](int mm) { const bf16_t* op = ob + (size_t)mm * 1024 + lane * 16; const bf16_t* zp = zb + (size_t)mm * 1024 + lane * 16;
        no0 = *(const u32x4*)op; no1 = *(const u32x4*)(op + 8); nz0 = *(const u32x4*)zp; nz1 = *(const u32x4*)(zp + 8); };
    if (m < M) ld(m);
    for (; m < M; m += stride) {
        bf16_t* op = ob + (size_t)m * 1024 + lane * 16;
        const u32x4 o0 = no0, o1 = no1, z0 = nz0, z1 = nz1;
        if (m + stride < M) ld(m + stride);
        float ss = 0.f;
#pragma unroll
        for (int e = 0; e < 4; ++e) { const float a = bflo(o0[e]), b2 = bfhi(o0[e]), c = bflo(o1[e]), d = bfhi(o1[e]); ss += (a * a + b2 * b2) + (c * c + d * d); }
        ss += __shfl_xor(ss, 1); ss += __shfl_xor(ss, 2); ss += __shfl_xor(ss, 4);
        const float rstd = rsqrtf(ss * (1.f / 128.f) + EPS);
        u32x4 y0, y1;
#pragma unroll
        for (int e = 0; e < 4; ++e) {
            y0[e] = cvtpk(bflo(o0[e]) * rstd * g[2 * e] * siluf(bflo(z0[e])), bfhi(o0[e]) * rstd * g[2 * e + 1] * siluf(bfhi(z0[e])));
            y1[e] = cvtpk(bflo(o1[e]) * rstd * g[8 + 2 * e] * siluf(bflo(z1[e])), bfhi(o1[e]) * rstd * g[8 + 2 * e + 1] * siluf(bfhi(z1[e])));
        }
        *(u32x4*)op = y0; *(u32x4*)(op + 8) = y1;
    }
}

DI void p8_compress(const Params& p, LAS unsigned char* lds) {
    const int tid = otid(), lane = tid & 63, wave = __builtin_amdgcn_readfirstlane(tid >> 6);
    const int r32 = lane & 31, hh = lane >> 5;
    unsigned char* ws = p.ws;
    constexpr int L_AS = 0  , L_BS = 4608  , L_HS = L_BS + 36864  , L_C1 = L_HS + 16896  ;
    const bf16_t* kv = (const bf16_t*)(ws + WS_KV);
    for (int u = blockIdx.x; u < 256; u += gridDim.x) {
        const int which = u >> 7, bg = (u >> 3) & 15, nb = u & 7, b = bg >> 1, g = bg & 1;
        __syncthreads();
        if (tid < 256) { float a = 0.f; for (int kc = 0; kc < 16; ++kc) a += ((const float*)(ws + WS_C1P))[(kc * 2 + which) * 256 + tid]; ((LAS float*)(lds + L_C1))[tid] = a; }
        const bf16_t* w1t = (const bf16_t*)(ws + WS_W1T) + (size_t)which * 256 * 2048;
        f32x16 acc = zero16();
        for (int l = 0; l < 32; ++l) {
            __syncthreads();
            if (tid < 256) { const int row = tid >> 3, ch = tid & 7; int tk = 16 * (32 * nb + row) + l; tk = tk > 4095 ? 4095 : tk;
                *(LAS u32x4*)(lds + L_AS + row * 144 + ch * 16) = *(const u32x4*)(kv + ((size_t)b * 4096 + tk) * 768 + which * 128 + g * 64 + ch * 8); }
#pragma unroll
            for (int k = 0; k < 4; ++k) { const int ci = tid + 512 * k; const int row = ci >> 3, ch = ci & 7;
                *(LAS u32x4*)(lds + L_BS + row * 144 + ch * 16) = *(const u32x4*)(w1t + (size_t)row * 2048 + l * 64 + ch * 8); }
            __syncthreads();
            const LAS unsigned char* ab = lds + L_AS + r32 * 144 + hh * 16;
            const LAS unsigned char* bb = lds + L_BS + (32 * wave + r32) * 144 + hh * 16;
#pragma unroll
            for (int ks = 0; ks < 4; ++ks) acc = MFMA32(lds128(ab + ks * 32), lds128(bb + ks * 32), acc);
        }
        {
            const float c1 = ((LAS float*)(lds + L_C1))[32 * wave + r32];
#pragma unroll
            for (int reg = 0; reg < 16; ++reg) *(LAS bf16_t*)(lds + L_HS + crow(reg, hh) * 528 + (32 * wave + r32) * 2) = f2bf(siluf(acc[reg] + c1));
        }
        __syncthreads();
        if (wave < 2) {
            const bf16_t* w2t = (const bf16_t*)(ws + WS_W2T) + (size_t)(which * 64 + 32 * wave + r32) * 256 + hh * 8;
            const LAS unsigned char* ab = lds + L_HS + r32 * 528 + hh * 16;
            f32x16 o = zero16();
#pragma unroll
            for (int ks = 0; ks < 16; ++ks) o = MFMA32(lds128(ab + ks * 32), *(const bf16x8*)(w2t + ks * 16), o);
            bf16_t* dst = (bf16_t*)(ws + WS_CMP) + (size_t)(which * 16 + bg) * 256 * 64;
#pragma unroll
            for (int reg = 0; reg < 16; ++reg) { const int n = 32 * nb + crow(reg, hh); const bf16_t val = (n < 255) ? f2bf(o[reg]) : (bf16_t)0;
                if (which == 0) dst[n * 64 + 32 * wave + r32] = val; else dst[(32 * wave + r32) * 256 + n] = val; }
        }
    }
}

__device__ const unsigned char T5_BUCKET[128] = {0, 1, 2, 3, 4, 5, 6, 7, 8, 9, 10, 11, 12, 13, 14, 15, 16, 16, 16, 17, 17, 18, 18, 18, 19, 19, 19, 20, 20, 20, 20, 21, 21, 21, 21, 22, 22, 22, 22, 22, 23, 23, 23, 23, 23, 23, 24, 24, 24, 24, 24, 24, 25, 25, 25, 25, 25, 25, 25, 26, 26, 26, 26, 26, 26, 26, 26, 27, 27, 27, 27, 27, 27, 27, 27, 27, 27, 28, 28, 28, 28, 28, 28, 28, 28, 28, 28, 29, 29, 29, 29, 29, 29, 29, 29, 29, 29, 29, 29, 30, 30, 30, 30, 30, 30, 30, 30, 30, 30, 30, 30, 30, 30, 31, 31, 31, 31, 31, 31, 31, 31, 31, 31, 31, 31, 31, 31, 31};
constexpr float NEGBIG = -1e30f;

template <int PMODE> DI void p9_nsa(const Params& p, LAS unsigned char* lds) {
    const int wave = __builtin_amdgcn_readfirstlane((int)threadIdx.x >> 6);
    unsigned char* ws = p.ws;
    constexpr int STG = 17920, L_K = 0, L_V = 9216, L_BT = 4 * STG, L_IA = L_BT + 4224, L_IB = L_IA + 8192, L_Y = L_IB + 8704;
    static_assert(L_Y + 65536 <= LDS_BYTES - 64, "p9 lds");
    constexpr float LOG2E = 1.4426950408889634f;
    LAS float* YL = (LAS float*)(lds + L_Y) + wave * 2048;
    LAS float* BT = (LAS float*)(lds + L_BT);
    LAS float* IA = (LAS float*)(lds + L_IA) + wave * 256;
    LAS float* IB = (LAS float*)(lds + L_IB) + wave * 272;
    const bf16_t* kvb = (const bf16_t*)(ws + WS_KV);
    const bf16_t* cmpb = (const bf16_t*)(ws + WS_CMP);
    const bf16_t* vtb = (const bf16_t*)(ws + WS_VT);
    const bf16_t* projb = (const bf16_t*)(ws + WS_PROJB);
    const float* gates = (const float*)(ws + WS_GATES);
    const float* relb = p.in[2];
    for (int vc0 = blockIdx.x; vc0 < 256; vc0 += gridDim.x) {
        const int vc = (gridDim.x == 256) ? ((vc0 & 7) * 32 + (vc0 >> 3)) : vc0;
        const int bg = vc >> 4, kk16 = vc & 15, b = bg >> 1, g = bg & 1;
        __syncthreads();
        for (int idx = (int)threadIdx.x; idx < 1040; idx += 512) { const int hd_ = idx / 130, e = idx - hd_ * 130;
            BT[idx] = (e == 0) ? NEGBIG : relb[(e == 129 ? 31 : (int)T5_BUCKET[e - 1]) * 16 + g * 8 + hd_] * LOG2E; }
        for (int ju = 0; ju < 8; ++ju) {
            int lane = (int)threadIdx.x & 63; asm volatile("" : "+v"(lane));
            const int tid = wave * 64 + lane, r32 = lane & 31, hh = lane >> 5, tok = r32 >> 3, hd = r32 & 7;
            const int srow = tid >> 3, sch = tid & 7;
            const int ub = (ju & 1) ? (32 * (ju >> 1) + 31 - kk16) : (32 * (ju >> 1) + kk16);
            const int t0 = 32 * ub, cur = ub >> 1;
            const int tq = t0 + 4 * wave + tok, head = g * 8 + hd;
            const int tqw = t0 + 4 * wave;
            const int trow32 = b * 4096 + tq;
            __syncthreads();
            for (int idx = lane; idx < 256; idx += 64) IA[idx] = 0.f;
            for (int idx = lane; idx < 272; idx += 64) IB[idx] = 0.f;
            bf16x8 Qf[4];
#pragma unroll
            for (int ks = 0; ks < 4; ++ks) Qf[ks] = *(const bf16x8*)(projb + (size_t)trow32 * 4096 + head * 64 + 16 * ks + 8 * hh);
            const int nct = (ub >> 5) + 1;
            const int nfar_s = (tqw - 176 >= 0) ? ((tqw - 176) >> 6) + 1 : 0;
            const int wlo = (t0 - 511) > 0 ? ((t0 - 511) >> 6) : 0;
            const int nwin = cur - wlo + 1;
            const int NT = 2 * nct + (cur + 1) + nwin;
            u32x4 kregA, vregA, kregB, vregB;
            auto tload = [&](u32x4& kreg, u32x4& vreg, int i) {
                const bf16_t *kp, *vp; int kstride, vstride;
                if (i < 2 * nct) { const int ti = i < nct ? i : i - nct; kp = cmpb + ((size_t)(0 * 16 + bg) * 256 + 64 * ti) * 64; kstride = 64; vp = cmpb + (size_t)(1 * 16 + bg) * 256 * 64 + 64 * ti; vstride = 256; }
                else if (i < 2 * nct + cur + 1) { const int s_ = i - 2 * nct; kp = kvb + ((size_t)b * 4096 + 64 * s_) * 768 + 256 + g * 64; kstride = 768; vp = vtb + (size_t)((0 * 8 + b) * 2 + g) * 64 * 4096 + 64 * s_; vstride = 4096; }
                else { const int blk = cur - (i - 2 * nct - cur - 1); kp = kvb + ((size_t)b * 4096 + 64 * blk) * 768 + 512 + g * 64; kstride = 768; vp = vtb + (size_t)((1 * 8 + b) * 2 + g) * 64 * 4096 + 64 * blk; vstride = 4096; }
                kreg = *(const u32x4*)(kp + (size_t)srow * kstride + sch * 8); vreg = *(const u32x4*)(vp + (size_t)srow * vstride + sch * 8);
            };
            auto twrite = [&](const u32x4& kreg, const u32x4& vreg, int st) {
                *(LAS u32x4*)(lds + st * STG + L_K + srow * 144 + sch * 16) = kreg;
                LAS u32x2* vd = (LAS u32x2*)(lds + st * STG + L_V + srow * 136 + sch * 16);
                vd[0] = (u32x2){vreg[0], vreg[1]}; vd[1] = (u32x2){vreg[2], vreg[3]};
            };
            tload(kregA, vregA, 0); twrite(kregA, vregA, 0);
            if (NT > 1) { tload(kregB, vregB, 1); twrite(kregB, vregB, 1); }
            if (NT > 2) tload(kregA, vregA, 2);
            __syncthreads();
            float m_run = NEGBIG, l_run = 0.f, m_c = NEGBIG, linv_c = 0.f;
            f32x16 O[2]; O[0] = zero16(); O[1] = zero16();
            unsigned long long mymask = 0ull, wmask = 0ull;
            u32x2 zpre[8]; float gpre;
            auto zfetch = [&](int br) {
                int l2 = lane; asm volatile("" : "+v"(l2)); const int hh2 = l2 >> 5;
                int tr_ = trow32; asm volatile("" : "+v"(tr_)); const size_t trow = (size_t)tr_;
                gpre = gates[trow * 48 + br * 16 + head];
                const bf16_t* zp = projb + trow * 4096 + 1024 + br * 1024 + head * 64;
#pragma unroll
                for (int db = 0; db < 2; ++db)
#pragma unroll
                    for (int gi = 0; gi < 4; ++gi) zpre[db * 4 + gi] = *(const u32x2*)(zp + 32 * db + 8 * gi + 4 * hh2);
            };
            zfetch(0);
            auto finalize = [&](int br, bool normalized) {
                float inv = 1.f;
                if (!normalized) { const float L = l_run + __shfl_xor(l_run, 32); inv = 1.f / fmaxf(L, 1e-30f); }
                const float gt = gpre * inv;
#pragma unroll
                for (int db = 0; db < 2; ++db)
#pragma unroll
                    for (int gi = 0; gi < 4; ++gi) { const u32x2 zv = zpre[db * 4 + gi];
                        LAS float* yl = YL + (db * 16 + 4 * gi) * 64 + lane;
                        const float c0 = gt * O[db][4 * gi + 0] * siluf(bflo(zv[0])), c1 = gt * O[db][4 * gi + 1] * siluf(bfhi(zv[0]));
                        const float c2 = gt * O[db][4 * gi + 2] * siluf(bflo(zv[1])), c3 = gt * O[db][4 * gi + 3] * siluf(bfhi(zv[1]));
                        if (br == 0) { yl[0] = c0; yl[64] = c1; yl[128] = c2; yl[192] = c3; }
                        else { yl[0] += c0; yl[64] += c1; yl[128] += c2; yl[192] += c3; } }
                O[0] = zero16(); O[1] = zero16(); m_run = NEGBIG; l_run = 0.f;
                if (br < 2) zfetch(br + 1);
            };
            auto tile_body_p = [&](auto KT, auto MD, auto PAR, const int i, const int tix) {
                constexpr int kind = decltype(KT)::value; constexpr int mode = decltype(MD)::value; constexpr int par = decltype(PAR)::value;
                const float bfar = BT[hd * 130 + 129];
                if (i + 3 < NT) { if constexpr (par) tload(kregA, vregA, i + 3); else tload(kregB, vregB, i + 3); }
                const LAS unsigned char* sb = lds + (i & 3) * STG;
                const bool skip = ((kind == 2) && (((wmask >> tix) & 1ull) == 0ull)) || PMODE == 1;
                if (!skip) {
                    f32x16 st[2];
#pragma unroll
                    for (int kb = 0; kb < 2; ++kb) {
                        bf16x8 kf[4];
#pragma unroll
                        for (int ks = 0; ks < 4; ++ks) kf[ks] = lds128(sb + L_K + (32 * kb + r32) * 144 + hh * 16 + ks * 32);
                        __builtin_amdgcn_sched_barrier(0);
                        st[kb] = zero16();
#pragma unroll
                        for (int ks = 0; ks < 4; ++ks) st[kb] = MFMA32(kf[ks], Qf[ks], st[kb]);
                    }
                    bf16x8 vf[8];
                    if constexpr (kind != 0 && mode == 0) {
#pragma unroll
                        for (int db = 0; db < 2; ++db)
#pragma unroll
                            for (int ks = 0; ks < 4; ++ks) { const LAS unsigned char* vr = sb + L_V + (32 * db + r32) * 136 + hh * 8 + ks * 32; vf[db * 4 + ks] = lds2x64(vr, vr + 16); }
                    }
                    __builtin_amdgcn_sched_barrier(0);
                    const bool selected = (kind != 2) || (((mymask >> tix) & 1ull) != 0ull);
                    float mx = NEGBIG;
                    if constexpr (mode == 1) {
                        int dbase = (kind <= 1) ? (tq - 30 - 1024 * tix - 64 * hh) : (tq + 1 - 64 * tix - 4 * hh);
                        asm volatile("" : "+v"(dbase));
                        constexpr int dmul = (kind <= 1) ? 16 : 1;
                        const LAS float* btl = BT + hd * 130;
                        float man[4] = {NEGBIG, NEGBIG, NEGBIG, NEGBIG};
#pragma unroll
                        for (int kb = 0; kb < 2; ++kb)
#pragma unroll
                            for (int reg = 0; reg < 16; ++reg) {
                                const int dr_ = dbase - dmul * (32 * kb + (reg & 3) + 8 * (reg >> 2)); const int di = dr_ < 0 ? 0 : (dr_ > 129 ? 129 : dr_);
                                const float sv = st[kb][reg] + btl[di];
                                st[kb][reg] = sv; man[reg & 3] = fmaxf(man[reg & 3], sv);
                            }
                        mx = fmaxf(fmaxf(man[0], man[1]), fmaxf(man[2], man[3]));
                        if (!selected) mx = NEGBIG;
                    } else if constexpr (mode == 2) {
                        int dbase = tq - 64 * tix - 4 * hh; asm volatile("" : "+v"(dbase));
#pragma unroll
                        for (int kb = 0; kb < 2; ++kb)
#pragma unroll
                            for (int reg = 0; reg < 16; ++reg) {
                                const int dist = dbase - (32 * kb + (reg & 3) + 8 * (reg >> 2));
                                const float sv = dist < 512 ? st[kb][reg] + bfar : NEGBIG;
                                st[kb][reg] = sv; mx = fmaxf(mx, sv);
                            }
                    } else {
                        float ma[4] = {NEGBIG, NEGBIG, NEGBIG, NEGBIG};
#pragma unroll
                        for (int kb = 0; kb < 2; ++kb)
#pragma unroll
                            for (int reg = 0; reg < 16; ++reg) ma[reg & 3] = fmaxf(ma[reg & 3], st[kb][reg]);
                        mx = fmaxf(fmaxf(ma[0], ma[1]), fmaxf(ma[2], ma[3]));
                        mx = selected ? mx + bfar : NEGBIG;
                    }
                    if constexpr (kind != 1) {
                        mx = fmaxf(mx, __shfl_xor(mx, 32));
                        const float mnew = fmaxf(m_run, mx);
                        const float alpha = __builtin_amdgcn_exp2f(m_run - mnew);
                        const float msub = selected ? (mode == 0 ? mnew - bfar : mnew) : 1e30f;
                        float ls;
                        {
                            const f32x2 ms2 = {msub, msub}; f32x2 acc2[4] = {{0.f, 0.f}, {0.f, 0.f}, {0.f, 0.f}, {0.f, 0.f}};
#pragma unroll
                            for (int kb = 0; kb < 2; ++kb)
#pragma unroll
                                for (int r2 = 0; r2 < 8; ++r2) { f32x2 v = {st[kb][2 * r2], st[kb][2 * r2 + 1]}; v = v - ms2;
                                    v[0] = __builtin_amdgcn_exp2f(v[0]); v[1] = __builtin_amdgcn_exp2f(v[1]); acc2[r2 & 3] = acc2[r2 & 3] + v; st[kb][2 * r2] = v[0]; st[kb][2 * r2 + 1] = v[1]; }
                            const f32x2 t2 = (acc2[0] + acc2[1]) + (acc2[2] + acc2[3]);
                            ls = t2[0] + t2[1];
                        }
                        l_run = l_run * alpha + ls; m_run = mnew;
                        if constexpr (kind != 0) { if (__ballot(alpha != 1.f) != 0ull) { O[0] = O[0] * alpha; O[1] = O[1] * alpha; } }
                    } else {
#pragma unroll
                        for (int kb = 0; kb < 2; ++kb) {
#pragma unroll
                            for (int reg = 0; reg < 16; ++reg) st[kb][reg] = __builtin_amdgcn_exp2f(st[kb][reg] - m_c) * linv_c;
#pragma unroll
                            for (int gi = 0; gi < 4; ++gi) {
                                float a = 2.f * (st[kb][4 * gi] + st[kb][4 * gi + 1] + st[kb][4 * gi + 2]) + st[kb][4 * gi + 3], bq = st[kb][4 * gi + 3];
                                a += __shfl_xor(a, 1); a += __shfl_xor(a, 2); a += __shfl_xor(a, 4);
                                bq += __shfl_xor(bq, 1); bq += __shfl_xor(bq, 2); bq += __shfl_xor(bq, 4);
                                const int sidx = 16 * tix + 8 * kb + 2 * gi + hh;
                                if (hd == 0) { IA[tok * 64 + sidx] = a; IB[tok * 68 + sidx + 1] = bq; }
                            }
                        }
                    }
                    if constexpr (kind != 0 && PMODE != 2) {
                        if constexpr (mode != 0) {
#pragma unroll
                            for (int db = 0; db < 2; ++db)
#pragma unroll
                                for (int ks = 0; ks < 4; ++ks) { const LAS unsigned char* vr = sb + L_V + (32 * db + r32) * 136 + hh * 8 + ks * 32; vf[db * 4 + ks] = lds2x64(vr, vr + 16); }
                        }
                        bf16x8 Pf[4];
#pragma unroll
                        for (int kb = 0; kb < 2; ++kb) { Pf[2 * kb] = pack8(st[kb], 0); Pf[2 * kb + 1] = pack8(st[kb], 1); }
                        __builtin_amdgcn_sched_barrier(0);
#pragma unroll
                        for (int ks = 0; ks < 4; ++ks)
#pragma unroll
                            for (int db = 0; db < 2; ++db) O[db] = MFMA32(vf[db * 4 + ks], Pf[ks], O[db]);
                    }
                }
                __builtin_amdgcn_sched_barrier(0);
                if (i + 2 < NT) { if constexpr (par) twrite(kregB, vregB, (i + 2) & 3); else twrite(kregA, vregA, (i + 2) & 3); }
                __syncthreads();
            };
            auto tile_body = [&](auto KT, auto MD, const int i, const int tix) {
                if (i & 1) tile_body_p(KT, MD, std::integral_constant<int, 1>{}, i, tix); else tile_body_p(KT, MD, std::integral_constant<int, 0>{}, i, tix);
            };
#define NSBAR() __builtin_amdgcn_sched_barrier(0)
#define NPIN(x) asm volatile("" : "+v"(x))
            auto far_run = [&](auto PAR0, auto KD, const int i0, const int n) {
                constexpr int par0 = decltype(PAR0)::value; constexpr int kd = decltype(KD)::value;
                using PE = std::integral_constant<int, par0>; using PO = std::integral_constant<int, par0 ^ 1>;
                constexpr float THR = 8.f;
                f32x16 sA[2], sB[2]; bf16x8 kfr[3], vfr[3]; u32x4 pw[4];
                const int e2 = 2 * nct, e3 = e2 + cur + 1;
                auto stg_begin = [&](auto PR, int i) { if (i + 3 < NT) { if constexpr (decltype(PR)::value) tload(kregA, vregA, i + 3); else tload(kregB, vregB, i + 3); } };
                auto stg_end = [&](auto PR, int i) { if (i + 2 < NT) { if constexpr (decltype(PR)::value) twrite(kregB, vregB, (i + 2) & 3); else twrite(kregA, vregA, (i + 2) & 3); } __syncthreads(); };
                auto blk_of = [&](int i) -> int { return kd == 2 ? i - e2 : cur - (i - e3); };
                auto mode_of = [&](int blk) -> int { if (kd == 2) return blk < nfar_s ? 0 : 1; return (tqw - 64 * blk - 63 < 113) ? 1 : 0; };
                auto c0_of = [&](int blk, int mode) -> float { const bool sel = kd == 3 || (((mymask >> blk) & 1ull) != 0ull); return sel ? (mode == 1 ? 0.f : BT[hd * 130 + 129]) : NEGBIG; };
                auto fixup = [&](f32x16 (&C)[2], int mode, int blk) {
                    if (mode == 1) {
                        int dbase = tq + 1 - 64 * blk - 4 * hh; asm volatile("" : "+v"(dbase));
                        const LAS float* btl = BT + hd * 130;
#pragma unroll
                        for (int kb = 0; kb < 2; ++kb)
#pragma unroll
                            for (int reg = 0; reg < 16; ++reg) { const int dr_ = dbase - (32 * kb + (reg & 3) + 8 * (reg >> 2)); const int di = dr_ < 0 ? 0 : (dr_ > 129 ? 129 : dr_); C[kb][reg] += btl[di];
                                if ((reg & 3) == 3) __builtin_amdgcn_sched_barrier(0); }
                    }
                };
                auto rowmax = [&](const f32x16& c0, const f32x16& c1) -> float {
                    float a = fmaxf(fmaxf(c0[0], c0[1]), c1[0]), b2 = fmaxf(fmaxf(c0[2], c0[3]), c1[1]); a = fmaxf(fmaxf(a, c1[2]), c1[3]);
#pragma unroll
                    for (int r = 4; r < 16; r += 4) { a = fmaxf(fmaxf(a, c0[r]), c0[r + 1]); b2 = fmaxf(fmaxf(b2, c0[r + 2]), c0[r + 3]); a = fmaxf(fmaxf(a, c1[r]), c1[r + 1]); b2 = fmaxf(fmaxf(b2, c1[r + 2]), c1[r + 3]); }
                    const float m = fmaxf(a, b2); return fmaxf(m, __shfl_xor(m, 32)); };
                {
                    const int i = i0; stg_begin(PE{}, i);
                    const int blk = blk_of(i), mode = mode_of(blk);
                    const LAS unsigned char* kb0 = lds + (i & 3) * STG + L_K + r32 * 144 + hh * 16;
                    kfr[0] = lds128(kb0); kfr[1] = lds128(kb0 + 32 * 144);
                    const float c0 = c0_of(blk, mode);
#pragma unroll
                    for (int r = 0; r < 16; ++r) { sA[0][r] = c0; sA[1][r] = c0; }
#pragma unroll
                    for (int g = 0; g < 8; ++g) { const int kb = g & 1, ks = g >> 1;
                        if (g + 2 < 8) { const int f = g + 2; kfr[f % 3] = lds128(kb0 + (f & 1) * 32 * 144 + (f >> 1) * 32); }
                        sA[kb] = MFMA32(kfr[g % 3], Qf[ks], sA[kb]); NSBAR(); }
                    const LAS unsigned char* kn = lds + ((i + 1) & 3) * STG + L_K + r32 * 144 + hh * 16;
                    kfr[0] = lds128(kn); kfr[1] = lds128(kn + 32 * 144);
                    fixup(sA, mode, blk);
                    const float mx = rowmax(sA[0], sA[1]);
                    const float mnew = fmaxf(m_run, mx), alpha = __builtin_amdgcn_exp2f(m_run - mnew);
                    l_run *= alpha; m_run = mnew;
                    if (__ballot(alpha != 1.f) != 0ull) { O[0] = O[0] * alpha; O[1] = O[1] * alpha; }
#pragma unroll
                    for (int kb = 0; kb < 2; ++kb)
#pragma unroll
                        for (int r = 0; r < 16; ++r) sA[kb][r] = __builtin_amdgcn_exp2f(sA[kb][r] - mnew);
                    stg_end(PE{}, i);
                }
#define NSTEP(C, P, PR, i_, GL) do { const int it_ = (i_); stg_begin(PR{}, it_); NSBAR(); \
                    const int blk_ = blk_of(it_), mode_ = mode_of(blk_); \
                    const LAS unsigned char* vp_ = lds + ((it_ - 1) & 3) * STG + L_V + r32 * 136 + hh * 8; \
                    const LAS unsigned char* kn_ = lds + ((it_ + 1) & 3) * STG + L_K + r32 * 144 + hh * 16; \
                    const LAS unsigned char* kc_ = lds + (it_ & 3) * STG + L_K + r32 * 144 + hh * 16; \
                    { const float c0_ = c0_of(blk_, mode_) - m_run; _Pragma("unroll") for (int r = 0; r < 16; ++r) { C[0][r] = c0_; C[1][r] = c0_; } }     \
                    float sacc = 0.f; \
                    _Pragma("unroll") for (int g = 0; g < 8; ++g) { const int kb = g & 1, ks = g >> 1, pk = g >> 2, pr = 4 * (g & 3); \
                        C[kb] = MFMA32(kfr[g % 3], Qf[ks], C[kb]); \
                        if (g + 2 < 8) { const int f = g + 2; kfr[f % 3] = lds128(kc_ + (f & 1) * 32 * 144 + (f >> 1) * 32); } \
                        sacc += (P[pk][pr] + P[pk][pr + 1]) + (P[pk][pr + 2] + P[pk][pr + 3]); \
                        pw[g >> 1][(g & 1) * 2] = cvtpk(P[pk][pr], P[pk][pr + 1]); pw[g >> 1][(g & 1) * 2 + 1] = cvtpk(P[pk][pr + 2], P[pk][pr + 3]); \
                        if (g >= 6) { const int f = g - 6; vfr[f] = lds2x64(vp_ + (f & 1) * 32 * 136 + (f >> 1) * 32, vp_ + (f & 1) * 32 * 136 + (f >> 1) * 32 + 16); } \
                        NPIN(pw[g >> 1]); NPIN(sacc); NSBAR(); } \
                    l_run += sacc; \
                    if (mode_ != 0) fixup(C, mode_, blk_); \
                    float fs_ = 1.f; bool resc_ = false; \
                    { const float mx = rowmax(C[0], C[1]);                        \
                      if (__builtin_expect(__ballot(mx > THR) != 0ull, 0)) { const float dl = fmaxf(mx, 0.f); m_run += dl; fs_ = __builtin_amdgcn_exp2f(-dl); l_run *= fs_; resc_ = true; \
                          _Pragma("unroll") for (int kb = 0; kb < 2; ++kb) _Pragma("unroll") for (int r = 0; r < 16; ++r) C[kb][r] -= dl; } } \
                    NSBAR(); \
                    _Pragma("unroll") for (int g = 0; g < 8; ++g) { const int db = g & 1, ks = g >> 1, ck = g >> 2, cr = 4 * (g & 3); \
                        O[db] = MFMA32(vfr[g % 3], __builtin_bit_cast(bf16x8, pw[ks]), O[db]); \
                        C[ck][cr] = __builtin_amdgcn_exp2f(C[ck][cr]); C[ck][cr + 1] = __builtin_amdgcn_exp2f(C[ck][cr + 1]); C[ck][cr + 2] = __builtin_amdgcn_exp2f(C[ck][cr + 2]); C[ck][cr + 3] = __builtin_amdgcn_exp2f(C[ck][cr + 3]); \
                        if (g + 2 < 8) { const int f = g + 2; vfr[f % 3] = lds2x64(vp_ + (f & 1) * 32 * 136 + (f >> 1) * 32, vp_ + (f & 1) * 32 * 136 + (f >> 1) * 32 + 16); } \
                        if ((GL) && g >= 6) kfr[g - 6] = lds128(kn_ + (g - 6) * 32 * 144);               \
                        NPIN(C[ck]); NSBAR(); } \
                    if (resc_) { O[0] = O[0] * fs_; O[1] = O[1] * fs_; } \
                    stg_end(PR{}, it_); } while (0)
                int i = i0 + 1; const int iend = i0 + n;
#pragma unroll 1
                for (; i + 1 < iend; i += 2) { NSTEP(sB, sA, PO, i, true); NSTEP(sA, sB, PE, i + 1, (i + 2 < iend)); }
                const bool lastB = (i < iend);
                if (lastB) { NSTEP(sB, sA, PO, i, false); }
                auto drain = [&](const f32x16 (&P)[2]) {
                    float sacc = 0.f;
#pragma unroll
                    for (int kb = 0; kb < 2; ++kb)
#pragma unroll
                        for (int r = 0; r < 16; ++r) sacc += P[kb][r];
                    l_run += sacc;
                    bf16x8 Pf[4];
#pragma unroll
                    for (int kb = 0; kb < 2; ++kb) { Pf[2 * kb] = pack8(P[kb], 0); Pf[2 * kb + 1] = pack8(P[kb], 1); }
                    const LAS unsigned char* vp_ = lds + ((iend - 1) & 3) * STG + L_V + r32 * 136 + hh * 8;
                    bf16x8 vf[8];
#pragma unroll
                    for (int g = 0; g < 8; ++g) vf[g] = lds2x64(vp_ + (g & 1) * 32 * 136 + (g >> 1) * 32, vp_ + (g & 1) * 32 * 136 + (g >> 1) * 32 + 16);
#pragma unroll
                    for (int g = 0; g < 8; ++g) O[g & 1] = MFMA32(vf[g], Pf[g >> 1], O[g & 1]);
                };
                if (lastB) drain(sB); else drain(sA);
#undef NSTEP
            };
            using IC0 = std::integral_constant<int, 0>; using IC1 = std::integral_constant<int, 1>; using IC2 = std::integral_constant<int, 2>; using IC3 = std::integral_constant<int, 3>;
            int ti = 0;
#pragma unroll 1
            for (int t = 0; t < nct; ++t, ++ti) tile_body(IC0{}, IC1{}, ti, t);
            { const float L = l_run + __shfl_xor(l_run, 32); m_c = m_run; linv_c = (tq >= 31) ? 1.f / fmaxf(L, 1e-30f) : 0.f; m_run = NEGBIG; l_run = 0.f; }
#pragma unroll 1
            for (int t = 0; t < nct; ++t, ++ti) tile_body(IC1{}, IC1{}, ti, t);
            finalize(0, true);
            {
                wmask = 0ull; mymask = 0ull;
#pragma unroll 1
                for (int tk = 0; tk < 4; ++tk) {
                    float v = IA[tk * 64 + lane] + IB[tk * 68 + lane];
                    if (lane == 0 || lane == cur || lane == cur - 1) v = 1e9f; else if (lane > cur) v = -1e9f;
                    int rank = 0;
#pragma unroll
                    for (int j = 0; j < 64; ++j) { const float vj = __builtin_bit_cast(float, __builtin_amdgcn_readlane(__builtin_bit_cast(int, v), j)); rank += ((vj > v) || (vj == v && j < lane)) ? 1 : 0; }
                    const unsigned long long mk = __ballot(rank < 16);
                    wmask |= mk; if (tok == tk) mymask = mk;
                }
            }
            {
                const int nsel = cur + 1;
                if (PMODE == 0 && nsel >= 2) { if (ti & 1) far_run(IC1{}, IC2{}, ti, nsel); else far_run(IC0{}, IC2{}, ti, nsel); ti += nsel; }
                else {
#pragma unroll 1
                    for (int t = 0; t <= cur; ++t, ++ti) { if (t < nfar_s) tile_body(IC2{}, IC0{}, ti, t); else tile_body(IC2{}, IC1{}, ti, t); }
                }
            }
            finalize(1, false);
            int twin = 0;
            {
                const int first_ok = (t0 - 480 > 0) ? ((t0 - 480 + 63) >> 6) : 0;
                const int nrun = cur - (first_ok > wlo ? first_ok : wlo) + 1;
                if (PMODE == 0 && nrun >= 2) { if (ti & 1) far_run(IC1{}, IC3{}, ti, nrun); else far_run(IC0{}, IC3{}, ti, nrun); ti += nrun; twin = nrun; }
            }
            {
#pragma unroll 1
                for (int t = twin; t < nwin; ++t, ++ti) { const int blk = cur - t;
                    const bool oldw = (tqw + 3 - 64 * blk > 511), nearw = (tqw - 64 * blk - 63 < 113);
                    if (oldw) tile_body(IC3{}, IC2{}, ti, blk); else if (nearw) tile_body(IC3{}, IC1{}, ti, blk); else tile_body(IC3{}, IC0{}, ti, blk); }
            }
            finalize(2, false);
            if (PMODE != 0) continue;
            int try_ = trow32; asm volatile("" : "+v"(try_));
            bf16_t* yp = (bf16_t*)(ws + WS_RA) + (size_t)try_ * 1024 + head * 64;
#pragma unroll
            for (int db = 0; db < 2; ++db)
#pragma unroll
                for (int gi = 0; gi < 4; ++gi) { const LAS float* yl = YL + (db * 16 + 4 * gi) * 64 + lane; u32x2 o; o.x = cvtpk(yl[0], yl[64]); o.y = cvtpk(yl[128], yl[192]);
                    *(u32x2*)(yp + 32 * db + 8 * gi + 4 * hh) = o; }
        }
    }
}

DI void p11_final(const Params& p) {
    const int tid = otid(), lane = tid & 63, wave = tid >> 6;
    const float* ssq = (const float*)(p.ws + WS_SSQ);
    f32x4 g4[4];
#pragma unroll
    for (int j = 0; j < 4; ++j) g4[j] = *((const f32x4*)p.in[22] + lane + 64 * j);
    const int stride = gridDim.x * 8;
    int m = blockIdx.x * 8 + wave;
    f32x4 vn[4]; float sn = 0.f;
    auto ld = [&](int mm) { f32x4* xr = (f32x4*)(p.out + (size_t)mm * 1024) + lane;
#pragma unroll
        for (int j = 0; j < 4; ++j) vn[j] = xr[64 * j];
        sn = (lane < 16) ? ssq[(size_t)lane * M + mm] : 0.f; };
    if (m < M) ld(m);
    for (; m < M; m += stride) {
        f32x4 v[4]; for (int j = 0; j < 4; ++j) v[j] = vn[j]; float s = sn;
        if (m + stride < M) ld(m + stride);
        s += __shfl_xor(s, 1); s += __shfl_xor(s, 2); s += __shfl_xor(s, 4); s += __shfl_xor(s, 8);
        s = __shfl(s, 0);
        const float rstd = rsqrtf(s * (1.f / 1024.f) + EPS);
        f32x4* xr = (f32x4*)(p.out + (size_t)m * 1024) + lane;
#pragma unroll
        for (int j = 0; j < 4; ++j) xr[64 * j] = v[j] * rstd * g4[j];
    }
}

template <int PH> DI void run_phase(const Params& p, LAS unsigned char* lds) {
    unsigned char* ws = p.ws;
    const int G = gridDim.x;
    bf16_t* h0 = (bf16_t*)((unsigned char*)p.out + 64 * MiB);
    if constexpr (PH == 0) p0_prologue<0>(p, lds, 0, (int)gridDim.x);
    if constexpr (PH == 1) norm_rows<0>(p, lds);
    if constexpr (PH == 2) {
        pg8::Gemm g{h0, h0, 0, (const bf16_t*)(ws + WS_WA), M, 4096, 1024}; pg8::StaticOrder S; S.init(M, 4096, G, (int)blockIdx.x);
        EpiA E{(bf16_t*)(ws + WS_RA), (bf16_t*)p.out, 0};
        pg8::gemm_phase<EpiA, true>(lds, g, S, E);
    }
    if constexpr (PH == 3) p3_prep(p, lds);
    if constexpr (PH == 6) { if (gridDim.x > 64) p0_prologue<1>(p, lds, 64, (int)gridDim.x - 64); else p0_prologue<1>(p, lds, 0, (int)gridDim.x); p4_scan<0>(p, lds); }
    if constexpr (PH == 14) p4b_onorm(p);
    if constexpr (PH == 100) p4_scan<1>(p, lds);
    if constexpr (PH == 101) p4_scan<2>(p, lds);
    if constexpr (PH == 7) {
        const bf16_t* ya = (const bf16_t*)(ws + WS_RA);
        pg8::Gemm g{ya, ya, 0, (const bf16_t*)(ws + WS_WAO), M, 1024, 1024}; pg8::StaticOrder S; S.init(M, 1024, G, (int)blockIdx.x);
        EpiRes<false> E{p.in[0], p.out, (const float*)(ws + WS_MOD), nullptr};
        pg8::gemm_phase<EpiRes<false>, true>(lds, g, S, E);
    }
    if constexpr (PH == 8) norm_rows<1>(p, lds);
    if constexpr (PH == 9) {
        pg8::Gemm g{(const bf16_t*)(ws + WS_S), (const bf16_t*)(ws + WS_RA), 3, (const bf16_t*)(ws + WS_WCAT), M, 5120, 1024}; pg8::StaticOrder S; S.init(M, 5120, G, (int)blockIdx.x);
        EpiB E{(bf16_t*)(ws + WS_KV), (bf16_t*)(ws + WS_PROJB), (float*)(ws + WS_GATES), (bf16_t*)(ws + WS_VT)};
        pg8::gemm_phase<EpiB, true>(lds, g, S, E);
    }
    if constexpr (PH == 10) p8_compress(p, lds);
    if constexpr (PH == 11) p9_nsa<0>(p, lds);
    if constexpr (PH == 110) p9_nsa<1>(p, lds);
    if constexpr (PH == 111) p9_nsa<2>(p, lds);
    if constexpr (PH == 12) {
        const bf16_t* yb = (const bf16_t*)(ws + WS_RA);
        pg8::Gemm g{yb, yb, 0, (const bf16_t*)(ws + WS_WBO), M, 1024, 1024}; pg8::StaticOrder S; S.init(M, 1024, G, (int)blockIdx.x);
        EpiRes<true> E{p.out, p.out, (const float*)(ws + WS_MOD) + 8 * 3072, (float*)(ws + WS_SSQ)};
        pg8::gemm_phase<EpiRes<true>, true>(lds, g, S, E);
    }
    if constexpr (PH == 13) p11_final(p);
}
#if MK_ONE_LAUNCH
__global__ void __launch_bounds__(512, 2) fwd_kernel(Params p) {
    extern __shared__ __attribute__((aligned(16))) unsigned char lds_raw[];
    LAS unsigned char* lds = (LAS unsigned char*)lds_raw;
    volatile LAS unsigned* misc = (volatile LAS unsigned*)(lds + LDS_BYTES - 64);
    if (threadIdx.x < 16) misc[threadIdx.x] = 0u;
    __syncthreads();
    XcdBarrier bar = xcd_barrier_post((unsigned*)(p.ws + WS_CTL) + 1024, misc);
    run_phase<0>(p, lds); xcd_barrier(bar); if (DUP_MASK & (1 << 0)) { run_phase<0>(p, lds); xcd_barrier(bar); }
    run_phase<1>(p, lds); xcd_barrier(bar); if (DUP_MASK & (1 << 1)) { run_phase<1>(p, lds); xcd_barrier(bar); }
    run_phase<2>(p, lds); xcd_barrier(bar); if (DUP_MASK & (1 << 2)) { run_phase<2>(p, lds); xcd_barrier(bar); }
    run_phase<3>(p, lds); xcd_barrier(bar); if (DUP_MASK & (1 << 3)) { run_phase<3>(p, lds); xcd_barrier(bar); }
    run_phase<6>(p, lds); xcd_barrier(bar); if (DUP_MASK & (1 << 6)) { run_phase<6>(p, lds); xcd_barrier(bar); }
#if defined(PROBE_SCAN)
    run_phase<PROBE_SCAN>(p, lds); xcd_barrier(bar);
#endif
    run_phase<14>(p, lds); xcd_barrier(bar);
    run_phase<7>(p, lds); xcd_barrier(bar); if (DUP_MASK & (1 << 7)) { run_phase<7>(p, lds); xcd_barrier(bar); }
    run_phase<8>(p, lds); xcd_barrier(bar); if (DUP_MASK & (1 << 8)) { run_phase<8>(p, lds); xcd_barrier(bar); }
    run_phase<9>(p, lds); xcd_barrier(bar); if (DUP_MASK & (1 << 9)) { run_phase<9>(p, lds); xcd_barrier(bar); }
    run_phase<10>(p, lds); xcd_barrier(bar); if (DUP_MASK & (1 << 10)) { run_phase<10>(p, lds); xcd_barrier(bar); }
    run_phase<11>(p, lds); xcd_barrier(bar); if (DUP_MASK & (1 << 11)) { run_phase<11>(p, lds); xcd_barrier(bar); }
#if defined(PROBE_NSA)
    run_phase<PROBE_NSA>(p, lds); xcd_barrier(bar);
#endif
    run_phase<12>(p, lds); xcd_barrier(bar); if (DUP_MASK & (1 << 12)) { run_phase<12>(p, lds); xcd_barrier(bar); }
    run_phase<13>(p, lds);
}
#else
template <int PH> __global__ void __launch_bounds__(512, 2) phase_kernel(Params p) {
    extern __shared__ __attribute__((aligned(16))) unsigned char lds_raw[];
    run_phase<PH>(p, (LAS unsigned char*)lds_raw);
}
template <int PH> static void launch_phase(const Params& a, int grid, hipStream_t stream) {
    static bool attr = false;
    if (!attr) { (void)hipFuncSetAttribute((const void*)phase_kernel<PH>, hipFuncAttributeMaxDynamicSharedMemorySize, LDS_BYTES); attr = true; }
    hipLaunchKernelGGL(phase_kernel<PH>, dim3(grid), dim3(512), LDS_BYTES, stream, a);
}
#endif

extern "C" void kernel_launch(void* const* d_in, const int* in_sizes, int n_in, void* d_out, int out_size, void* d_ws, size_t ws_size, hipStream_t stream) {
    static int grid = 0;
    if (grid == 0) {
        if (n_in != 23 || out_size != M * D || ws_size < WS_END) { fprintf(stderr, "kernel_launch: unexpected shapes (n_in %d out %d ws %zu)\n", n_in, out_size, ws_size); grid = -1; return; }
        int dev = 0, cus = 0;
        if (hipGetDevice(&dev) != hipSuccess || hipDeviceGetAttribute(&cus, hipDeviceAttributeMultiprocessorCount, dev) != hipSuccess) { grid = -1; return; }
#if MK_ONE_LAUNCH
        if (hipFuncSetAttribute((const void*)fwd_kernel, hipFuncAttributeMaxDynamicSharedMemorySize, LDS_BYTES) != hipSuccess) { fprintf(stderr, "kernel_launch: hipFuncSetAttribute failed\n"); grid = -1; return; }
        int per_cu = 0;
        if (hipOccupancyMaxActiveBlocksPerMultiprocessor(&per_cu, (const void*)fwd_kernel, 512, LDS_BYTES) != hipSuccess || per_cu < 1) fprintf(stderr, "kernel_launch: occupancy query says %d\n", per_cu);
        (void)hipGetLastError();
#endif
        grid = cus;
    }
    if (grid < 0) return;
    Params a{};
    for (int i = 0; i < 23; ++i) a.in[i] = (const float*)d_in[i];
    a.out = (float*)d_out; a.ws = (unsigned char*)d_ws;
    a.ph_lo = 0; a.ph_hi = NPH;
#if MK_ONE_LAUNCH
    hipMemsetAsync((char*)d_ws + WS_CTL, 0, 65536, stream);
    hipLaunchKernelGGL(fwd_kernel, dim3(grid), dim3(512), LDS_BYTES, stream, a);
#else
    launch_phase<0>(a, grid, stream); launch_phase<1>(a, grid, stream); launch_phase<2>(a, grid, stream); launch_phase<3>(a, grid, stream);
    launch_phase<6>(a, grid, stream); launch_phase<14>(a, grid, stream); launch_phase<7>(a, grid, stream);
    launch_phase<8>(a, grid, stream); launch_phase<9>(a, grid, stream); launch_phase<10>(a, grid, stream); launch_phase<11>(a, grid, stream);
    launch_phase<12>(a, grid, stream); launch_phase<13>(a, grid, stream);
#endif
}
```
